# Optimizing an MI355X kernel written in HIP

```python
import jax, jax.numpy as jnp
from jax import lax
import numpy as np

D_MODEL = 2048
BATCH = 1
SEQ = 8192
DEPTH = 2

CHUNK = 64
A_WIDTH = 1024
A_GROUPS = 4
A_HEAD = A_WIDTH // A_GROUPS
A_BLOCK = 128
B_WIDTH = 1024
CONV_W = 3
C_WIDTH = 1024
POOL_WINDOWS = (2, 4, 8, 16)
C_GROUPS = len(POOL_WINDOWS)
C_HEAD = C_WIDTH // C_GROUPS
N_BRANCH = 3
IN_COLS = 2 * A_WIDTH + 3 * B_WIDTH + C_WIDTH
N_EXPERTS = 64
TOP_K = 8
N_GROUPS = 8
TOPK_GROUPS = 4
EXPERT_HIDDEN = 512
SHARED_HIDDEN = 512
ROUTED_SCALE = 2.5
ALPHA = (2.0 * DEPTH) ** 0.25
BETA = (8.0 * DEPTH) ** -0.25
LN_EPS = 1e-5

kernel_name = "hybrid_gmlp_conv_pool_moe_deepnorm"


def layer_norm(x, g, b):
    xf = x.astype(jnp.float32)
    mu = jnp.mean(xf, axis=-1, keepdims=True)
    var = jnp.mean(jnp.square(xf - mu), axis=-1, keepdims=True)
    y = (xf - mu) * lax.rsqrt(var + LN_EPS)
    return (y * g.astype(jnp.float32) + b.astype(jnp.float32)).astype(x.dtype)


def normalize(x):
    xf = x.astype(jnp.float32)
    mu = jnp.mean(xf, axis=-1, keepdims=True)
    var = jnp.mean(jnp.square(xf - mu), axis=-1, keepdims=True)
    return ((xf - mu) * lax.rsqrt(var + LN_EPS)).astype(x.dtype)


def spatial_gating(u, v, w_s, b_s):
    bsz, s, _ = u.shape
    v = normalize(v.reshape(bsz, s // A_BLOCK, A_BLOCK, A_GROUPS, A_HEAD))
    chunk_id = jnp.arange(A_BLOCK) // CHUNK
    mask = chunk_id[None, :] <= chunk_id[:, None]
    w = jnp.where(mask[None], w_s, 0)
    mixed = jnp.einsum('gij,bnjgc->bnigc', w, v) + b_s.T[None, None, :, :, None]
    return u * mixed.reshape(bsz, s, A_WIDTH)


def short_conv(b_gate, c_gate, h, w_conv):
    z = c_gate * h
    s = z.shape[1]
    zp = jnp.pad(z, ((0, 0), (CONV_W - 1, 0), (0, 0)))
    conv = w_conv[0] * zp[:, 0:s]
    for k in range(1, CONV_W):
        conv = conv + w_conv[k] * zp[:, k:k + s]
    return b_gate * conv


def multiscale_pool(p, w_pool, pool_scale):
    bsz, s, _ = p.shape
    pf = p.astype(jnp.float32).reshape(bsz, s, C_GROUPS, C_HEAD)
    cs = jnp.pad(jnp.cumsum(pf, axis=1), ((0, 0), (1, 0), (0, 0), (0, 0)))
    t = jnp.arange(s)
    means = []
    for g, win in enumerate(POOL_WINDOWS):
        start = jnp.maximum(t + 1 - win, 0)
        count = (t + 1 - start).astype(jnp.float32)
        total = cs[:, 1:, g] - cs[:, start, g]
        means.append(total / count[None, :, None])
    pooled = (jnp.stack(means, axis=2) - pf).astype(p.dtype)
    mixed = jnp.einsum('bsgc,gcd->bsgd', pooled, w_pool).reshape(bsz, s, C_WIDTH)
    return mixed * pool_scale


def mixer_block(x, w_in, w_s, b_s, w_conv, w_pool, pool_scale, w_gate, b_gate,
                w_proj_a, w_proj_b, w_proj_c, w_out):
    bsz, s, d = x.shape
    proj = jnp.einsum('bsd,de->bse', x, w_in)
    splits = [A_WIDTH, 2 * A_WIDTH, 2 * A_WIDTH + B_WIDTH,
              2 * A_WIDTH + 2 * B_WIDTH, 2 * A_WIDTH + 3 * B_WIDTH]
    u, v, bg, cg, h, p = jnp.split(proj, splits, axis=-1)
    y_a = spatial_gating(jax.nn.gelu(u, approximate=False),
                         jax.nn.gelu(v, approximate=False), w_s, b_s)
    y_b = short_conv(bg, cg, h, w_conv)
    y_c = multiscale_pool(p, w_pool, pool_scale)
    gates = jax.nn.sigmoid(jnp.einsum('bsd,de->bse', x, w_gate) + b_gate)
    gates = gates.reshape(bsz, s, N_BRANCH, d)
    merged = (gates[:, :, 0] * jnp.einsum('bsc,cd->bsd', y_a, w_proj_a)
              + gates[:, :, 1] * jnp.einsum('bsc,cd->bsd', y_b, w_proj_b)
              + gates[:, :, 2] * jnp.einsum('bsc,cd->bsd', y_c, w_proj_c))
    return jnp.einsum('bsd,de->bse', merged, w_out)


def swiglu(x, w_g, w_u, w_d):
    return jnp.einsum('th,hd->td', jax.nn.silu(x @ w_g) * (x @ w_u), w_d)


def moe_block(x, w_router, router_bias, w1, w3, w2, ws1, ws3, ws2):
    bsz, s, d = x.shape
    xt = x.reshape(bsz * s, d)
    scores = jax.nn.sigmoid(jnp.einsum('td,de->te', xt, w_router).astype(jnp.float32))
    sel = scores + router_bias.astype(jnp.float32)
    grp = sel.reshape(-1, N_GROUPS, N_EXPERTS // N_GROUPS)
    grp_score = lax.top_k(grp, 2)[0].sum(-1)
    _, grp_idx = lax.top_k(grp_score, TOPK_GROUPS)
    grp_mask = jax.nn.one_hot(grp_idx, N_GROUPS, dtype=jnp.float32).sum(1)
    exp_mask = jnp.repeat(grp_mask, N_EXPERTS // N_GROUPS, axis=-1)
    sel = jnp.where(exp_mask > 0, sel, -jnp.inf)
    _, idx = lax.top_k(sel, TOP_K)
    w = jnp.take_along_axis(scores, idx, axis=-1)
    w = w / jnp.sum(w, axis=-1, keepdims=True) * ROUTED_SCALE
    combine = jnp.sum(jax.nn.one_hot(idx, N_EXPERTS, dtype=jnp.float32) * w[..., None], axis=1)
    combine = combine.astype(x.dtype)
    out = swiglu(xt, ws1, ws3, ws2)
    for e in range(N_EXPERTS):
        out = out + combine[:, e:e + 1] * swiglu(xt, w1[e], w3[e], w2[e])
    return out.reshape(bsz, s, d)


def setup_inputs(seed: int = 0) -> dict:
    key = jax.random.key(seed)
    ks = jax.random.split(key, 32)
    f32 = jnp.float32

    def nrm(k, shape, scale):
        return jax.random.normal(k, shape, f32) * scale

    L = DEPTH
    return {
        "x": nrm(ks[0], (BATCH, SEQ, D_MODEL), 1.0),
        "in_ln_g": 1.0 + nrm(ks[1], (D_MODEL,), 0.02),
        "in_ln_b": nrm(ks[2], (D_MODEL,), 0.02),
        "w_in": nrm(ks[3], (L, D_MODEL, IN_COLS), D_MODEL ** -0.5),
        "w_spatial": nrm(ks[4], (L, A_GROUPS, A_BLOCK, A_BLOCK), A_BLOCK ** -0.5),
        "b_spatial": 1.0 + nrm(ks[5], (L, A_GROUPS, A_BLOCK), 0.02),
        "w_conv": nrm(ks[6], (L, CONV_W, B_WIDTH), CONV_W ** -0.5),
        "w_pool": nrm(ks[7], (L, C_GROUPS, C_HEAD, C_HEAD), C_HEAD ** -0.5),
        "pool_scale": 1.0 + nrm(ks[8], (L, C_WIDTH), 0.02),
        "w_gate": nrm(ks[9], (L, D_MODEL, N_BRANCH * D_MODEL), D_MODEL ** -0.5),
        "b_gate": nrm(ks[10], (L, N_BRANCH * D_MODEL), 0.02),
        "w_proj_a": nrm(ks[11], (L, A_WIDTH, D_MODEL), A_WIDTH ** -0.5),
        "w_proj_b": nrm(ks[12], (L, B_WIDTH, D_MODEL), B_WIDTH ** -0.5),
        "w_proj_c": nrm(ks[13], (L, C_WIDTH, D_MODEL), C_WIDTH ** -0.5),
        "w_out": nrm(ks[14], (L, D_MODEL, D_MODEL), BETA * D_MODEL ** -0.5),
        "ln1_g": 1.0 + nrm(ks[15], (L, D_MODEL), 0.02),
        "ln1_b": nrm(ks[16], (L, D_MODEL), 0.02),
        "w_router": nrm(ks[17], (L, D_MODEL, N_EXPERTS), D_MODEL ** -0.5),
        "router_bias": nrm(ks[18], (L, N_EXPERTS), 0.01),
        "w_expert_gate": nrm(ks[19], (L, N_EXPERTS, D_MODEL, EXPERT_HIDDEN), D_MODEL ** -0.5),
        "w_expert_up": nrm(ks[20], (L, N_EXPERTS, D_MODEL, EXPERT_HIDDEN), D_MODEL ** -0.5),
        "w_expert_down": nrm(ks[21], (L, N_EXPERTS, EXPERT_HIDDEN, D_MODEL), BETA * EXPERT_HIDDEN ** -0.5),
        "w_shared_gate": nrm(ks[22], (L, D_MODEL, SHARED_HIDDEN), D_MODEL ** -0.5),
        "w_shared_up": nrm(ks[23], (L, D_MODEL, SHARED_HIDDEN), D_MODEL ** -0.5),
        "w_shared_down": nrm(ks[24], (L, SHARED_HIDDEN, D_MODEL), BETA * SHARED_HIDDEN ** -0.5),
        "ln2_g": 1.0 + nrm(ks[25], (L, D_MODEL), 0.02),
        "ln2_b": nrm(ks[26], (L, D_MODEL), 0.02),
    }


def reference(x, in_ln_g, in_ln_b, w_in, w_spatial, b_spatial, w_conv, w_pool, pool_scale,
              w_gate, b_gate, w_proj_a, w_proj_b, w_proj_c, w_out, ln1_g, ln1_b,
              w_router, router_bias, w_expert_gate, w_expert_up, w_expert_down,
              w_shared_gate, w_shared_up, w_shared_down, ln2_g, ln2_b):
    x = layer_norm(x, in_ln_g, in_ln_b)
    for l in range(DEPTH):
        mix = mixer_block(x, w_in[l], w_spatial[l], b_spatial[l], w_conv[l], w_pool[l],
                          pool_scale[l], w_gate[l], b_gate[l], w_proj_a[l], w_proj_b[l],
                          w_proj_c[l], w_out[l])
        x = layer_norm(ALPHA * x + mix, ln1_g[l], ln1_b[l])
        ffn = moe_block(x, w_router[l], router_bias[l], w_expert_gate[l], w_expert_up[l],
                        w_expert_down[l], w_shared_gate[l], w_shared_up[l], w_shared_down[l])
        x = layer_norm(ALPHA * x + ffn, ln2_g[l], ln2_b[l])
    return x
```

```cpp
#include <hip/hip_runtime.h>
#include <cstdio>
#include <cstdint>

#define LAS __attribute__((address_space(3)))
typedef unsigned short bf16;
typedef short bf16x8 __attribute__((ext_vector_type(8)));
typedef float f32x4 __attribute__((ext_vector_type(4)));
typedef unsigned u32x4 __attribute__((ext_vector_type(4)));
typedef unsigned u32x2 __attribute__((ext_vector_type(2)));

constexpr int T = 8192, D = 2048, NL = 2, INC = 6144, NE = 64, EH = 512;
constexpr float ALPHA = 1.41421356237309515f;
constexpr float LN_EPS = 1e-5f;
constexpr float ROUTED_SCALE = 2.5f;

constexpr size_t MiB = 1ull << 20;
constexpr size_t WS_CTL = 0;
constexpr size_t WS_TOPE = 1 * MiB, WS_TOPPOS = WS_TOPE + 256 * 1024, WS_TOPW = WS_TOPPOS + 256 * 1024;
constexpr size_t WS_LIST = 2 * MiB;
constexpr size_t WS_X = 8 * MiB;
constexpr size_t WS_XB = 72 * MiB;
constexpr size_t WS_PROJ = 104 * MiB;
constexpr size_t WS_GATE = 200 * MiB;
constexpr size_t WS_YABC = 296 * MiB;
constexpr size_t WS_YC = 344 * MiB;
constexpr size_t WS_MERGED = 360 * MiB;
constexpr size_t WS_MF32 = 392 * MiB;
constexpr size_t WS_PRE = 456 * MiB;
constexpr size_t WS_H = 520 * MiB;
constexpr size_t WS_Y = 608 * MiB;
constexpr size_t WS_W = 960 * MiB;
constexpr size_t WS_END = 1876 * MiB;
constexpr int HROWS = 90112;
constexpr int CW_CNT = 1024;

struct Params { const float* in[27]; float* out; unsigned char* ws; int layer; int arg; };

__device__ __forceinline__ float bf2f(unsigned b) { return __uint_as_float(b << 16); }
__device__ __forceinline__ float bflo(unsigned w) { return __uint_as_float(w << 16); }
__device__ __forceinline__ float bfhi(unsigned w) { return __uint_as_float(w & 0xffff0000u); }
__device__ __forceinline__ unsigned f2bf(float f) { unsigned u = __float_as_uint(f); return (u + 0x7fffu + ((u >> 16) & 1u)) >> 16; }
__device__ __forceinline__ unsigned pk2(float lo, float hi) { return f2bf(lo) | (f2bf(hi) << 16); }
__device__ __forceinline__ float wave_sum(float v) {
#pragma unroll
    for (int o = 1; o < 64; o <<= 1) v += __shfl_xor(v, o);
    return v;
}
__device__ __forceinline__ float gelu_exact(float v) { return 0.5f * v * (1.0f + erff(v * 0.70710678118654752f)); }
__device__ __forceinline__ float sigmoidf_(float v) { return 1.0f / (1.0f + __expf(-v)); }

template <int MAP>
__device__ __forceinline__ void ln_finish(float (&v)[32], const float* __restrict__ g, const float* __restrict__ b, float* xout, bf16* xbout, int lane) {
    float s = 0.f;
#pragma unroll
    for (int i = 0; i < 32; ++i) s += v[i];
    const float mean = wave_sum(s) * (1.0f / D);
    float q = 0.f;
#pragma unroll
    for (int i = 0; i < 32; ++i) { v[i] -= mean; q += v[i] * v[i]; }
    const float rstd = 1.0f / sqrtf(wave_sum(q) * (1.0f / D) + LN_EPS);
    if (MAP == 0) {
#pragma unroll
        for (int j = 0; j < 8; ++j) {
            const int c = 4 * (lane + 64 * j);
            const f32x4 gv = *(const f32x4*)(g + c), bv = *(const f32x4*)(b + c);
            f32x4 o; o.x = v[4 * j] * rstd * gv.x + bv.x; o.y = v[4 * j + 1] * rstd * gv.y + bv.y; o.z = v[4 * j + 2] * rstd * gv.z + bv.z; o.w = v[4 * j + 3] * rstd * gv.w + bv.w;
            *(f32x4*)(xout + c) = o;
            if (xbout) { u32x2 w; w.x = pk2(o.x, o.y); w.y = pk2(o.z, o.w); *(u32x2*)(xbout + c) = w; }
        }
    } else {
#pragma unroll
        for (int j = 0; j < 4; ++j) {
            const int c = 8 * (lane + 64 * j);
            const f32x4 g0 = *(const f32x4*)(g + c), g1 = *(const f32x4*)(g + c + 4), b0 = *(const f32x4*)(b + c), b1 = *(const f32x4*)(b + c + 4);
            f32x4 o0, o1;
            o0.x = v[8 * j] * rstd * g0.x + b0.x; o0.y = v[8 * j + 1] * rstd * g0.y + b0.y; o0.z = v[8 * j + 2] * rstd * g0.z + b0.z; o0.w = v[8 * j + 3] * rstd * g0.w + b0.w;
            o1.x = v[8 * j + 4] * rstd * g1.x + b1.x; o1.y = v[8 * j + 5] * rstd * g1.y + b1.y; o1.z = v[8 * j + 6] * rstd * g1.z + b1.z; o1.w = v[8 * j + 7] * rstd * g1.w + b1.w;
            *(f32x4*)(xout + c) = o0; *(f32x4*)(xout + c + 4) = o1;
            if (xbout) { u32x4 w; w.x = pk2(o0.x, o0.y); w.y = pk2(o0.z, o0.w); w.z = pk2(o1.x, o1.y); w.w = pk2(o1.z, o1.w); *(u32x4*)(xbout + c) = w; }
        }
    }
}

__global__ void __launch_bounds__(512) k_entry_ln(Params p) {
    const int lane = threadIdx.x & 63, gw = blockIdx.x * 8 + (threadIdx.x >> 6), ngw = gridDim.x * 8;
    float* X = (float*)(p.ws + WS_X); bf16* XB = (bf16*)(p.ws + WS_XB);
    for (int t = gw; t < T; t += ngw) {
        float v[32]; const float* xr = p.in[0] + (size_t)t * D;
#pragma unroll
        for (int j = 0; j < 8; ++j) { const f32x4 a = *(const f32x4*)(xr + 4 * (lane + 64 * j)); v[4 * j] = a.x; v[4 * j + 1] = a.y; v[4 * j + 2] = a.z; v[4 * j + 3] = a.w; }
        ln_finish<0>(v, p.in[1], p.in[2], X + (size_t)t * D, XB + (size_t)t * D, lane);
    }
}

struct SG { const bf16* A; int lda; const int* rows; int nvalid; int a_off; const float* W; int ldw; int K; };
template <class Epi>
__device__ __forceinline__ void sgemm_tile(const SG& g, int m0, int n0, int out_row0, Epi&& epi, LAS bf16* sA, LAS bf16* sB) {
    const int tid = threadIdx.x, lane = tid & 63, wid = tid >> 6, wm = wid >> 1, wn = wid & 1, fr = lane & 15, fq = lane >> 4;
    f32x4 acc[2][2];
#pragma unroll
    for (int a = 0; a < 2; ++a)
#pragma unroll
        for (int b = 0; b < 2; ++b) acc[a][b] = (f32x4){0.f, 0.f, 0.f, 0.f};
    const int ar = tid >> 2, akseg = (tid & 3) * 8;
    int arow = m0 + ar;
    if (g.rows) arow = (arow < g.nvalid) ? g.rows[arow] : 0; else arow += g.a_off;
    const bf16* ap = g.A + (size_t)arow * g.lda + akseg;
    const int wk = tid >> 4, wns = (tid & 15) * 4;
    const float* wp = g.W + (size_t)wk * g.ldw + n0 + wns;
    for (int k0 = 0; k0 < g.K; k0 += 32) {
        const u32x4 av = *(const u32x4*)(ap + k0);
        const f32x4 wv = *(const f32x4*)(wp + (size_t)k0 * g.ldw);
        *(LAS u32x4*)(sA + ar * 40 + akseg) = av;
        sB[(wns + 0) * 40 + wk] = (bf16)f2bf(wv.x); sB[(wns + 1) * 40 + wk] = (bf16)f2bf(wv.y); sB[(wns + 2) * 40 + wk] = (bf16)f2bf(wv.z); sB[(wns + 3) * 40 + wk] = (bf16)f2bf(wv.w);
        __syncthreads();
#pragma unroll
        for (int mi = 0; mi < 2; ++mi) {
            const bf16x8 a = *(const LAS bf16x8*)(sA + (wm * 32 + mi * 16 + fr) * 40 + fq * 8);
#pragma unroll
            for (int ni = 0; ni < 2; ++ni) {
                const bf16x8 b = *(const LAS bf16x8*)(sB + (wn * 32 + ni * 16 + fr) * 40 + fq * 8);
                acc[mi][ni] = __builtin_amdgcn_mfma_f32_16x16x32_bf16(a, b, acc[mi][ni], 0, 0, 0);
            }
        }
        __syncthreads();
    }
#pragma unroll
    for (int mi = 0; mi < 2; ++mi)
#pragma unroll
        for (int ni = 0; ni < 2; ++ni)
#pragma unroll
            for (int j = 0; j < 4; ++j) epi(out_row0 + wm * 32 + mi * 16 + fq * 4 + j, n0 + wn * 32 + ni * 16 + fr, acc[mi][ni][j]);
}

__global__ void __launch_bounds__(512) k_gemm_in(Params p) {
    __shared__ __attribute__((aligned(16))) bf16 sA[128 * 40]; __shared__ __attribute__((aligned(16))) bf16 sB[64 * 40];
    const int l = p.layer; const int ntn = 2 * INC / 64, ntiles = (T / 128) * ntn;
    bf16* PROJ = (bf16*)(p.ws + WS_PROJ); bf16* GATE = (bf16*)(p.ws + WS_GATE);
    const float* bgate = p.in[10] + (size_t)l * INC;
    for (int u = blockIdx.x; u < ntiles; u += gridDim.x) {
        const int tm = u / ntn, tn = u % ntn; const int n0 = tn * 64;
        SG g; g.A = (const bf16*)(p.ws + WS_XB); g.lda = D; g.rows = nullptr; g.nvalid = 0; g.a_off = 0; g.ldw = INC; g.K = D;
        if (n0 < INC) {
            g.W = p.in[3] + (size_t)l * D * INC;
            sgemm_tile(g, tm * 128, n0, tm * 128, [&](int m, int n, float v) { if (n < 2048) v = gelu_exact(v); PROJ[(size_t)m * INC + n] = (bf16)f2bf(v); }, (LAS bf16*)sA, (LAS bf16*)sB);
        } else {
            g.W = p.in[9] + (size_t)l * D * INC;
            sgemm_tile(g, tm * 128, n0 - INC, tm * 128, [&](int m, int n, float v) { GATE[(size_t)m * INC + n] = (bf16)f2bf(sigmoidf_(v + bgate[n])); }, (LAS bf16*)sA, (LAS bf16*)sB);
        }
    }
}

__device__ __forceinline__ void spatial_unit(const Params& p, int l, int unit, LAS float* vh) {
    const int nb = unit >> 2, g = unit & 3, tid = threadIdx.x, lane = tid & 63, wid = tid >> 6;
    const bf16* PROJ = (const bf16*)(p.ws + WS_PROJ); bf16* YABC = (bf16*)(p.ws + WS_YABC);
    for (int rr = 0; rr < 16; ++rr) {
        const int j = wid * 16 + rr; const size_t t = (size_t)nb * 128 + j;
        const u32x2 raw = *(const u32x2*)(PROJ + t * INC + 1024 + g * 256 + lane * 4);
        float a0 = bflo(raw.x), a1 = bfhi(raw.x), a2 = bflo(raw.y), a3 = bfhi(raw.y);
        const float mean = wave_sum((a0 + a1) + (a2 + a3)) * (1.0f / 256.0f);
        a0 -= mean; a1 -= mean; a2 -= mean; a3 -= mean;
        const float rstd = 1.0f / sqrtf(wave_sum((a0 * a0 + a1 * a1) + (a2 * a2 + a3 * a3)) * (1.0f / 256.0f) + LN_EPS);
        *(LAS f32x4*)(vh + j * 256 + lane * 4) = (f32x4){a0 * rstd, a1 * rstd, a2 * rstd, a3 * rstd};
    }
    __syncthreads();
    const int c = tid & 255, ih = tid >> 8;
    const float* ws = p.in[4] + ((size_t)l * 4 + g) * 128 * 128; const float* bs = p.in[5] + ((size_t)l * 4 + g) * 128;
    const int jmax = ih ? 128 : 64;
    for (int ii = 0; ii < 64; ii += 4) {
        const int i = ih * 64 + ii;
        float a0 = 0.f, a1 = 0.f, a2 = 0.f, a3 = 0.f;
        for (int j = 0; j < jmax; ++j) {
            const float v = vh[j * 256 + c];
            a0 += ws[(i + 0) * 128 + j] * v; a1 += ws[(i + 1) * 128 + j] * v; a2 += ws[(i + 2) * 128 + j] * v; a3 += ws[(i + 3) * 128 + j] * v;
        }
        const float mx[4] = {a0 + bs[i], a1 + bs[i + 1], a2 + bs[i + 2], a3 + bs[i + 3]};
#pragma unroll
        for (int r = 0; r < 4; ++r) {
            const size_t t = (size_t)nb * 128 + i + r;
            const float uu = bf2f(PROJ[t * INC + g * 256 + c]);
            YABC[t * 3072 + g * 256 + c] = (bf16)f2bf(uu * mx[r]);
        }
    }
    __syncthreads();
}
__global__ void __launch_bounds__(512) k_spatial(Params p) {
    extern __shared__ __attribute__((aligned(16))) unsigned char dyn[];
    for (int u = blockIdx.x; u < 256; u += gridDim.x) spatial_unit(p, p.layer, u, (LAS float*)dyn);
}

__device__ __forceinline__ void ld8(const bf16* ptr, float (&f)[8]) {
    const u32x4 w = *(const u32x4*)ptr;
    f[0] = bflo(w.x); f[1] = bfhi(w.x); f[2] = bflo(w.y); f[3] = bfhi(w.y); f[4] = bflo(w.z); f[5] = bfhi(w.z); f[6] = bflo(w.w); f[7] = bfhi(w.w);
}
__device__ __forceinline__ void st8(bf16* ptr, const float (&f)[8]) {
    u32x4 w; w.x = pk2(f[0], f[1]); w.y = pk2(f[2], f[3]); w.z = pk2(f[4], f[5]); w.w = pk2(f[6], f[7]); *(u32x4*)ptr = w;
}
__device__ __forceinline__ void convpool_item(const Params& p, int l, int item) {
    const bf16* PROJ = (const bf16*)(p.ws + WS_PROJ); bf16* YABC = (bf16*)(p.ws + WS_YABC);
    const int which = item >= T * 128; if (which) item -= T * 128;
    const int t = item >> 7, c = (item & 127) * 8;
    if (!which) {
        float bgv[8], cv[8], acc[8];
        ld8(PROJ + (size_t)t * INC + 2048 + c, bgv);
#pragma unroll
        for (int i = 0; i < 8; ++i) acc[i] = 0.f;
#pragma unroll
        for (int d = 0; d < 3; ++d) {
            const int tt = t - 2 + d;
            if (tt >= 0) {
                float cg[8], hh[8]; ld8(PROJ + (size_t)tt * INC + 3072 + c, cg); ld8(PROJ + (size_t)tt * INC + 4096 + c, hh);
                const float* wc = p.in[6] + ((size_t)l * 3 + d) * 1024 + c;
                const f32x4 w0 = *(const f32x4*)wc, w1 = *(const f32x4*)(wc + 4);
                cv[0] = w0.x; cv[1] = w0.y; cv[2] = w0.z; cv[3] = w0.w; cv[4] = w1.x; cv[5] = w1.y; cv[6] = w1.z; cv[7] = w1.w;
#pragma unroll
                for (int i = 0; i < 8; ++i) acc[i] += cv[i] * (cg[i] * hh[i]);
            }
        }
#pragma unroll
        for (int i = 0; i < 8; ++i) acc[i] *= bgv[i];
        st8(YABC + (size_t)t * 3072 + 1024 + c, acc);
    } else {
        const int g = c >> 8, win = 2 << g; const int start = (t + 1 - win) > 0 ? (t + 1 - win) : 0; const float inv = 1.0f / (float)(t + 1 - start);
        float tot[8], cur[8];
#pragma unroll
        for (int i = 0; i < 8; ++i) tot[i] = 0.f;
        for (int s = start; s <= t; ++s) { ld8(PROJ + (size_t)s * INC + 5120 + c, cur);
#pragma unroll
            for (int i = 0; i < 8; ++i) tot[i] += cur[i]; }
#pragma unroll
        for (int i = 0; i < 8; ++i) tot[i] = tot[i] * inv - cur[i];
        st8(YABC + (size_t)t * 3072 + 2048 + c, tot);
    }
}
__global__ void __launch_bounds__(512) k_convpool(Params p) {
    for (int it = blockIdx.x * 512 + threadIdx.x; it < 2 * T * 128; it += gridDim.x * 512) convpool_item(p, p.layer, it);
}

__global__ void __launch_bounds__(512) k_poolgemm(Params p) {
    __shared__ __attribute__((aligned(16))) bf16 sA[128 * 40]; __shared__ __attribute__((aligned(16))) bf16 sB[64 * 40];
    const int l = p.layer; bf16* YC = (bf16*)(p.ws + WS_YC); const float* psc = p.in[8] + (size_t)l * 1024;
    const int ntiles = (T / 128) * 4 * 4;
    for (int u = blockIdx.x; u < ntiles; u += gridDim.x) {
        const int tm = u / 16, g = (u % 16) / 4, tn = u % 4;
        SG s; s.A = (const bf16*)(p.ws + WS_YABC) + 2048 + g * 256; s.lda = 3072; s.rows = nullptr; s.nvalid = 0; s.a_off = 0; s.W = p.in[7] + ((size_t)l * 4 + g) * 256 * 256; s.ldw = 256; s.K = 256;
        sgemm_tile(s, tm * 128, tn * 64, tm * 128, [&](int m, int n, float v) { YC[(size_t)m * 1024 + g * 256 + n] = (bf16)f2bf(v * psc[g * 256 + n]); }, (LAS bf16*)sA, (LAS bf16*)sB);
    }
}

__global__ void __launch_bounds__(512) k_proj(Params p) {
    __shared__ __attribute__((aligned(16))) bf16 sA[128 * 40]; __shared__ __attribute__((aligned(16))) bf16 sB[64 * 40];
    const int l = p.layer, br = p.arg; const bf16* GATE = (const bf16*)(p.ws + WS_GATE); float* MF = (float*)(p.ws + WS_MF32); bf16* MG = (bf16*)(p.ws + WS_MERGED);
    const int ntiles = (T / 128) * (D / 64);
    for (int u = blockIdx.x; u < ntiles; u += gridDim.x) {
        const int tm = u / (D / 64), tn = u % (D / 64);
        SG s; s.rows = nullptr; s.nvalid = 0; s.a_off = 0; s.ldw = D; s.K = 1024;
        if (br < 2) { s.A = (const bf16*)(p.ws + WS_YABC) + br * 1024; s.lda = 3072; } else { s.A = (const bf16*)(p.ws + WS_YC); s.lda = 1024; }
        s.W = p.in[11 + br] + (size_t)l * 1024 * D;
        sgemm_tile(s, tm * 128, tn * 64, tm * 128, [&](int m, int n, float v) {
            const float gt = bf2f(GATE[(size_t)m * INC + br * D + n]); const size_t o = (size_t)m * D + n;
            float r = gt * v; if (br > 0) r += MF[o];
            if (br < 2) MF[o] = r; else MG[o] = (bf16)f2bf(r); }, (LAS bf16*)sA, (LAS bf16*)sB);
    }
}

__global__ void __launch_bounds__(512) k_wout(Params p) {
    __shared__ __attribute__((aligned(16))) bf16 sA[128 * 40]; __shared__ __attribute__((aligned(16))) bf16 sB[64 * 40];
    const int l = p.layer; const float* X = (const float*)(p.ws + WS_X); float* PRE = (float*)(p.ws + WS_PRE);
    const int ntiles = (T / 128) * (D / 64);
    for (int u = blockIdx.x; u < ntiles; u += gridDim.x) {
        const int tm = u / (D / 64), tn = u % (D / 64);
        SG s; s.A = (const bf16*)(p.ws + WS_MERGED); s.lda = D; s.rows = nullptr; s.nvalid = 0; s.a_off = 0; s.W = p.in[14] + (size_t)l * D * D; s.ldw = D; s.K = D;
        sgemm_tile(s, tm * 128, tn * 64, tm * 128, [&](int m, int n, float v) { const size_t o = (size_t)m * D + n; PRE[o] = ALPHA * X[o] + v; }, (LAS bf16*)sA, (LAS bf16*)sB);
    }
}

constexpr int P5_LDS = 32 * 260 * 4 + 32 * 64 * 4 + 32 * 8 * 4 * 3 + 64 * 4 * 2;
__device__ __forceinline__ void ln1_router_unit(const Params& p, int l, int unit, LAS unsigned char* lds) {
    LAS float* xs = (LAS float*)lds; LAS float* lg = xs + 32 * 260; LAS float* gs = lg + 32 * 64; LAS int* le = (LAS int*)(gs + 32 * 8); LAS float* lw = (LAS float*)(le + 32 * 8);
    LAS int* cnt = (LAS int*)(lw + 32 * 8); LAS int* base = cnt + 64;
    const int tid = threadIdx.x, lane = tid & 63, wid = tid >> 6; const int t0 = unit * 32;
    const float* PRE = (const float*)(p.ws + WS_PRE); float* X = (float*)(p.ws + WS_X); bf16* XB = (bf16*)(p.ws + WS_XB);
    for (int r = 0; r < 4; ++r) {
        const int t = t0 + wid * 4 + r; float v[32]; const float* xr = PRE + (size_t)t * D;
#pragma unroll
        for (int j = 0; j < 8; ++j) { const f32x4 a = *(const f32x4*)(xr + 4 * (lane + 64 * j)); v[4 * j] = a.x; v[4 * j + 1] = a.y; v[4 * j + 2] = a.z; v[4 * j + 3] = a.w; }
        ln_finish<0>(v, p.in[15] + (size_t)l * D, p.in[16] + (size_t)l * D, X + (size_t)t * D, XB + (size_t)t * D, lane);
    }
    if (tid < 64) cnt[tid] = 0;
    __threadfence_block();
    __syncthreads();
    const float* wr = p.in[17] + (size_t)l * D * NE;
    float a0 = 0.f, a1 = 0.f, a2 = 0.f, a3 = 0.f;
    for (int kc = 0; kc < D; kc += 256) {
#pragma unroll
        for (int i = 0; i < 4; ++i) { const int pc = tid + 512 * i, rr = pc >> 6, cc = (pc & 63) * 4; *(LAS f32x4*)(xs + rr * 260 + cc) = *(const f32x4*)(X + (size_t)(t0 + rr) * D + kc + cc); }
        __syncthreads();
        const LAS float* x0 = xs + (wid * 4) * 260;
        for (int k = 0; k < 256; k += 4) {
            const f32x4 xa = *(const LAS f32x4*)(x0 + k), xb = *(const LAS f32x4*)(x0 + 260 + k), xc = *(const LAS f32x4*)(x0 + 520 + k), xd = *(const LAS f32x4*)(x0 + 780 + k);
            const float w0 = wr[(size_t)(kc + k) * NE + lane], w1 = wr[(size_t)(kc + k + 1) * NE + lane], w2 = wr[(size_t)(kc + k + 2) * NE + lane], w3 = wr[(size_t)(kc + k + 3) * NE + lane];
            a0 += xa.x * w0; a0 += xa.y * w1; a0 += xa.z * w2; a0 += xa.w * w3;
            a1 += xb.x * w0; a1 += xb.y * w1; a1 += xb.z * w2; a1 += xb.w * w3;
            a2 += xc.x * w0; a2 += xc.y * w1; a2 += xc.z * w2; a2 += xc.w * w3;
            a3 += xd.x * w0; a3 += xd.y * w1; a3 += xd.z * w2; a3 += xd.w * w3;
        }
        __syncthreads();
    }
    lg[(wid * 4 + 0) * 64 + lane] = sigmoidf_(a0); lg[(wid * 4 + 1) * 64 + lane] = sigmoidf_(a1); lg[(wid * 4 + 2) * 64 + lane] = sigmoidf_(a2); lg[(wid * 4 + 3) * 64 + lane] = sigmoidf_(a3);
    __syncthreads();
    const float* rb = p.in[18] + (size_t)l * NE;
    if (tid < 32) {
        const LAS float* sc = lg + tid * 64;
        for (int g = 0; g < 8; ++g) { float m1 = -INFINITY, m2 = -INFINITY;
            for (int j = 0; j < 8; ++j) { const float s = sc[g * 8 + j] + rb[g * 8 + j]; if (s > m1) { m2 = m1; m1 = s; } else if (s > m2) m2 = s; }
            gs[tid * 8 + g] = m1 + m2; }
        unsigned gmask = 0;
        for (int it = 0; it < 4; ++it) { float best = -INFINITY; int bi = 0;
            for (int g = 0; g < 8; ++g) { const float s = gs[tid * 8 + g]; if (!((gmask >> g) & 1u) && s > best) { best = s; bi = g; } }
            gmask |= 1u << bi; }
        unsigned long long chosen = 0ull; float wsum = 0.f;
        for (int it = 0; it < 8; ++it) { float best = -INFINITY; int bi = -1;
            for (int e = 0; e < 64; ++e) { if (!((gmask >> (e >> 3)) & 1u) || ((chosen >> e) & 1ull)) continue; const float s = sc[e] + rb[e]; if (bi < 0 || s > best) { best = s; bi = e; } }
            chosen |= 1ull << bi; const float w = sc[bi]; wsum += w; le[tid * 8 + it] = bi; lw[tid * 8 + it] = w; }
        const float scale = ROUTED_SCALE / wsum;
        for (int it = 0; it < 8; ++it) { lw[tid * 8 + it] *= scale; }
    }
    __syncthreads();
    int myrank = 0, mye = 0;
    if (tid < 256) { mye = le[tid]; myrank = atomicAdd((int*)&cnt[mye], 1); }
    __syncthreads();
    if (tid < 64) { const int c = cnt[tid]; base[tid] = c ? (int)atomicAdd((unsigned*)(p.ws + WS_CTL) + CW_CNT + 64 * l + tid, (unsigned)c) : 0; }
    __syncthreads();
    if (tid < 256) {
        const int t = t0 + (tid >> 3), s = tid & 7, pos = base[mye] + myrank;
        ((int*)(p.ws + WS_TOPE))[t * 8 + s] = mye; ((int*)(p.ws + WS_TOPPOS))[t * 8 + s] = pos; ((float*)(p.ws + WS_TOPW))[t * 8 + s] = lw[tid];
        ((int*)(p.ws + WS_LIST))[((size_t)l * 64 + mye) * 8192 + pos] = t;
    }
    __syncthreads();
}
__global__ void __launch_bounds__(512) k_ln1_router(Params p) {
    __shared__ __attribute__((aligned(16))) unsigned char lds[P5_LDS];
    for (int u = blockIdx.x; u < T / 32; u += gridDim.x) ln1_router_unit(p, p.layer, u, (LAS unsigned char*)lds);
}

struct MoeTab { int cnt[65]; int rb[66]; int tp[66]; int tq[66]; };
__device__ __forceinline__ void moe_tables(const Params& p, int l, LAS MoeTab* tb) {
    if (threadIdx.x == 0) {
        const unsigned* c = (const unsigned*)(p.ws + WS_CTL) + CW_CNT + 64 * l; int rb = 0, tp = 0, tq = 0;
        for (int e = 0; e < 65; ++e) { const int n = (e < 64) ? (int)__hip_atomic_load(c + e, __ATOMIC_RELAXED, __HIP_MEMORY_SCOPE_AGENT) : T;
            tb->cnt[e] = n; tb->rb[e] = rb; tb->tp[e] = tp; tb->tq[e] = tq; rb += ((n + 255) >> 8) << 8; tp += (n + 127) >> 7; tq += (n + 255) >> 8; }
        tb->rb[65] = rb; tb->tp[65] = tp; tb->tq[65] = tq;
    }
    __syncthreads();
}

__global__ void __launch_bounds__(512) k_moe_gateup(Params p) {
    __shared__ __attribute__((aligned(16))) bf16 sA[128 * 40]; __shared__ __attribute__((aligned(16))) bf16 sB[64 * 40]; __shared__ MoeTab tb;
    const int l = p.layer, which = p.arg; moe_tables(p, l, (LAS MoeTab*)&tb);
    float* HS = (float*)(p.ws + WS_W); bf16* H = (bf16*)(p.ws + WS_H);
    const int nunits = tb.tp[65] * (EH / 64);
    for (int u = blockIdx.x; u < nunits; u += gridDim.x) {
        const int mt = u / (EH / 64), tn = u % (EH / 64); int e = 0; while (tb.tp[e + 1] <= mt) ++e;
        const int m0 = (mt - tb.tp[e]) * 128;
        SG s; s.A = (const bf16*)(p.ws + WS_XB); s.lda = D; s.rows = (e < 64) ? (const int*)(p.ws + WS_LIST) + ((size_t)l * 64 + e) * 8192 : nullptr; s.nvalid = tb.cnt[e]; s.a_off = 0; s.ldw = EH; s.K = D;
        if (e < 64) s.W = p.in[which ? 20 : 19] + ((size_t)l * 64 + e) * D * EH; else s.W = p.in[which ? 23 : 22] + (size_t)l * D * EH;
        if (!which) sgemm_tile(s, m0, tn * 64, tb.rb[e] + m0, [&](int m, int n, float v) { HS[(size_t)m * EH + n] = v / (1.0f + __expf(-v)); }, (LAS bf16*)sA, (LAS bf16*)sB);
        else sgemm_tile(s, m0, tn * 64, tb.rb[e] + m0, [&](int m, int n, float v) { H[(size_t)m * EH + n] = (bf16)f2bf(HS[(size_t)m * EH + n] * v); }, (LAS bf16*)sA, (LAS bf16*)sB);
    }
}
__global__ void __launch_bounds__(512) k_moe_down(Params p) {
    __shared__ __attribute__((aligned(16))) bf16 sA[128 * 40]; __shared__ __attribute__((aligned(16))) bf16 sB[64 * 40]; __shared__ MoeTab tb;
    const int l = p.layer; moe_tables(p, l, (LAS MoeTab*)&tb);
    bf16* Y = (bf16*)(p.ws + WS_Y);
    const int nunits = tb.tp[65] * (D / 64);
    for (int u = blockIdx.x; u < nunits; u += gridDim.x) {
        const int mt = u / (D / 64), tn = u % (D / 64); int e = 0; while (tb.tp[e + 1] <= mt) ++e;
        const int m0 = (mt - tb.tp[e]) * 128;
        SG s; s.A = (const bf16*)(p.ws + WS_H); s.lda = EH; s.rows = nullptr; s.nvalid = 0; s.a_off = tb.rb[e]; s.ldw = D; s.K = EH;
        s.W = (e < 64) ? p.in[21] + ((size_t)l * 64 + e) * EH * D : p.in[24] + (size_t)l * EH * D;
        sgemm_tile(s, m0, tn * 64, tb.rb[e] + m0, [&](int m, int n, float v) { Y[(size_t)m * D + n] = (bf16)f2bf(v); }, (LAS bf16*)sA, (LAS bf16*)sB);
    }
}
__device__ __forceinline__ void combine_ln2_row(const Params& p, int l, int t, const LAS MoeTab* tb, int lane, bool last) {
    const bf16* Y = (const bf16*)(p.ws + WS_Y); float* X = (float*)(p.ws + WS_X); bf16* XB = (bf16*)(p.ws + WS_XB);
    float v[32];
    const float* xr = X + (size_t)t * D;
#pragma unroll
    for (int j = 0; j < 4; ++j) { const int c = 8 * (lane + 64 * j); const f32x4 a = *(const f32x4*)(xr + c), b = *(const f32x4*)(xr + c + 4);
        v[8 * j] = ALPHA * a.x; v[8 * j + 1] = ALPHA * a.y; v[8 * j + 2] = ALPHA * a.z; v[8 * j + 3] = ALPHA * a.w; v[8 * j + 4] = ALPHA * b.x; v[8 * j + 5] = ALPHA * b.y; v[8 * j + 6] = ALPHA * b.z; v[8 * j + 7] = ALPHA * b.w; }
    for (int s = 0; s < 9; ++s) {
        int row; float w;
        if (s < 8) { const int e = ((const int*)(p.ws + WS_TOPE))[t * 8 + s]; row = tb->rb[e] + ((const int*)(p.ws + WS_TOPPOS))[t * 8 + s]; w = ((const float*)(p.ws + WS_TOPW))[t * 8 + s]; }
        else { row = tb->rb[64] + t; w = 1.0f; }
        const bf16* yr = Y + (size_t)row * D;
#pragma unroll
        for (int j = 0; j < 4; ++j) { float f[8]; ld8(yr + 8 * (lane + 64 * j), f);
#pragma unroll
            for (int i = 0; i < 8; ++i) v[8 * j + i] += w * f[i]; }
    }
    float* xo = last ? p.out + (size_t)t * D : X + (size_t)t * D;
    ln_finish<1>(v, p.in[25] + (size_t)l * D, p.in[26] + (size_t)l * D, xo, last ? nullptr : XB + (size_t)t * D, lane);
}
__global__ void __launch_bounds__(512) k_combine_ln2(Params p) {
    __shared__ MoeTab tb; moe_tables(p, p.layer, (LAS MoeTab*)&tb);
    const int lane = threadIdx.x & 63, gw = blockIdx.x * 8 + (threadIdx.x >> 6), ngw = gridDim.x * 8;
    for (int t = gw; t < T; t += ngw) combine_ln2_row(p, p.layer, t, (const LAS MoeTab*)&tb, lane, p.layer == NL - 1);
}

extern "C" void kernel_launch(void* const* d_in, const int* in_sizes, int n_in, void* d_out, int out_size, void* d_ws, size_t ws_size, hipStream_t stream) {
    static int ok = 0;
    if (ok == 0) {
        if (n_in != 27 || out_size != T * D || ws_size < WS_END) { fprintf(stderr, "kernel_launch: unexpected shapes (n_in %d out %d ws %zu)\n", n_in, out_size, ws_size); ok = -1; return; }
        if (hipFuncSetAttribute((const void*)k_spatial, hipFuncAttributeMaxDynamicSharedMemorySize, 128 * 1024) != hipSuccess) { fprintf(stderr, "hipFuncSetAttribute failed\n"); ok = -1; return; }
        ok = 1;
    }
    if (ok < 0) return;
    hipMemsetAsync((char*)d_ws + WS_CTL, 0, 1 * MiB, stream);
    Params p{};
    for (int i = 0; i < 27; ++i) p.in[i] = (const float*)d_in[i];
    p.out = (float*)d_out; p.ws = (unsigned char*)d_ws; p.layer = 0; p.arg = 0;
    const int G = 1024;
    hipLaunchKernelGGL(k_entry_ln, dim3(G), dim3(512), 0, stream, p);
    for (int l = 0; l < NL; ++l) {
        p.layer = l; p.arg = 0;
        hipLaunchKernelGGL(k_gemm_in, dim3(2048), dim3(512), 0, stream, p);
        hipLaunchKernelGGL(k_spatial, dim3(256), dim3(512), 128 * 1024, stream, p);
        hipLaunchKernelGGL(k_convpool, dim3(2048), dim3(512), 0, stream, p);
        hipLaunchKernelGGL(k_poolgemm, dim3(1024), dim3(512), 0, stream, p);
        for (int b = 0; b < 3; ++b) { p.arg = b; hipLaunchKernelGGL(k_proj, dim3(2048), dim3(512), 0, stream, p); }
        p.arg = 0;
        hipLaunchKernelGGL(k_wout, dim3(2048), dim3(512), 0, stream, p);
        hipLaunchKernelGGL(k_ln1_router, dim3(256), dim3(512), 0, stream, p);
        p.arg = 0; hipLaunchKernelGGL(k_moe_gateup, dim3(2048), dim3(512), 0, stream, p);
        p.arg = 1; hipLaunchKernelGGL(k_moe_gateup, dim3(2048), dim3(512), 0, stream, p);
        p.arg = 0;
        hipLaunchKernelGGL(k_moe_down, dim3(2048), dim3(512), 0, stream, p);
        hipLaunchKernelGGL(k_combine_ln2, dim3(G), dim3(512), 0, stream, p);
    }
}
```

```cpp
#include <hip/hip_runtime.h>
#include <cstdio>
#include <cstdint>

#ifndef MK_N_LAUNCHES
#define MK_N_LAUNCHES 1
#endif

#define LAS __attribute__((address_space(3)))
typedef unsigned short bf16;
typedef short bf16x8 __attribute__((ext_vector_type(8)));
typedef float f32x4 __attribute__((ext_vector_type(4)));
typedef float f32x2 __attribute__((ext_vector_type(2)));
typedef unsigned u32x4 __attribute__((ext_vector_type(4)));
typedef unsigned u32x2 __attribute__((ext_vector_type(2)));

constexpr int T = 8192, D = 2048, NL = 2, INC = 6144, NE = 64, EH = 512;
constexpr float ALPHA = 1.41421356237309515f;
constexpr float LN_EPS = 1e-5f;
constexpr float ROUTED_SCALE = 2.5f;
constexpr int NPHASES = 1 + 8 * NL;

constexpr size_t MiB = 1ull << 20;
constexpr size_t WS_CTL = 0;
constexpr size_t WS_TOPE = 1 * MiB, WS_TOPPOS = WS_TOPE + 256 * 1024, WS_TOPW = WS_TOPPOS + 256 * 1024;
constexpr size_t WS_LIST = 2 * MiB;
constexpr size_t WS_X = 8 * MiB;
constexpr size_t WS_XB = 72 * MiB;
constexpr size_t WS_PROJ = 104 * MiB;
constexpr size_t WS_GATE = 200 * MiB;
constexpr size_t WS_YABC = 296 * MiB;
constexpr size_t WS_MERGED = 360 * MiB;
constexpr size_t WS_MF32 = 392 * MiB;
constexpr size_t WS_PRE = 456 * MiB;
constexpr size_t WS_H = 520 * MiB;
constexpr size_t WS_Y = 608 * MiB;
constexpr size_t WS_W = 960 * MiB;
constexpr int HROWS = 90112;
constexpr size_t WL_IG = 0;
constexpr size_t WL_ABC = 48 * MiB;
constexpr size_t WL_O = 60 * MiB;
constexpr size_t WL_GU = 68 * MiB;
constexpr size_t WL_D = 328 * MiB;
constexpr size_t WL_BYTES = 458 * MiB;
constexpr size_t WS_END = WS_W + 2 * WL_BYTES;
constexpr int CW_CNT = 1024;
constexpr int CW_BAR = 4096;
constexpr int LDS_BYTES = 147456;
constexpr int LDSCTL_OFF = 143360;
constexpr int MISC_OFF = LDSCTL_OFF + 2048;

struct Params { const float* in[27]; float* out; unsigned char* ws; int ph_lo, ph_hi; };

__device__ __forceinline__ float bf2f(unsigned b) { return __uint_as_float(b << 16); }
__device__ __forceinline__ float bflo(unsigned w) { return __uint_as_float(w << 16); }
__device__ __forceinline__ float bfhi(unsigned w) { return __uint_as_float(w & 0xffff0000u); }
__device__ __forceinline__ unsigned f2bf(float f) { unsigned u = __float_as_uint(f); return (u + 0x7fffu + ((u >> 16) & 1u)) >> 16; }
__device__ __forceinline__ unsigned pk2(float lo, float hi) { return f2bf(lo) | (f2bf(hi) << 16); }
__device__ __forceinline__ unsigned cvt_pk_bf16(float lo, float hi) { unsigned r; asm volatile("v_cvt_pk_bf16_f32 %0, %1, %2" : "=v"(r) : "v"(lo), "v"(hi)); return r; }
__device__ __forceinline__ float wave_sum(float v) {
#pragma unroll
    for (int o = 1; o < 64; o <<= 1) v += __shfl_xor(v, o);
    return v;
}
__device__ __forceinline__ int ltid() { int t = threadIdx.x; asm volatile("" : "+v"(t)); return t; }
__device__ __forceinline__ float sigmoidf_(float v) { return 1.0f / (1.0f + __expf(-v)); }
__device__ __forceinline__ float fast_sigmoid(float v) { return __builtin_amdgcn_rcpf(1.0f + __builtin_amdgcn_exp2f(v * -1.44269504089f)); }
__device__ __forceinline__ f32x2 gelu_pk(f32x2 v) {
    const f32x2 av = __builtin_elementwise_abs(v), d = av * 0.2316418882f + 1.0f;
    f32x2 t; t.x = __builtin_amdgcn_rcpf(d.x); t.y = __builtin_amdgcn_rcpf(d.y);
    f32x2 q = t * 0.5307027145f + (-0.7265760135f); q = q * t + 0.7107068705f; q = q * t + (-0.142248368f); q = q * t + 0.127414796f; q = q * t;
    const f32x2 s = (v * v) * (-0.72134752044f);
    f32x2 e; e.x = __builtin_amdgcn_exp2f(s.x); e.y = __builtin_amdgcn_exp2f(s.y);
    const f32x2 m = v * (q * e), r = v - m;
    f32x2 o; o.x = v.x < 0.f ? m.x : r.x; o.y = v.y < 0.f ? m.y : r.y; return o;
}

struct MoeTab { int cnt[65]; int rb[66]; int tq[66]; int pad[3]; };
__device__ __forceinline__ void moe_tables(const Params& p, int l, LAS MoeTab* tb, int tid) {
    __syncthreads();
    if (tid < 65) tb->cnt[tid] = (tid < 64) ? (int)__hip_atomic_load((unsigned*)(p.ws + WS_CTL) + CW_CNT + 64 * l + tid, __ATOMIC_RELAXED, __HIP_MEMORY_SCOPE_AGENT) : T;
    __syncthreads();
    if (tid == 0) { int rb = 0, tq = 0;
        for (int e = 0; e < 65; ++e) { const int n = tb->cnt[e]; tb->rb[e] = rb; tb->tq[e] = tq; rb += ((n + 255) >> 8) << 8; tq += (n + 255) >> 8; }
        tb->rb[65] = rb; tb->tq[65] = tq; }
    __syncthreads();
}

namespace pg8 {
constexpr int BM = 256, BK = 64, HALF = 128, HTB = HALF * BK * 2, STAGE_BYTES = 8 * HTB, NXCD = 8, WGM = 8;
__device__ __forceinline__ int lds_byte(int r, int c) { const int st = (r >> 4) * 2 + (c >> 5), rr = r & 15, cc = c & 31, ob = rr * 64 + cc * 2; return st * 1024 + (ob ^ (((ob >> 9) & 1) << 5)); }
__device__ __forceinline__ void stage_rc(int b, int& R, int& C) { const int st = b / 1024, sb = b % 1024, swz = sb ^ (((sb >> 9) & 1) << 5); R = (st >> 1) * 16 + swz / 64; C = (st & 1) * 32 + (swz % 64) / 2; }
__device__ __forceinline__ int perm32(int rho) { const int n = rho >> 4, i = rho & 15; return 8 * (i >> 2) + 4 * n + (i & 3); }

struct Unit { const char* A; const char* B; int orow, pn, seg, e, m0; };

__device__ __forceinline__ void tile_of(int L, int nM, int nN, int& pm, int& pn) {
    const int nwg = nM * nN; int wgid = L; { const int q = nwg / NXCD, r = nwg % NXCD, xcd = wgid % NXCD, off = wgid / NXCD; wgid = (xcd < r ? xcd * (q + 1) : r * (q + 1) + (xcd - r) * q) + off; }
    const int nig = WGM * nN, gid = wgid / nig, fm = gid * WGM, gsz = (nM - fm) < WGM ? (nM - fm) : WGM;
    pm = fm + ((wgid % nig) % gsz); pn = (wgid % nig) / gsz;
}
struct DenseSched {
    const char* A; const char* B; size_t atile, btile; int nM, nN, G, c;
    __device__ __forceinline__ bool next(int i, Unit& u) const {
        const int L = i * G + c; if (L >= nM * nN) return false;
        int pm, pn; tile_of(L, nM, nN, pm, pn);
        u.A = A + (size_t)pm * atile; u.B = B + (size_t)pn * btile; u.orow = pm * BM; u.pn = pn; u.seg = 0; u.e = 0; u.m0 = 0; return true; }
    __device__ __forceinline__ int row(const Unit&, int) const { return 0; }
};
struct ProjSched {
    const char* A; const char* B; int G, c;
    __device__ __forceinline__ bool next(int i, Unit& u) const {
        const int L = (i / 3) * G + c; if (L >= 32 * 8) return false;
        int pm, pn; tile_of(L, 32, 8, pm, pn); const int seg = i % 3;
        u.A = A + ((size_t)pm * BM * 3072 + (size_t)seg * 1024) * 2; u.B = B + ((size_t)seg * 2048 * 1024 + (size_t)pn * BM * 1024) * 2; u.orow = pm * BM; u.pn = pn; u.seg = seg; u.e = 0; u.m0 = 0; return true; }
    __device__ __forceinline__ int row(const Unit&, int) const { return 0; }
};
template <int NT, bool GATH> struct MoeSched {
    const LAS MoeTab* tb; const char* A; const char* B; size_t bexp, btile; const int* list; int G, vcu;
    __device__ __forceinline__ bool next(int i, Unit& u) const {
        const int L = i * G + vcu; if (L >= tb->tq[65] * NT) return false;
        const int mt = L / NT, pn = L % NT; int e = 0; while (tb->tq[e + 1] <= mt) ++e;
        const int m0 = (mt - tb->tq[e]) * BM;
        u.e = e; u.m0 = m0; u.orow = tb->rb[e] + m0; u.pn = pn; u.seg = 0;
        u.B = B + (size_t)e * bexp + (size_t)pn * btile;
        u.A = GATH ? A : A + (size_t)u.orow * EH * 2; return true; }
    __device__ __forceinline__ int row(const Unit& u, int r) const { const int idx = u.m0 + r; if (u.e == 64) return idx; return idx < tb->cnt[u.e] ? list[u.e * 8192 + idx] : 0; }
};

template <class Epi, class Sched, bool GATHER>
__device__ __forceinline__ void gemm_phase(LAS unsigned char* lds, const int K, const int lda, const int ldb, const Sched& S, const Epi& E) {
    const int tid = ltid(), wid = __builtin_amdgcn_readfirstlane(tid >> 6), lane = tid & 63, wr = wid >> 2, wc = wid & 3, fr = lane & 15, fq = lane >> 4;
    const int nt = K / BK;
    unsigned voffB[2], voffA[2][2], voffN[2][2]; int Rr[2], Cc[2];
#pragma unroll
    for (int i = 0; i < 2; ++i) { int R, C; stage_rc(tid * 16 + i * 8192, R, C); const int Rb = (R & ~31) + perm32(R & 31);
        Rr[i] = R; Cc[i] = C; voffB[i] = (unsigned)(Rb * ldb + C) * 2u;
        voffA[0][i] = (unsigned)(R * lda + C) * 2u; voffA[1][i] = (unsigned)((R + HALF) * lda + C) * 2u; voffN[0][i] = voffA[0][i]; voffN[1][i] = voffA[1][i]; }
    const size_t kstep = (size_t)(BK * 2);
    const size_t hstepB = (size_t)HALF * ldb * 2;
    const unsigned ldsw = (unsigned)wid * 1024u;
    const int aoff = lds_byte(wr * 64 + fr, fq * 8), boff = lds_byte(wc * 32 + fr, fq * 8);
#define PG8_SA(b, h) (((b) * 2 + (h)) * HTB)
#define PG8_SB(b, h) ((4 + (b) * 2 + (h)) * HTB)
#define PG8_STAGE_B(bufoff, gbase) do { _Pragma("unroll") for (int _i = 0; _i < 2; ++_i) \
        __builtin_amdgcn_global_load_lds((const unsigned*)((const char*)(gbase) + voffB[_i]), (LAS unsigned*)(lds + (bufoff) + ldsw + _i * 8192), 16, 0, 0); } while (0)
#define PG8_STAGE_A(bufoff, gbase, VO, h) do { _Pragma("unroll") for (int _i = 0; _i < 2; ++_i) \
        __builtin_amdgcn_global_load_lds((const unsigned*)((const char*)(gbase) + (VO)[h][_i]), (LAS unsigned*)(lds + (bufoff) + ldsw + _i * 8192), 16, 0, 0); } while (0)
#define PG8_LDA(dst, b, h) do { _Pragma("unroll") for (int m = 0; m < 4; ++m) _Pragma("unroll") for (int k = 0; k < 2; ++k) dst[m][k] = *(const LAS bf16x8*)(lds + PG8_SA(b, h) + aoff + m * 2048 + k * 1024); } while (0)
#define PG8_LDB(dst, b, h) do { _Pragma("unroll") for (int n = 0; n < 2; ++n) _Pragma("unroll") for (int k = 0; k < 2; ++k) dst[n][k] = *(const LAS bf16x8*)(lds + PG8_SB(b, h) + boff + n * 2048 + k * 1024); } while (0)
#define PG8_MMA(ai, bj, At, Bt) do { __builtin_amdgcn_s_setprio(1); _Pragma("unroll") for (int m = 0; m < 4; ++m) _Pragma("unroll") for (int n = 0; n < 2; ++n) _Pragma("unroll") for (int k = 0; k < 2; ++k) \
        acc[ai][bj][m][n] = __builtin_amdgcn_mfma_f32_16x16x32_bf16(Bt[n][k], At[m][k], acc[ai][bj][m][n], 0, 0, 0); __builtin_amdgcn_s_setprio(0); } while (0)
#define PG8_WAIT_V(n) asm volatile("s_waitcnt vmcnt(" #n ")" ::: "memory")
#define PG8_WAIT_L(n) asm volatile("s_waitcnt lgkmcnt(" #n ")" ::: "memory")
#define PG8_BAR __builtin_amdgcn_s_barrier()
#define PG8_SCHED __builtin_amdgcn_sched_barrier(0)
    Unit cur, nxt; int ui = 0;
    if (!S.next(0, cur)) return;
    if constexpr (GATHER) {
#pragma unroll
        for (int h = 0; h < 2; ++h)
#pragma unroll
            for (int i = 0; i < 2; ++i) voffA[h][i] = (unsigned)(S.row(cur, Rr[i] + h * HALF) * lda + Cc[i]) * 2u;
    }
    f32x4 acc[2][2][4][2];
#pragma unroll
    for (int a = 0; a < 2; ++a)
#pragma unroll
        for (int b = 0; b < 2; ++b)
#pragma unroll
            for (int m = 0; m < 4; ++m)
#pragma unroll
                for (int n = 0; n < 2; ++n) acc[a][b][m][n] = (f32x4){0.f, 0.f, 0.f, 0.f};
    bf16x8 At[4][2], B0[2][2], B1[2][2];
    const char* cA = cur.A; const char* cB = cur.B;
    PG8_STAGE_B(PG8_SB(0, 0), cB); PG8_STAGE_B(PG8_SB(0, 1), cB + hstepB); PG8_STAGE_A(PG8_SA(0, 0), cA, voffA, 0); PG8_STAGE_A(PG8_SA(0, 1), cA, voffA, 1);
    if (wr == 1) PG8_BAR;
    PG8_WAIT_V(2); PG8_BAR;
    PG8_STAGE_B(PG8_SB(1, 0), cB + kstep); PG8_STAGE_A(PG8_SA(1, 0), cA + kstep, voffA, 0); PG8_STAGE_B(PG8_SB(1, 1), cB + hstepB + kstep);
    PG8_WAIT_V(6); PG8_BAR;
    for (;;) {
        const bool has_next = S.next(ui + 1, nxt);
        if constexpr (GATHER) {
            if (has_next) {
#pragma unroll
                for (int h = 0; h < 2; ++h)
#pragma unroll
                    for (int i = 0; i < 2; ++i) voffN[h][i] = (unsigned)(S.row(nxt, Rr[i] + h * HALF) * lda + Cc[i]) * 2u;
            } else {
#pragma unroll
                for (int h = 0; h < 2; ++h)
#pragma unroll
                    for (int i = 0; i < 2; ++i) voffN[h][i] = voffA[h][i];
            }
        }
        const char* nA = has_next ? nxt.A : cA; const char* nB = has_next ? nxt.B : cB;
        for (int t = 0; t < nt; t += 2) {
            const bool last = (t == nt - 2);
            const char* a1 = cA + (size_t)(t + 1) * kstep;
            const char* a2 = last ? nA : cA + (size_t)(t + 2) * kstep; const char* b2 = last ? nB : cB + (size_t)(t + 2) * kstep;
            const char* a3 = a2 + kstep; const char* b3 = b2 + kstep;
            unsigned vo2[2][2];
#pragma unroll
            for (int h = 0; h < 2; ++h)
#pragma unroll
                for (int i = 0; i < 2; ++i) vo2[h][i] = (GATHER && last) ? voffN[h][i] : voffA[h][i];
            PG8_LDB(B0, 0, 0); PG8_LDB(B1, 0, 1); PG8_SCHED; PG8_LDA(At, 0, 0); PG8_STAGE_A(PG8_SA(1, 1), a1, voffA, 1);
            PG8_WAIT_V(8); PG8_WAIT_L(0); PG8_BAR; PG8_MMA(0, 0, At, B0); PG8_MMA(0, 1, At, B1); PG8_BAR; PG8_SCHED;
            PG8_LDA(At, 0, 1); PG8_STAGE_B(PG8_SB(0, 0), b2); PG8_STAGE_B(PG8_SB(0, 1), b2 + hstepB); PG8_STAGE_A(PG8_SA(0, 0), a2, vo2, 0);
            PG8_WAIT_V(8); PG8_WAIT_L(0); PG8_BAR; PG8_MMA(1, 0, At, B0); PG8_MMA(1, 1, At, B1); PG8_BAR; PG8_SCHED;
            PG8_LDB(B0, 1, 0); PG8_LDB(B1, 1, 1); PG8_SCHED; PG8_LDA(At, 1, 0); PG8_STAGE_A(PG8_SA(0, 1), a2, vo2, 1);
            PG8_WAIT_V(8); PG8_WAIT_L(0); PG8_BAR; PG8_MMA(0, 0, At, B0); PG8_MMA(0, 1, At, B1); PG8_BAR; PG8_SCHED;
            PG8_LDA(At, 1, 1); PG8_STAGE_B(PG8_SB(1, 0), b3); PG8_STAGE_B(PG8_SB(1, 1), b3 + hstepB); PG8_STAGE_A(PG8_SA(1, 0), a3, vo2, 0);
            PG8_WAIT_V(8); PG8_WAIT_L(0); PG8_BAR; PG8_MMA(1, 0, At, B0); PG8_MMA(1, 1, At, B1); PG8_BAR; PG8_SCHED;
        }
        if (wr == 0) PG8_BAR;
        E(acc, cur, wr, wc, fr, fq);
        if (!has_next) break;
#pragma unroll
        for (int a = 0; a < 2; ++a)
#pragma unroll
            for (int b = 0; b < 2; ++b)
#pragma unroll
                for (int m = 0; m < 4; ++m)
#pragma unroll
                    for (int n = 0; n < 2; ++n) acc[a][b][m][n] = (f32x4){0.f, 0.f, 0.f, 0.f};
        cur = nxt; cA = nA; cB = nB; ++ui;
        if constexpr (GATHER) {
#pragma unroll
            for (int h = 0; h < 2; ++h)
#pragma unroll
                for (int i = 0; i < 2; ++i) voffA[h][i] = voffN[h][i];
        }
        if (wr == 1) PG8_BAR;
    }
    PG8_WAIT_V(0);
    PG8_BAR;
#undef PG8_SA
#undef PG8_SB
#undef PG8_STAGE_A
#undef PG8_STAGE_B
#undef PG8_LDA
#undef PG8_LDB
#undef PG8_MMA
#undef PG8_WAIT_V
#undef PG8_WAIT_L
#undef PG8_BAR
#undef PG8_SCHED
}

#define EPI_ROWCOL const int row0 = u.orow + wr * 64 + fr, colw = wc * 32 + 8 * fq
struct EpiP1 {
    bf16* PROJ; bf16* GATE; const float* bgate;
    __device__ __forceinline__ void operator()(const f32x4 (&acc)[2][2][4][2], const Unit& u, int wr, int wc, int fr, int fq) const {
        EPI_ROWCOL; const int pn = u.pn; const int mode = pn < 8 ? 1 : (pn < 24 ? 0 : 2);
        bf16* base = (mode == 2) ? GATE : PROJ; const int colt = ((mode == 2) ? (pn - 24) : pn) * BM + colw;
        f32x4 bv[2][2];
#pragma unroll
        for (int bj = 0; bj < 2; ++bj)
#pragma unroll
            for (int n = 0; n < 2; ++n) { const f32x4 t = *(const f32x4*)(bgate + ((mode == 2) ? colt : colw) + bj * HALF + 4 * n); bv[bj][n] = (mode == 2) ? t : (f32x4){0.f, 0.f, 0.f, 0.f}; }
#pragma unroll
        for (int ai = 0; ai < 2; ++ai)
#pragma unroll
            for (int m = 0; m < 4; ++m) { bf16* rowp = base + (size_t)(row0 + ai * HALF + m * 16) * INC + colt;
#pragma unroll
                for (int bj = 0; bj < 2; ++bj) { f32x4 v0 = acc[ai][bj][m][0] + bv[bj][0], v1 = acc[ai][bj][m][1] + bv[bj][1];
                    if (mode == 1) { const f32x2 a = gelu_pk((f32x2){v0[0], v0[1]}), b = gelu_pk((f32x2){v0[2], v0[3]}), c = gelu_pk((f32x2){v1[0], v1[1]}), d = gelu_pk((f32x2){v1[2], v1[3]});
                        v0 = (f32x4){a.x, a.y, b.x, b.y}; v1 = (f32x4){c.x, c.y, d.x, d.y}; }
                    else if (mode == 2) {
#pragma unroll
                        for (int j = 0; j < 4; ++j) { v0[j] = fast_sigmoid(v0[j]); v1[j] = fast_sigmoid(v1[j]); } }
                    u32x4 w; w.x = cvt_pk_bf16(v0[0], v0[1]); w.y = cvt_pk_bf16(v0[2], v0[3]); w.z = cvt_pk_bf16(v1[0], v1[1]); w.w = cvt_pk_bf16(v1[2], v1[3]);
                    *(u32x4*)(rowp + bj * HALF) = w; } }
    }
};
struct EpiP3 {
    const bf16* GATE; float* MF; bf16* MG;
    __device__ __forceinline__ void operator()(const f32x4 (&acc)[2][2][4][2], const Unit& u, int wr, int wc, int fr, int fq) const {
        EPI_ROWCOL; const int seg = u.seg;
#pragma unroll
        for (int ai = 0; ai < 2; ++ai)
#pragma unroll
            for (int m = 0; m < 4; ++m) { const size_t r = (size_t)(row0 + ai * HALF + m * 16);
#pragma unroll
                for (int bj = 0; bj < 2; ++bj) { const int col = u.pn * BM + bj * HALF + colw;
                    const u32x4 gw = *(const u32x4*)(GATE + r * INC + seg * D + col);
                    f32x4 r0 = acc[ai][bj][m][0], r1 = acc[ai][bj][m][1];
                    r0[0] *= bflo(gw.x); r0[1] *= bfhi(gw.x); r0[2] *= bflo(gw.y); r0[3] *= bfhi(gw.y); r1[0] *= bflo(gw.z); r1[1] *= bfhi(gw.z); r1[2] *= bflo(gw.w); r1[3] *= bfhi(gw.w);
                    float* mp = MF + r * D + col;
                    if (seg > 0) { r0 += *(const f32x4*)mp; r1 += *(const f32x4*)(mp + 4); }
                    if (seg < 2) { *(f32x4*)mp = r0; *(f32x4*)(mp + 4) = r1; }
                    else { u32x4 w; w.x = cvt_pk_bf16(r0[0], r0[1]); w.y = cvt_pk_bf16(r0[2], r0[3]); w.z = cvt_pk_bf16(r1[0], r1[1]); w.w = cvt_pk_bf16(r1[2], r1[3]); *(u32x4*)(MG + r * D + col) = w; } }
                asm volatile("" ::: "memory"); }
    }
};
struct EpiP4 {
    const float* X; float* PRE;
    __device__ __forceinline__ void operator()(const f32x4 (&acc)[2][2][4][2], const Unit& u, int wr, int wc, int fr, int fq) const {
        EPI_ROWCOL;
#pragma unroll
        for (int ai = 0; ai < 2; ++ai)
#pragma unroll
            for (int m = 0; m < 4; ++m) { const size_t r = (size_t)(row0 + ai * HALF + m * 16);
#pragma unroll
                for (int bj = 0; bj < 2; ++bj) { const size_t o = r * D + u.pn * BM + bj * HALF + colw;
                    const f32x4 x0 = *(const f32x4*)(X + o), x1 = *(const f32x4*)(X + o + 4);
                    *(f32x4*)(PRE + o) = x0 * ALPHA + acc[ai][bj][m][0]; *(f32x4*)(PRE + o + 4) = x1 * ALPHA + acc[ai][bj][m][1]; }
                asm volatile("" ::: "memory"); }
    }
};
struct EpiP6 {
    bf16* H;
    __device__ __forceinline__ void operator()(const f32x4 (&acc)[2][2][4][2], const Unit& u, int wr, int wc, int fr, int fq) const {
        EPI_ROWCOL;
#pragma unroll
        for (int ai = 0; ai < 2; ++ai)
#pragma unroll
            for (int m = 0; m < 4; ++m) { const size_t r = (size_t)(row0 + ai * HALF + m * 16);
                float h[8];
#pragma unroll
                for (int n = 0; n < 2; ++n)
#pragma unroll
                    for (int j = 0; j < 4; ++j) { const float g = acc[ai][0][m][n][j], up = acc[ai][1][m][n][j]; h[4 * n + j] = g * fast_sigmoid(g) * up; }
                u32x4 w; w.x = cvt_pk_bf16(h[0], h[1]); w.y = cvt_pk_bf16(h[2], h[3]); w.z = cvt_pk_bf16(h[4], h[5]); w.w = cvt_pk_bf16(h[6], h[7]);
                *(u32x4*)(H + r * EH + u.pn * HALF + colw) = w; }
    }
};
struct EpiP7 {
    bf16* Y;
    __device__ __forceinline__ void operator()(const f32x4 (&acc)[2][2][4][2], const Unit& u, int wr, int wc, int fr, int fq) const {
        EPI_ROWCOL;
#pragma unroll
        for (int ai = 0; ai < 2; ++ai)
#pragma unroll
            for (int m = 0; m < 4; ++m) { bf16* rowp = Y + (size_t)(row0 + ai * HALF + m * 16) * D + u.pn * BM + colw;
#pragma unroll
                for (int bj = 0; bj < 2; ++bj) { const f32x4 v0 = acc[ai][bj][m][0], v1 = acc[ai][bj][m][1];
                    u32x4 w; w.x = cvt_pk_bf16(v0[0], v0[1]); w.y = cvt_pk_bf16(v0[2], v0[3]); w.z = cvt_pk_bf16(v1[0], v1[1]); w.w = cvt_pk_bf16(v1[2], v1[3]);
                    *(u32x4*)(rowp + bj * HALF) = w; } }
    }
};
}

#define XB_TMO      128
#define XB_XCNT(j)  (256  + 64 * (j))
#define XB_XSUB(j)  (1280 + 64 * (j))
#define XB_XGEN(j)  (2304 + 64 * (j))
#define XB_TOP      3328
#define XB_TOPGEN   3392
#define XCD_BAR_WORDS 3456
#define XB_SPIN_CAP (1u << 18)
__device__ __forceinline__ unsigned xb_ld(unsigned* p)              { return __hip_atomic_load(p, __ATOMIC_RELAXED, __HIP_MEMORY_SCOPE_AGENT); }
__device__ __forceinline__ unsigned xb_add(unsigned* p, unsigned v) { return __hip_atomic_fetch_add(p, v, __ATOMIC_RELAXED, __HIP_MEMORY_SCOPE_AGENT); }
__device__ __forceinline__ unsigned xb_xcc_id() { return (unsigned)__builtin_amdgcn_s_getreg((3 << 11) | 20) & 0xFu; }
#define XB_SPIN(cond, bar) do { unsigned _sp = 0; while (cond) { __builtin_amdgcn_s_sleep(1); \
    if ((++_sp & 255u) == 0u) { if (xb_ld(&(bar)[XB_TMO])) break; if (_sp > XB_SPIN_CAP) { atomicAdd(&(bar)[XB_TMO], 1u); break; } } } } while (0)
struct XcdBarrier { unsigned* bar; unsigned x; volatile LAS unsigned* st; };
__device__ __forceinline__ XcdBarrier xcd_barrier_post(unsigned* bar, volatile LAS unsigned* st) {
    XcdBarrier b; b.bar = bar; b.x = xb_xcc_id(); b.st = st;
    if (threadIdx.x == 0) (void)xb_add(&bar[XB_XCNT(b.x)], 1u);
    return b;
}
__device__ __forceinline__ void xcd_barrier_complete(unsigned* bar, unsigned x, unsigned& nloc, unsigned& nx) {
    const unsigned G = gridDim.x * gridDim.y * gridDim.z;
    unsigned sum, cnt, mine, sp = 0u;
    for (;;) {
        sum = 0u; cnt = 0u; mine = 0u;
#pragma unroll
        for (unsigned j = 0; j < 16; ++j) { const unsigned c = xb_ld(&bar[XB_XCNT(j)]); sum += c; cnt += (c > 0u) ? 1u : 0u; mine = (j == x) ? c : mine; }
        if (sum == G) break;
        __builtin_amdgcn_s_sleep(1);
        if ((++sp & 255u) == 0u) { if (xb_ld(&bar[XB_TMO])) break; if (sp > XB_SPIN_CAP) { atomicAdd(&bar[XB_TMO], 1u); break; } }
    }
    nloc = mine > 0u ? mine : 1u; nx = cnt > 0u ? cnt : 1u;
}
__device__ __forceinline__ void xcd_barrier(const XcdBarrier& b) {
    asm volatile("s_waitcnt vmcnt(0)" ::: "memory");
    __syncthreads();
    if (threadIdx.x == 0) {
        unsigned* bar = b.bar;
        __builtin_amdgcn_s_waitcnt(0);
        unsigned nloc = b.st[0], nx = b.st[1];
        if (nloc == 0u) { xcd_barrier_complete(bar, b.x, nloc, nx); b.st[0] = nloc; b.st[1] = nx; }
        const unsigned old = xb_add(&bar[XB_XSUB(b.x)], 1u);
        const unsigned gen = old / nloc;
        if (old + 1u == (gen + 1u) * nloc) {
            __builtin_amdgcn_fence(__ATOMIC_RELEASE, "agent");
            asm volatile("s_waitcnt vmcnt(0)" ::: "memory");
            const unsigned og = xb_add(&bar[XB_TOP], 1u);
            const unsigned tg = og / nx;
            if (og + 1u == (tg + 1u) * nx) xb_add(&bar[XB_TOPGEN], 1u);
            else XB_SPIN(xb_ld(&bar[XB_TOPGEN]) == tg, bar);
            __builtin_amdgcn_fence(__ATOMIC_ACQUIRE, "agent");
            xb_add(&bar[XB_XGEN(b.x)], 1u);
            asm volatile("s_waitcnt vmcnt(0)" ::: "memory");
        } else {
            XB_SPIN(xb_ld(&bar[XB_XGEN(b.x)]) == gen, bar);
            __builtin_amdgcn_fence(__ATOMIC_ACQUIRE, "agent");
            asm volatile("s_waitcnt vmcnt(0)" ::: "memory");
        }
    }
    __syncthreads();
}

template <int MAP>
__device__ __forceinline__ void ln_finish(float (&v)[32], const float* __restrict__ g, const float* __restrict__ b, float* xout, bf16* xbout, int lane) {
    float s = 0.f;
#pragma unroll
    for (int i = 0; i < 32; ++i) s += v[i];
    const float mean = wave_sum(s) * (1.0f / D);
    float q = 0.f;
#pragma unroll
    for (int i = 0; i < 32; ++i) { v[i] -= mean; q += v[i] * v[i]; }
    const float rstd = 1.0f / sqrtf(wave_sum(q) * (1.0f / D) + LN_EPS);
    if (MAP == 0) {
#pragma unroll
        for (int j = 0; j < 8; ++j) {
            const int c = 4 * (lane + 64 * j);
            const f32x4 gv = *(const f32x4*)(g + c), bv = *(const f32x4*)(b + c);
            f32x4 o; o.x = v[4 * j] * rstd * gv.x + bv.x; o.y = v[4 * j + 1] * rstd * gv.y + bv.y; o.z = v[4 * j + 2] * rstd * gv.z + bv.z; o.w = v[4 * j + 3] * rstd * gv.w + bv.w;
            *(f32x4*)(xout + c) = o;
            if (xbout) { u32x2 w; w.x = pk2(o.x, o.y); w.y = pk2(o.z, o.w); *(u32x2*)(xbout + c) = w; }
        }
    } else {
#pragma unroll
        for (int j = 0; j < 4; ++j) {
            const int c = 8 * (lane + 64 * j);
            const f32x4 g0 = *(const f32x4*)(g + c), g1 = *(const f32x4*)(g + c + 4), b0 = *(const f32x4*)(b + c), b1 = *(const f32x4*)(b + c + 4);
            f32x4 o0, o1;
            o0.x = v[8 * j] * rstd * g0.x + b0.x; o0.y = v[8 * j + 1] * rstd * g0.y + b0.y; o0.z = v[8 * j + 2] * rstd * g0.z + b0.z; o0.w = v[8 * j + 3] * rstd * g0.w + b0.w;
            o1.x = v[8 * j + 4] * rstd * g1.x + b1.x; o1.y = v[8 * j + 5] * rstd * g1.y + b1.y; o1.z = v[8 * j + 6] * rstd * g1.z + b1.z; o1.w = v[8 * j + 7] * rstd * g1.w + b1.w;
            *(f32x4*)(xout + c) = o0; *(f32x4*)(xout + c + 4) = o1;
            if (xbout) { u32x4 w; w.x = pk2(o0.x, o0.y); w.y = pk2(o0.z, o0.w); w.z = pk2(o1.x, o1.y); w.w = pk2(o1.z, o1.w); *(u32x4*)(xbout + c) = w; }
        }
    }
}
__device__ __forceinline__ void entry_ln_row(const Params& p, int t, int lane) {
    float* X = (float*)(p.ws + WS_X); bf16* XB = (bf16*)(p.ws + WS_XB);
    float v[32]; const float* xr = p.in[0] + (size_t)t * D;
#pragma unroll
    for (int j = 0; j < 8; ++j) { const f32x4 a = *(const f32x4*)(xr + 4 * (lane + 64 * j)); v[4 * j] = a.x; v[4 * j + 1] = a.y; v[4 * j + 2] = a.z; v[4 * j + 3] = a.w; }
    ln_finish<0>(v, p.in[1], p.in[2], X + (size_t)t * D, XB + (size_t)t * D, lane);
}

__device__ __forceinline__ void spatial_unit(const Params& p, int l, int unit, LAS float* vh, int tid) {
    const int nb = unit >> 2, g = unit & 3, lane = tid & 63, wid = tid >> 6;
    const bf16* PROJ = (const bf16*)(p.ws + WS_PROJ); bf16* YABC = (bf16*)(p.ws + WS_YABC);
    for (int rr = 0; rr < 16; ++rr) {
        const int j = wid * 16 + rr; const size_t t = (size_t)nb * 128 + j;
        const u32x2 raw = *(const u32x2*)(PROJ + t * INC + 1024 + g * 256 + lane * 4);
        float a0 = bflo(raw.x), a1 = bfhi(raw.x), a2 = bflo(raw.y), a3 = bfhi(raw.y);
        const float mean = wave_sum((a0 + a1) + (a2 + a3)) * (1.0f / 256.0f);
        a0 -= mean; a1 -= mean; a2 -= mean; a3 -= mean;
        const float rstd = 1.0f / sqrtf(wave_sum((a0 * a0 + a1 * a1) + (a2 * a2 + a3 * a3)) * (1.0f / 256.0f) + LN_EPS);
        *(LAS f32x4*)(vh + j * 256 + lane * 4) = (f32x4){a0 * rstd, a1 * rstd, a2 * rstd, a3 * rstd};
    }
    __syncthreads();
    const int c = tid & 255, ih = tid >> 8;
    const float* ws = p.in[4] + ((size_t)l * 4 + g) * 128 * 128; const float* bs = p.in[5] + ((size_t)l * 4 + g) * 128;
    const int jmax = ih ? 128 : 64;
    for (int ii = 0; ii < 64; ii += 4) {
        const int i = ih * 64 + ii;
        float a0 = 0.f, a1 = 0.f, a2 = 0.f, a3 = 0.f;
        for (int j = 0; j < jmax; ++j) {
            const float v = vh[j * 256 + c];
            a0 += ws[(i + 0) * 128 + j] * v; a1 += ws[(i + 1) * 128 + j] * v; a2 += ws[(i + 2) * 128 + j] * v; a3 += ws[(i + 3) * 128 + j] * v;
        }
        const float mx[4] = {a0 + bs[i], a1 + bs[i + 1], a2 + bs[i + 2], a3 + bs[i + 3]};
#pragma unroll
        for (int r = 0; r < 4; ++r) {
            const size_t t = (size_t)nb * 128 + i + r;
            const float uu = bf2f(PROJ[t * INC + g * 256 + c]);
            YABC[t * 3072 + g * 256 + c] = (bf16)f2bf(uu * mx[r]);
        }
    }
    __syncthreads();
}
__device__ __forceinline__ void ld8(const bf16* ptr, float (&f)[8]) {
    const u32x4 w = *(const u32x4*)ptr;
    f[0] = bflo(w.x); f[1] = bfhi(w.x); f[2] = bflo(w.y); f[3] = bfhi(w.y); f[4] = bflo(w.z); f[5] = bfhi(w.z); f[6] = bflo(w.w); f[7] = bfhi(w.w);
}
__device__ __forceinline__ void st8(bf16* ptr, const float (&f)[8]) {
    u32x4 w; w.x = pk2(f[0], f[1]); w.y = pk2(f[2], f[3]); w.z = pk2(f[4], f[5]); w.w = pk2(f[6], f[7]); *(u32x4*)ptr = w;
}
__device__ __forceinline__ void convpool_item(const Params& p, int l, int item) {
    const bf16* PROJ = (const bf16*)(p.ws + WS_PROJ); bf16* YABC = (bf16*)(p.ws + WS_YABC);
    const int which = item >= T * 128; if (which) item -= T * 128;
    const int t = item >> 7, c = (item & 127) * 8;
    if (!which) {
        float bgv[8], cv[8], acc[8];
        ld8(PROJ + (size_t)t * INC + 2048 + c, bgv);
#pragma unroll
        for (int i = 0; i < 8; ++i) acc[i] = 0.f;
#pragma unroll
        for (int d = 0; d < 3; ++d) {
            const int tt = t - 2 + d;
            if (tt >= 0) {
                float cg[8], hh[8]; ld8(PROJ + (size_t)tt * INC + 3072 + c, cg); ld8(PROJ + (size_t)tt * INC + 4096 + c, hh);
                const float* wc = p.in[6] + ((size_t)l * 3 + d) * 1024 + c;
                const f32x4 w0 = *(const f32x4*)wc, w1 = *(const f32x4*)(wc + 4);
                cv[0] = w0.x; cv[1] = w0.y; cv[2] = w0.z; cv[3] = w0.w; cv[4] = w1.x; cv[5] = w1.y; cv[6] = w1.z; cv[7] = w1.w;
#pragma unroll
                for (int i = 0; i < 8; ++i) acc[i] += cv[i] * (cg[i] * hh[i]);
            }
        }
#pragma unroll
        for (int i = 0; i < 8; ++i) acc[i] *= bgv[i];
        st8(YABC + (size_t)t * 3072 + 1024 + c, acc);
    } else {
        const int g = c >> 8, win = 2 << g; const int start = (t + 1 - win) > 0 ? (t + 1 - win) : 0; const float inv = 1.0f / (float)(t + 1 - start);
        float tot[8], cur[8];
#pragma unroll
        for (int i = 0; i < 8; ++i) { tot[i] = 0.f; cur[i] = 0.f; }
        for (int s = start; s <= t; ++s) { ld8(PROJ + (size_t)s * INC + 5120 + c, cur);
#pragma unroll
            for (int i = 0; i < 8; ++i) tot[i] += cur[i]; }
#pragma unroll
        for (int i = 0; i < 8; ++i) tot[i] = tot[i] * inv - cur[i];
        st8(YABC + (size_t)t * 3072 + 2048 + c, tot);
    }
}

__device__ __forceinline__ void ln1_router_unit(const Params& p, int l, int unit, LAS unsigned char* lds, int tid) {
    LAS float* xs = (LAS float*)lds; LAS float* lg = xs + 32 * 260; LAS float* gs = lg + 32 * 64; LAS int* le = (LAS int*)(gs + 32 * 8); LAS float* lw = (LAS float*)(le + 32 * 8);
    LAS int* cnt = (LAS int*)(lw + 32 * 8); LAS int* base = cnt + 64;
    const int lane = tid & 63, wid = tid >> 6; const int t0 = unit * 32;
    const float* PRE = (const float*)(p.ws + WS_PRE); float* X = (float*)(p.ws + WS_X); bf16* XB = (bf16*)(p.ws + WS_XB);
    for (int r = 0; r < 4; ++r) {
        const int t = t0 + wid * 4 + r; float v[32]; const float* xr = PRE + (size_t)t * D;
#pragma unroll
        for (int j = 0; j < 8; ++j) { const f32x4 a = *(const f32x4*)(xr + 4 * (lane + 64 * j)); v[4 * j] = a.x; v[4 * j + 1] = a.y; v[4 * j + 2] = a.z; v[4 * j + 3] = a.w; }
        ln_finish<0>(v, p.in[15] + (size_t)l * D, p.in[16] + (size_t)l * D, X + (size_t)t * D, XB + (size_t)t * D, lane);
    }
    if (tid < 64) cnt[tid] = 0;
    __threadfence_block();
    __syncthreads();
    const float* wr = p.in[17] + (size_t)l * D * NE;
    float a0 = 0.f, a1 = 0.f, a2 = 0.f, a3 = 0.f;
    for (int kc = 0; kc < D; kc += 256) {
#pragma unroll
        for (int i = 0; i < 4; ++i) { const int pc = tid + 512 * i, rr = pc >> 6, cc = (pc & 63) * 4; *(LAS f32x4*)(xs + rr * 260 + cc) = *(const f32x4*)(X + (size_t)(t0 + rr) * D + kc + cc); }
        __syncthreads();
        const LAS float* x0 = xs + (wid * 4) * 260;
        for (int k = 0; k < 256; k += 4) {
            const f32x4 xa = *(const LAS f32x4*)(x0 + k), xb = *(const LAS f32x4*)(x0 + 260 + k), xc = *(const LAS f32x4*)(x0 + 520 + k), xd = *(const LAS f32x4*)(x0 + 780 + k);
            const float w0 = wr[(size_t)(kc + k) * NE + lane], w1 = wr[(size_t)(kc + k + 1) * NE + lane], w2 = wr[(size_t)(kc + k + 2) * NE + lane], w3 = wr[(size_t)(kc + k + 3) * NE + lane];
            a0 += xa.x * w0; a0 += xa.y * w1; a0 += xa.z * w2; a0 += xa.w * w3;
            a1 += xb.x * w0; a1 += xb.y * w1; a1 += xb.z * w2; a1 += xb.w * w3;
            a2 += xc.x * w0; a2 += xc.y * w1; a2 += xc.z * w2; a2 += xc.w * w3;
            a3 += xd.x * w0; a3 += xd.y * w1; a3 += xd.z * w2; a3 += xd.w * w3;
        }
        __syncthreads();
    }
    lg[(wid * 4 + 0) * 64 + lane] = sigmoidf_(a0); lg[(wid * 4 + 1) * 64 + lane] = sigmoidf_(a1); lg[(wid * 4 + 2) * 64 + lane] = sigmoidf_(a2); lg[(wid * 4 + 3) * 64 + lane] = sigmoidf_(a3);
    __syncthreads();
    const float* rb = p.in[18] + (size_t)l * NE;
    if (tid < 32) {
        const LAS float* sc = lg + tid * 64;
        for (int g = 0; g < 8; ++g) { float m1 = -INFINITY, m2 = -INFINITY;
            for (int j = 0; j < 8; ++j) { const float s = sc[g * 8 + j] + rb[g * 8 + j]; if (s > m1) { m2 = m1; m1 = s; } else if (s > m2) m2 = s; }
            gs[tid * 8 + g] = m1 + m2; }
        unsigned gmask = 0;
        for (int it = 0; it < 4; ++it) { float best = -INFINITY; int bi = 0;
            for (int g = 0; g < 8; ++g) { const float s = gs[tid * 8 + g]; if (!((gmask >> g) & 1u) && s > best) { best = s; bi = g; } }
            gmask |= 1u << bi; }
        unsigned long long chosen = 0ull; float wsum = 0.f;
        for (int it = 0; it < 8; ++it) { float best = -INFINITY; int bi = -1;
            for (int e = 0; e < 64; ++e) { if (!((gmask >> (e >> 3)) & 1u) || ((chosen >> e) & 1ull)) continue; const float s = sc[e] + rb[e]; if (bi < 0 || s > best) { best = s; bi = e; } }
            chosen |= 1ull << bi; const float w = sc[bi]; wsum += w; le[tid * 8 + it] = bi; lw[tid * 8 + it] = w; }
        const float scale = ROUTED_SCALE / wsum;
        for (int it = 0; it < 8; ++it) { lw[tid * 8 + it] *= scale; }
    }
    __syncthreads();
    int myrank = 0, mye = 0;
    if (tid < 256) { mye = le[tid]; myrank = atomicAdd((int*)&cnt[mye], 1); }
    __syncthreads();
    if (tid < 64) { const int c = cnt[tid]; base[tid] = c ? (int)atomicAdd((unsigned*)(p.ws + WS_CTL) + CW_CNT + 64 * l + tid, (unsigned)c) : 0; }
    __syncthreads();
    if (tid < 256) {
        const int t = t0 + (tid >> 3), s = tid & 7, pos = base[mye] + myrank;
        ((int*)(p.ws + WS_TOPE))[t * 8 + s] = mye; ((int*)(p.ws + WS_TOPPOS))[t * 8 + s] = pos; ((float*)(p.ws + WS_TOPW))[t * 8 + s] = lw[tid];
        ((int*)(p.ws + WS_LIST))[((size_t)l * 64 + mye) * 8192 + pos] = t;
    }
    __syncthreads();
}

__device__ __forceinline__ void combine_ln2_row(const Params& p, int l, int t, const LAS MoeTab* tb, int lane, bool last) {
    const bf16* Y = (const bf16*)(p.ws + WS_Y); float* X = (float*)(p.ws + WS_X); bf16* XB = (bf16*)(p.ws + WS_XB);
    float v[32];
    const float* xr = X + (size_t)t * D;
#pragma unroll
    for (int j = 0; j < 4; ++j) { const int c = 8 * (lane + 64 * j); const f32x4 a = *(const f32x4*)(xr + c), b = *(const f32x4*)(xr + c + 4);
        v[8 * j] = ALPHA * a.x; v[8 * j + 1] = ALPHA * a.y; v[8 * j + 2] = ALPHA * a.z; v[8 * j + 3] = ALPHA * a.w; v[8 * j + 4] = ALPHA * b.x; v[8 * j + 5] = ALPHA * b.y; v[8 * j + 6] = ALPHA * b.z; v[8 * j + 7] = ALPHA * b.w; }
    for (int s = 0; s < 9; ++s) {
        int row; float w;
        if (s < 8) {
            const int e = (int)__hip_atomic_load((unsigned*)(p.ws + WS_TOPE) + t * 8 + s, __ATOMIC_RELAXED, __HIP_MEMORY_SCOPE_AGENT);
            row = tb->rb[e] + (int)__hip_atomic_load((unsigned*)(p.ws + WS_TOPPOS) + t * 8 + s, __ATOMIC_RELAXED, __HIP_MEMORY_SCOPE_AGENT);
            w = __uint_as_float(__hip_atomic_load((unsigned*)(p.ws + WS_TOPW) + t * 8 + s, __ATOMIC_RELAXED, __HIP_MEMORY_SCOPE_AGENT)); }
        else { row = tb->rb[64] + t; w = 1.0f; }
        const bf16* yr = Y + (size_t)row * D;
#pragma unroll
        for (int j = 0; j < 4; ++j) { float f[8]; ld8(yr + 8 * (lane + 64 * j), f);
#pragma unroll
            for (int i = 0; i < 8; ++i) v[8 * j + i] += w * f[i]; }
    }
    float* xo = last ? p.out + (size_t)t * D : X + (size_t)t * D;
    ln_finish<1>(v, p.in[25] + (size_t)l * D, p.in[26] + (size_t)l * D, xo, last ? nullptr : XB + (size_t)t * D, lane);
}

__device__ __forceinline__ void tr_item(const float* __restrict__ src, int ldsrc, bf16* dst, int lddst, LAS float* scr, int lane) {
    f32x4 v[16];
    const int kr = lane >> 4, n4 = (lane & 15) * 4;
#pragma unroll
    for (int q = 0; q < 16; ++q) v[q] = __builtin_nontemporal_load((const f32x4*)(src + (size_t)(4 * q + kr) * ldsrc + n4));
#pragma unroll
    for (int q = 0; q < 16; ++q) { const int k = 4 * q + kr; *(LAS f32x4*)(scr + k * 64 + (n4 ^ (8 * (k >> 3)))) = v[q]; }
    asm volatile("s_waitcnt lgkmcnt(0)" ::: "memory");
    const int kg = lane >> 3, r = lane & 7;
#pragma unroll
    for (int s = 0; s < 8; ++s) {
        const int n = 8 * s + r; const LAS float* sp = scr + (8 * kg) * 64 + (n ^ (8 * kg));
        u32x4 w; w.x = pk2(sp[0], sp[64]); w.y = pk2(sp[128], sp[192]); w.z = pk2(sp[256], sp[320]); w.w = pk2(sp[384], sp[448]);
        *(u32x4*)(dst + (size_t)n * lddst + 8 * kg) = w;
    }
    asm volatile("s_waitcnt lgkmcnt(0)" ::: "memory");
}
constexpr int I_IN = 32 * 96, I_PA = 16 * 32, I_O = 32 * 32, I_EX = 65 * 256, I_LAYER = 2 * I_IN + 2 * I_PA + I_O + 3 * I_EX;
__device__ __forceinline__ void prologue_item(const Params& p, int it, LAS float* scr, int lane) {
    const int l = it / I_LAYER; int r = it % I_LAYER;
    unsigned char* wl = p.ws + WS_W + (size_t)l * WL_BYTES;
    if (r < 2 * I_IN) {
        const int which = r / I_IN; r %= I_IN; const int kb = r / 96, nb = r % 96;
        const float* src = p.in[which ? 9 : 3] + (size_t)l * D * INC + (size_t)(kb * 64) * INC + nb * 64;
        tr_item(src, INC, (bf16*)(wl + WL_IG) + (size_t)(which * INC + nb * 64) * D + kb * 64, D, scr, lane); return; }
    r -= 2 * I_IN;
    if (r < 2 * I_PA) {
        const int which = r / I_PA; r %= I_PA; const int kb = r / 32, nb = r % 32;
        const float* src = p.in[11 + which] + (size_t)l * 1024 * D + (size_t)(kb * 64) * D + nb * 64;
        tr_item(src, D, (bf16*)(wl + WL_ABC) + (size_t)which * D * 1024 + (size_t)(nb * 64) * 1024 + kb * 64, 1024, scr, lane); return; }
    r -= 2 * I_PA;
    if (r < I_O) {
        const int kb = r / 32, nb = r % 32;
        const float* src = p.in[14] + (size_t)l * D * D + (size_t)(kb * 64) * D + nb * 64;
        tr_item(src, D, (bf16*)(wl + WL_O) + (size_t)(nb * 64) * D + kb * 64, D, scr, lane); return; }
    r -= I_O;
    const int kind = r / I_EX; r %= I_EX; const int e = r >> 8; r &= 255;
    if (kind < 2) {
        const int kb = r >> 3, nb = r & 7, n0 = nb * 64;
        const float* src = (e < 64 ? p.in[19 + kind] + ((size_t)l * 64 + e) * D * EH : p.in[22 + kind] + (size_t)l * D * EH) + (size_t)(kb * 64) * EH + n0;
        const int drow = (n0 >> 7) * 256 + kind * 128 + (n0 & 127);
        tr_item(src, EH, (bf16*)(wl + WL_GU) + (size_t)e * 1024 * D + (size_t)drow * D + kb * 64, D, scr, lane);
    } else {
        const int kb = r >> 5, nb = r & 31;
        const float* src = (e < 64 ? p.in[21] + ((size_t)l * 64 + e) * EH * D : p.in[24] + (size_t)l * EH * D) + (size_t)(kb * 64) * D + nb * 64;
        tr_item(src, D, (bf16*)(wl + WL_D) + (size_t)e * D * EH + (size_t)(nb * 64) * EH + kb * 64, EH, scr, lane);
    }
}
__device__ __forceinline__ void wcprime_tile(const Params& p, int tile, LAS bf16* sA, LAS bf16* sB, int tid) {
    const int l = tile >> 8, g = (tile >> 6) & 3, tm = (tile >> 5) & 1, tn = tile & 31;
    const int lane = tid & 63, wid = tid >> 6, wm = wid >> 1, wn = wid & 1, fr = lane & 15, fq = lane >> 4;
    const float* Ap = p.in[7] + ((size_t)l * 4 + g) * 256 * 256; const float* sc = p.in[8] + (size_t)l * 1024 + g * 256;
    const float* Wp = p.in[13] + (size_t)l * 1024 * D + (size_t)(g * 256) * D;
    bf16* dst = (bf16*)(p.ws + WS_W + (size_t)l * WL_BYTES + WL_ABC) + (size_t)2 * D * 1024;
    f32x4 acc[2][2];
#pragma unroll
    for (int a = 0; a < 2; ++a)
#pragma unroll
        for (int b = 0; b < 2; ++b) acc[a][b] = (f32x4){0.f, 0.f, 0.f, 0.f};
    const int ar = tid >> 2, akseg = (tid & 3) * 8, wk = tid >> 4, wns = (tid & 15) * 4;
    for (int k0 = 0; k0 < 256; k0 += 32) {
        const float* ap = Ap + (size_t)(tm * 128 + ar) * 256 + k0 + akseg;
        const f32x4 x0 = *(const f32x4*)ap, x1 = *(const f32x4*)(ap + 4), s0 = *(const f32x4*)(sc + k0 + akseg), s1 = *(const f32x4*)(sc + k0 + akseg + 4);
        u32x4 av; av.x = pk2(x0.x * s0.x, x0.y * s0.y); av.y = pk2(x0.z * s0.z, x0.w * s0.w); av.z = pk2(x1.x * s1.x, x1.y * s1.y); av.w = pk2(x1.z * s1.z, x1.w * s1.w);
        const f32x4 wv = *(const f32x4*)(Wp + (size_t)(k0 + wk) * D + tn * 64 + wns);
        *(LAS u32x4*)(sA + ar * 40 + akseg) = av;
        sB[(wns + 0) * 40 + wk] = (bf16)f2bf(wv.x); sB[(wns + 1) * 40 + wk] = (bf16)f2bf(wv.y); sB[(wns + 2) * 40 + wk] = (bf16)f2bf(wv.z); sB[(wns + 3) * 40 + wk] = (bf16)f2bf(wv.w);
        __syncthreads();
#pragma unroll
        for (int mi = 0; mi < 2; ++mi) {
            const bf16x8 a = *(const LAS bf16x8*)(sA + (wm * 32 + mi * 16 + fr) * 40 + fq * 8);
#pragma unroll
            for (int ni = 0; ni < 2; ++ni) {
                const bf16x8 b = *(const LAS bf16x8*)(sB + (wn * 32 + ni * 16 + fr) * 40 + fq * 8);
                acc[mi][ni] = __builtin_amdgcn_mfma_f32_16x16x32_bf16(a, b, acc[mi][ni], 0, 0, 0);
            }
        }
        __syncthreads();
    }
#pragma unroll
    for (int mi = 0; mi < 2; ++mi)
#pragma unroll
        for (int ni = 0; ni < 2; ++ni)
#pragma unroll
            for (int j = 0; j < 4; ++j) { const int c = tm * 128 + wm * 32 + mi * 16 + fq * 4 + j, n = tn * 64 + wn * 32 + ni * 16 + fr;
                dst[(size_t)n * 1024 + g * 256 + c] = (bf16)f2bf(acc[mi][ni][j]); }
}

__global__ void __launch_bounds__(512, 2) fwd(Params p) {
    extern __shared__ __attribute__((aligned(16))) unsigned char lds_raw[];
    LAS unsigned char* lds = (LAS unsigned char*)lds_raw;
    LAS MoeTab* tb = (LAS MoeTab*)(lds + LDSCTL_OFF);
    volatile LAS unsigned* MISC = (volatile LAS unsigned*)(lds + MISC_OFF);
    const int G = gridDim.x, bx = blockIdx.x; const int vcu = (G % 8 == 0) ? (bx % 8) * (G / 8) + bx / 8 : bx;
    if (threadIdx.x < 32) MISC[threadIdx.x] = 0u;
    __syncthreads();
    unsigned* ctl = (unsigned*)(p.ws + WS_CTL);
    XcdBarrier bar; bar.bar = ctl + CW_BAR; bar.x = 0; bar.st = nullptr;
    const int lo = p.ph_lo, hi = p.ph_hi;
    if (hi - lo > 1) bar = xcd_barrier_post(ctl + CW_BAR, MISC + 8);
#define IN(k) (lo <= (k) && (k) < hi)
#define SEAM(k) do { if (IN(k) && IN((k) + 1)) xcd_barrier(bar); } while (0)

    if (IN(0)) {
        const int tid = ltid(), lane = tid & 63, wave = __builtin_amdgcn_readfirstlane(tid >> 6);
        LAS float* scr = (LAS float*)(lds + wave * 16384);
        const int gw = vcu * 8 + wave, NGW = G * 8;
        for (int it = gw; it < NL * I_LAYER; it += NGW) prologue_item(p, it, scr, lane);
        for (int t = gw; t < T; t += NGW) entry_ln_row(p, t, lane);
        __syncthreads();
        for (int tile = bx; tile < 512; tile += G) wcprime_tile(p, tile, (LAS bf16*)lds, (LAS bf16*)(lds + 16384), tid);
    }
    SEAM(0);

    for (int l = 0; l < NL; ++l) {
        const int pb = 1 + 8 * l;
        const char* wl = (const char*)(p.ws + WS_W + (size_t)l * WL_BYTES);
        if (IN(pb + 0)) {
            pg8::DenseSched S; S.A = (const char*)(p.ws + WS_XB); S.B = wl + WL_IG; S.atile = (size_t)256 * D * 2; S.btile = (size_t)256 * D * 2; S.nM = 32; S.nN = 48; S.G = G; S.c = bx;
            pg8::EpiP1 E{(bf16*)(p.ws + WS_PROJ), (bf16*)(p.ws + WS_GATE), p.in[10] + (size_t)l * INC};
            pg8::gemm_phase<pg8::EpiP1, pg8::DenseSched, false>(lds, D, D, D, S, E);
        }
        SEAM(pb + 0);
        if (IN(pb + 1)) {
            const int tid = ltid();
            for (int u = bx; u < 256; u += G) spatial_unit(p, l, u, (LAS float*)lds, tid);
            for (int it = bx * 512 + tid; it < 2 * T * 128; it += G * 512) convpool_item(p, l, it);
        }
        SEAM(pb + 1);
        if (IN(pb + 2)) {
            pg8::ProjSched S; S.A = (const char*)(p.ws + WS_YABC); S.B = wl + WL_ABC; S.G = G; S.c = bx;
            pg8::EpiP3 E{(const bf16*)(p.ws + WS_GATE), (float*)(p.ws + WS_MF32), (bf16*)(p.ws + WS_MERGED)};
            pg8::gemm_phase<pg8::EpiP3, pg8::ProjSched, false>(lds, 1024, 3072, 1024, S, E);
        }
        SEAM(pb + 2);
        if (IN(pb + 3)) {
            pg8::DenseSched S; S.A = (const char*)(p.ws + WS_MERGED); S.B = wl + WL_O; S.atile = (size_t)256 * D * 2; S.btile = (size_t)256 * D * 2; S.nM = 32; S.nN = 8; S.G = G; S.c = bx;
            pg8::EpiP4 E{(const float*)(p.ws + WS_X), (float*)(p.ws + WS_PRE)};
            pg8::gemm_phase<pg8::EpiP4, pg8::DenseSched, false>(lds, D, D, D, S, E);
        }
        SEAM(pb + 3);
        if (IN(pb + 4)) {
            const int tid = ltid();
            for (int u = bx; u < T / 32; u += G) ln1_router_unit(p, l, u, lds, tid);
        }
        SEAM(pb + 4);
        if (IN(pb + 5)) {
            moe_tables(p, l, tb, ltid());
            pg8::MoeSched<4, true> S; S.tb = tb; S.A = (const char*)(p.ws + WS_XB); S.B = wl + WL_GU; S.bexp = (size_t)1024 * D * 2; S.btile = (size_t)256 * D * 2;
            S.list = (const int*)(p.ws + WS_LIST) + (size_t)l * 64 * 8192; S.G = G; S.vcu = vcu;
            pg8::EpiP6 E{(bf16*)(p.ws + WS_H)};
            pg8::gemm_phase<pg8::EpiP6, pg8::MoeSched<4, true>, true>(lds, D, D, D, S, E);
        }
        SEAM(pb + 5);
        if (IN(pb + 6)) {
            moe_tables(p, l, tb, ltid());
            pg8::MoeSched<8, false> S; S.tb = tb; S.A = (const char*)(p.ws + WS_H); S.B = wl + WL_D; S.bexp = (size_t)D * EH * 2; S.btile = (size_t)256 * EH * 2;
            S.list = nullptr; S.G = G; S.vcu = vcu;
            pg8::EpiP7 E{(bf16*)(p.ws + WS_Y)};
            pg8::gemm_phase<pg8::EpiP7, pg8::MoeSched<8, false>, false>(lds, EH, EH, EH, S, E);
        }
        SEAM(pb + 6);
        if (IN(pb + 7)) {
            const int tid = ltid(), lane = tid & 63, wave = __builtin_amdgcn_readfirstlane(tid >> 6);
            moe_tables(p, l, tb, tid);
            const int gw = bx * 8 + wave, NGW = G * 8;
            for (int t = gw; t < T; t += NGW) combine_ln2_row(p, l, t, tb, lane, l == NL - 1);
        }
        SEAM(pb + 7);
    }
#undef IN
#undef SEAM
}

extern "C" void kernel_launch(void* const* d_in, const int* in_sizes, int n_in, void* d_out, int out_size, void* d_ws, size_t ws_size, hipStream_t stream) {
    static int grid = 0;
    if (grid == 0) {
        if (n_in != 27 || out_size != T * D || ws_size < WS_END) { fprintf(stderr, "kernel_launch: unexpected shapes (n_in %d out %d ws %zu, need %zu)\n", n_in, out_size, ws_size, (size_t)WS_END); grid = -1; return; }
        int dev = 0, cus = 0, per_cu = 0;
        if (hipGetDevice(&dev) != hipSuccess || hipDeviceGetAttribute(&cus, hipDeviceAttributeMultiprocessorCount, dev) != hipSuccess) { fprintf(stderr, "kernel_launch: device query failed\n"); grid = -1; return; }
        if (hipFuncSetAttribute((const void*)fwd, hipFuncAttributeMaxDynamicSharedMemorySize, LDS_BYTES) != hipSuccess) { fprintf(stderr, "kernel_launch: hipFuncSetAttribute failed\n"); grid = -1; return; }
        if (hipOccupancyMaxActiveBlocksPerMultiprocessor(&per_cu, (const void*)fwd, 512, LDS_BYTES) != hipSuccess || per_cu < 1) fprintf(stderr, "kernel_launch: note: occupancy query reports %d workgroups per CU\n", per_cu);
        (void)hipGetLastError();
        grid = cus;
    }
    if (grid < 0) return;
    if (hipMemsetAsync((char*)d_ws + WS_CTL, 0, 1 * MiB, stream) != hipSuccess) { fprintf(stderr, "kernel_launch: memset failed\n"); return; }
    Params p{};
    for (int i = 0; i < 27; ++i) p.in[i] = (const float*)d_in[i];
    p.out = (float*)d_out; p.ws = (unsigned char*)d_ws;
#if MK_N_LAUNCHES == 1
    p.ph_lo = 0; p.ph_hi = NPHASES;
    hipLaunchKernelGGL(fwd, dim3(grid), dim3(512), LDS_BYTES, stream, p);
#else
    for (int ph = 0; ph < NPHASES; ++ph) { p.ph_lo = ph; p.ph_hi = ph + 1; hipLaunchKernelGGL(fwd, dim3(grid), dim3(512), LDS_BYTES, stream, p); }
#endif
    const hipError_t le = hipPeekAtLastError();
    if (le != hipSuccess) fprintf(stderr, "kernel_launch: launch failed: %s\n", hipGetErrorName(le));
}
```

```cpp
#include <hip/hip_runtime.h>
#include <cstdio>
#include <cstdint>

#ifndef MK_N_LAUNCHES
#define MK_N_LAUNCHES 1
#endif

#ifndef REP_MASK
#define REP_MASK 0
#endif
#define REPS(k) (1 + ((REP_MASK >> (k)) & 1))
#define LAS __attribute__((address_space(3)))
typedef unsigned short bf16;
typedef short bf16x8 __attribute__((ext_vector_type(8)));
typedef float f32x4 __attribute__((ext_vector_type(4)));
typedef float f32x2 __attribute__((ext_vector_type(2)));
typedef unsigned u32x4 __attribute__((ext_vector_type(4)));
typedef unsigned u32x2 __attribute__((ext_vector_type(2)));

constexpr int T = 8192, D = 2048, NL = 2, INC = 6144, NE = 64, EH = 512;
constexpr float ALPHA = 1.41421356237309515f;
constexpr float LN_EPS = 1e-5f;
constexpr float ROUTED_SCALE = 2.5f;
constexpr int NPHASES = 1 + 8 * NL;

constexpr size_t MiB = 1ull << 20;
constexpr size_t WS_CTL = 0;
constexpr size_t WS_TOPE = 1 * MiB, WS_TOPPOS = WS_TOPE + 256 * 1024, WS_TOPW = WS_TOPPOS + 256 * 1024;
constexpr size_t WS_LIST = 2 * MiB;
constexpr size_t WS_X = 8 * MiB;
constexpr size_t WS_XB = 72 * MiB;
constexpr size_t WS_PROJ = 104 * MiB;
constexpr size_t WS_GATE = 200 * MiB;
constexpr size_t WS_YABC = 296 * MiB;
constexpr size_t WS_MERGED = 360 * MiB;
constexpr size_t WS_MF32 = 392 * MiB;
constexpr size_t WS_PRE = 456 * MiB;
constexpr size_t WS_H = 520 * MiB;
constexpr size_t WS_Y = 608 * MiB;
constexpr size_t WS_W = 960 * MiB;
constexpr int HROWS = 90112;
constexpr size_t WL_IG = 0;
constexpr size_t WL_ABC = 48 * MiB;
constexpr size_t WL_O = 60 * MiB;
constexpr size_t WL_GU = 68 * MiB;
constexpr size_t WL_D = 328 * MiB;
constexpr size_t WL_BYTES = 458 * MiB;
constexpr size_t WS_END = WS_W + 2 * WL_BYTES;
constexpr int CW_CNT = 1024;
constexpr int CW_BAR = 4096;
constexpr int LDS_BYTES = 147456;
constexpr int LDSCTL_OFF = 143360;
constexpr int MISC_OFF = LDSCTL_OFF + 2048;

struct Params { const float* in[27]; float* out; unsigned char* ws; int ph_lo, ph_hi; };

__device__ __forceinline__ float bf2f(unsigned b) { return __uint_as_float(b << 16); }
__device__ __forceinline__ float bflo(unsigned w) { return __uint_as_float(w << 16); }
__device__ __forceinline__ float bfhi(unsigned w) { return __uint_as_float(w & 0xffff0000u); }
__device__ __forceinline__ unsigned f2bf(float f) { unsigned u = __float_as_uint(f); return (u + 0x7fffu + ((u >> 16) & 1u)) >> 16; }
__device__ __forceinline__ unsigned pk2(float lo, float hi) { return f2bf(lo) | (f2bf(hi) << 16); }
__device__ __forceinline__ unsigned cvt_pk_bf16(float lo, float hi) { unsigned r; asm volatile("v_cvt_pk_bf16_f32 %0, %1, %2" : "=v"(r) : "v"(lo), "v"(hi)); return r; }
__device__ __forceinline__ float wave_sum(float v) {
#pragma unroll
    for (int o = 1; o < 64; o <<= 1) v += __shfl_xor(v, o);
    return v;
}
__device__ __forceinline__ int ltid() { int t = threadIdx.x; asm volatile("" : "+v"(t)); return t; }
__device__ __forceinline__ float sigmoidf_(float v) { return 1.0f / (1.0f + __expf(-v)); }
__device__ __forceinline__ float fast_sigmoid(float v) { return __builtin_amdgcn_rcpf(1.0f + __builtin_amdgcn_exp2f(v * -1.44269504089f)); }
__device__ __forceinline__ f32x2 gelu_pk(f32x2 v) {
    const f32x2 av = __builtin_elementwise_abs(v), d = av * 0.2316418882f + 1.0f;
    f32x2 t; t.x = __builtin_amdgcn_rcpf(d.x); t.y = __builtin_amdgcn_rcpf(d.y);
    f32x2 q = t * 0.5307027145f + (-0.7265760135f); q = q * t + 0.7107068705f; q = q * t + (-0.142248368f); q = q * t + 0.127414796f; q = q * t;
    const f32x2 s = (v * v) * (-0.72134752044f);
    f32x2 e; e.x = __builtin_amdgcn_exp2f(s.x); e.y = __builtin_amdgcn_exp2f(s.y);
    const f32x2 m = v * (q * e), r = v - m;
    f32x2 o; o.x = v.x < 0.f ? m.x : r.x; o.y = v.y < 0.f ? m.y : r.y; return o;
}

struct MoeTab { int cnt[65]; int rb[66]; int tq[66]; int pad[3]; };
__device__ __forceinline__ void moe_tables(const Params& p, int l, LAS MoeTab* tb, int tid) {
    __syncthreads();
    if (tid < 65) tb->cnt[tid] = (tid < 64) ? (int)__hip_atomic_load((unsigned*)(p.ws + WS_CTL) + CW_CNT + 64 * l + tid, __ATOMIC_RELAXED, __HIP_MEMORY_SCOPE_AGENT) : T;
    __syncthreads();
    if (tid == 0) { int rb = 0, tq = 0;
        for (int e = 0; e < 65; ++e) { const int n = tb->cnt[e]; tb->rb[e] = rb; tb->tq[e] = tq; rb += ((n + 255) >> 8) << 8; tq += (n + 255) >> 8; }
        tb->rb[65] = rb; tb->tq[65] = tq; }
    __syncthreads();
}

namespace pg8 {
constexpr int BM = 256, BK = 64, HALF = 128, HTB = HALF * BK * 2, STAGE_BYTES = 8 * HTB, NXCD = 8, WGM = 8;
__device__ __forceinline__ int lds_byte(int r, int c) { const int st = (r >> 4) * 2 + (c >> 5), rr = r & 15, cc = c & 31, ob = rr * 64 + cc * 2; return st * 1024 + (ob ^ (((ob >> 9) & 1) << 5)); }
__device__ __forceinline__ void stage_rc(int b, int& R, int& C) { const int st = b / 1024, sb = b % 1024, swz = sb ^ (((sb >> 9) & 1) << 5); R = (st >> 1) * 16 + swz / 64; C = (st & 1) * 32 + (swz % 64) / 2; }
__device__ __forceinline__ int perm32(int rho) { const int n = rho >> 4, i = rho & 15; return 8 * (i >> 2) + 4 * n + (i & 3); }

struct Unit { const char* A; const char* B; int orow, pn, seg, e, m0; };

__device__ __forceinline__ void tile_of(int L, int nM, int nN, int& pm, int& pn) {
    const int nwg = nM * nN; int wgid = L; { const int q = nwg / NXCD, r = nwg % NXCD, xcd = wgid % NXCD, off = wgid / NXCD; wgid = (xcd < r ? xcd * (q + 1) : r * (q + 1) + (xcd - r) * q) + off; }
    const int nig = WGM * nN, gid = wgid / nig, fm = gid * WGM, gsz = (nM - fm) < WGM ? (nM - fm) : WGM;
    pm = fm + ((wgid % nig) % gsz); pn = (wgid % nig) / gsz;
}
struct DenseSched {
    const char* A; const char* B; size_t atile, btile; int nM, nN, G, c;
    __device__ __forceinline__ bool next(int i, Unit& u) const {
        const int L = i * G + c; if (L >= nM * nN) return false;
        int pm, pn; tile_of(L, nM, nN, pm, pn);
        u.A = A + (size_t)pm * atile; u.B = B + (size_t)pn * btile; u.orow = pm * BM; u.pn = pn; u.seg = 0; u.e = 0; u.m0 = 0; return true; }
    __device__ __forceinline__ int row(const Unit&, int) const { return 0; }
};
struct ProjSched {
    const char* A; const char* B; int G, c;
    __device__ __forceinline__ bool next(int i, Unit& u) const {
        const int L = (i / 3) * G + c; if (L >= 32 * 8) return false;
        int pm, pn; tile_of(L, 32, 8, pm, pn); const int seg = i % 3;
        u.A = A + ((size_t)pm * BM * 3072 + (size_t)seg * 1024) * 2; u.B = B + ((size_t)seg * 2048 * 1024 + (size_t)pn * BM * 1024) * 2; u.orow = pm * BM; u.pn = pn; u.seg = seg; u.e = 0; u.m0 = 0; return true; }
    __device__ __forceinline__ int row(const Unit&, int) const { return 0; }
};
template <int NT, bool GATH> struct MoeSched {
    const LAS MoeTab* tb; const char* A; const char* B; size_t bexp, btile; const int* list; int G, vcu;
    __device__ __forceinline__ bool next(int i, Unit& u) const {
        const int L = i * G + vcu; if (L >= tb->tq[65] * NT) return false;
        const int mt = L / NT, pn = L % NT; int e = 0; while (tb->tq[e + 1] <= mt) ++e;
        const int m0 = (mt - tb->tq[e]) * BM;
        u.e = e; u.m0 = m0; u.orow = tb->rb[e] + m0; u.pn = pn; u.seg = 0;
        u.B = B + (size_t)e * bexp + (size_t)pn * btile;
        u.A = GATH ? A : A + (size_t)u.orow * EH * 2; return true; }
    __device__ __forceinline__ int row(const Unit& u, int r) const { const int idx = u.m0 + r; if (u.e == 64) return idx; return idx < tb->cnt[u.e] ? list[u.e * 8192 + idx] : 0; }
};

template <class Epi, class Sched, bool GATHER>
__device__ __forceinline__ void gemm_phase(LAS unsigned char* lds, const int K, const int lda, const int ldb, const Sched& S, const Epi& E) {
    const int tid = ltid(), wid = __builtin_amdgcn_readfirstlane(tid >> 6), lane = tid & 63, wr = wid >> 2, wc = wid & 3, fr = lane & 15, fq = lane >> 4;
    const int nt = K / BK;
    unsigned voffB[2], voffA[2][2], voffN[2][2]; int Rr[2], Cc[2];
#pragma unroll
    for (int i = 0; i < 2; ++i) { int R, C; stage_rc(tid * 16 + i * 8192, R, C); const int Rb = (R & ~31) + perm32(R & 31);
        Rr[i] = R; Cc[i] = C; voffB[i] = (unsigned)(Rb * ldb + C) * 2u;
        voffA[0][i] = (unsigned)(R * lda + C) * 2u; voffA[1][i] = (unsigned)((R + HALF) * lda + C) * 2u; voffN[0][i] = voffA[0][i]; voffN[1][i] = voffA[1][i]; }
    const size_t kstep = (size_t)(BK * 2);
    const size_t hstepB = (size_t)HALF * ldb * 2;
    const unsigned ldsw = (unsigned)wid * 1024u;
    const int aoff = lds_byte(wr * 64 + fr, fq * 8), boff = lds_byte(wc * 32 + fr, fq * 8);
#define PG8_SA(b, h) (((b) * 2 + (h)) * HTB)
#define PG8_SB(b, h) ((4 + (b) * 2 + (h)) * HTB)
#define PG8_STAGE_B(bufoff, gbase) do { _Pragma("unroll") for (int _i = 0; _i < 2; ++_i) \
        __builtin_amdgcn_global_load_lds((const unsigned*)((const char*)(gbase) + voffB[_i]), (LAS unsigned*)(lds + (bufoff) + ldsw + _i * 8192), 16, 0, 0); } while (0)
#define PG8_STAGE_A(bufoff, gbase, VO, h) do { _Pragma("unroll") for (int _i = 0; _i < 2; ++_i) \
        __builtin_amdgcn_global_load_lds((const unsigned*)((const char*)(gbase) + (VO)[h][_i]), (LAS unsigned*)(lds + (bufoff) + ldsw + _i * 8192), 16, 0, 0); } while (0)
#define PG8_LDA(dst, b, h) do { _Pragma("unroll") for (int m = 0; m < 4; ++m) _Pragma("unroll") for (int k = 0; k < 2; ++k) dst[m][k] = *(const LAS bf16x8*)(lds + PG8_SA(b, h) + aoff + m * 2048 + k * 1024); } while (0)
#define PG8_LDB(dst, b, h) do { _Pragma("unroll") for (int n = 0; n < 2; ++n) _Pragma("unroll") for (int k = 0; k < 2; ++k) dst[n][k] = *(const LAS bf16x8*)(lds + PG8_SB(b, h) + boff + n * 2048 + k * 1024); } while (0)
#define PG8_MMA(ai, bj, At, Bt) do { __builtin_amdgcn_s_setprio(1); _Pragma("unroll") for (int m = 0; m < 4; ++m) _Pragma("unroll") for (int n = 0; n < 2; ++n) _Pragma("unroll") for (int k = 0; k < 2; ++k) \
        acc[ai][bj][m][n] = __builtin_amdgcn_mfma_f32_16x16x32_bf16(Bt[n][k], At[m][k], acc[ai][bj][m][n], 0, 0, 0); __builtin_amdgcn_s_setprio(0); } while (0)
#define PG8_WAIT_V(n) asm volatile("s_waitcnt vmcnt(" #n ")" ::: "memory")
#define PG8_WAIT_L(n) asm volatile("s_waitcnt lgkmcnt(" #n ")" ::: "memory")
#define PG8_BAR __builtin_amdgcn_s_barrier()
#define PG8_SCHED __builtin_amdgcn_sched_barrier(0)
    Unit cur, nxt; int ui = 0;
    if (!S.next(0, cur)) return;
    if constexpr (GATHER) {
#pragma unroll
        for (int h = 0; h < 2; ++h)
#pragma unroll
            for (int i = 0; i < 2; ++i) voffA[h][i] = (unsigned)(S.row(cur, Rr[i] + h * HALF) * lda + Cc[i]) * 2u;
    }
    f32x4 acc[2][2][4][2];
#pragma unroll
    for (int a = 0; a < 2; ++a)
#pragma unroll
        for (int b = 0; b < 2; ++b)
#pragma unroll
            for (int m = 0; m < 4; ++m)
#pragma unroll
                for (int n = 0; n < 2; ++n) acc[a][b][m][n] = (f32x4){0.f, 0.f, 0.f, 0.f};
    bf16x8 At[4][2], B0[2][2], B1[2][2];
    const char* cA = cur.A; const char* cB = cur.B;
    PG8_STAGE_B(PG8_SB(0, 0), cB); PG8_STAGE_B(PG8_SB(0, 1), cB + hstepB); PG8_STAGE_A(PG8_SA(0, 0), cA, voffA, 0); PG8_STAGE_A(PG8_SA(0, 1), cA, voffA, 1);
    if (wr == 1) PG8_BAR;
    PG8_WAIT_V(2); PG8_BAR;
    PG8_STAGE_B(PG8_SB(1, 0), cB + kstep); PG8_STAGE_A(PG8_SA(1, 0), cA + kstep, voffA, 0); PG8_STAGE_B(PG8_SB(1, 1), cB + hstepB + kstep);
    PG8_WAIT_V(6); PG8_BAR;
    for (;;) {
        const bool has_next = S.next(ui + 1, nxt);
        if constexpr (GATHER) {
            if (has_next) {
#pragma unroll
                for (int h = 0; h < 2; ++h)
#pragma unroll
                    for (int i = 0; i < 2; ++i) voffN[h][i] = (unsigned)(S.row(nxt, Rr[i] + h * HALF) * lda + Cc[i]) * 2u;
            } else {
#pragma unroll
                for (int h = 0; h < 2; ++h)
#pragma unroll
                    for (int i = 0; i < 2; ++i) voffN[h][i] = voffA[h][i];
            }
        }
        const char* nA = has_next ? nxt.A : cA; const char* nB = has_next ? nxt.B : cB;
        for (int t = 0; t < nt; t += 2) {
            const bool last = (t == nt - 2);
            const char* a1 = cA + (size_t)(t + 1) * kstep;
            const char* a2 = last ? nA : cA + (size_t)(t + 2) * kstep; const char* b2 = last ? nB : cB + (size_t)(t + 2) * kstep;
            const char* a3 = a2 + kstep; const char* b3 = b2 + kstep;
            unsigned vo2[2][2];
#pragma unroll
            for (int h = 0; h < 2; ++h)
#pragma unroll
                for (int i = 0; i < 2; ++i) vo2[h][i] = (GATHER && last) ? voffN[h][i] : voffA[h][i];
            PG8_LDB(B0, 0, 0); PG8_LDB(B1, 0, 1); PG8_SCHED; PG8_LDA(At, 0, 0); PG8_STAGE_A(PG8_SA(1, 1), a1, voffA, 1);
            PG8_WAIT_V(8); PG8_WAIT_L(0); PG8_BAR; PG8_MMA(0, 0, At, B0); PG8_MMA(0, 1, At, B1); PG8_BAR; PG8_SCHED;
            PG8_LDA(At, 0, 1); PG8_STAGE_B(PG8_SB(0, 0), b2); PG8_STAGE_B(PG8_SB(0, 1), b2 + hstepB); PG8_STAGE_A(PG8_SA(0, 0), a2, vo2, 0);
            PG8_WAIT_V(8); PG8_WAIT_L(0); PG8_BAR; PG8_MMA(1, 0, At, B0); PG8_MMA(1, 1, At, B1); PG8_BAR; PG8_SCHED;
            PG8_LDB(B0, 1, 0); PG8_LDB(B1, 1, 1); PG8_SCHED; PG8_LDA(At, 1, 0); PG8_STAGE_A(PG8_SA(0, 1), a2, vo2, 1);
            PG8_WAIT_V(8); PG8_WAIT_L(0); PG8_BAR; PG8_MMA(0, 0, At, B0); PG8_MMA(0, 1, At, B1); PG8_BAR; PG8_SCHED;
            PG8_LDA(At, 1, 1); PG8_STAGE_B(PG8_SB(1, 0), b3); PG8_STAGE_B(PG8_SB(1, 1), b3 + hstepB); PG8_STAGE_A(PG8_SA(1, 0), a3, vo2, 0);
            PG8_WAIT_V(8); PG8_WAIT_L(0); PG8_BAR; PG8_MMA(1, 0, At, B0); PG8_MMA(1, 1, At, B1); PG8_BAR; PG8_SCHED;
        }
        if (wr == 0) PG8_BAR;
        E(acc, cur, wr, wc, fr, fq);
        if (!has_next) break;
#pragma unroll
        for (int a = 0; a < 2; ++a)
#pragma unroll
            for (int b = 0; b < 2; ++b)
#pragma unroll
                for (int m = 0; m < 4; ++m)
#pragma unroll
                    for (int n = 0; n < 2; ++n) acc[a][b][m][n] = (f32x4){0.f, 0.f, 0.f, 0.f};
        cur = nxt; cA = nA; cB = nB; ++ui;
        if constexpr (GATHER) {
#pragma unroll
            for (int h = 0; h < 2; ++h)
#pragma unroll
                for (int i = 0; i < 2; ++i) voffA[h][i] = voffN[h][i];
        }
        if (wr == 1) PG8_BAR;
    }
    PG8_WAIT_V(0);
    PG8_BAR;
#undef PG8_SA
#undef PG8_SB
#undef PG8_STAGE_A
#undef PG8_STAGE_B
#undef PG8_LDA
#undef PG8_LDB
#undef PG8_MMA
#undef PG8_WAIT_V
#undef PG8_WAIT_L
#undef PG8_BAR
#undef PG8_SCHED
}

#define EPI_ROWCOL const int row0 = u.orow + wr * 64 + fr, colw = wc * 32 + 8 * fq
struct EpiP1 {
    bf16* PROJ; bf16* GATE; const float* bgate;
    __device__ __forceinline__ void operator()(const f32x4 (&acc)[2][2][4][2], const Unit& u, int wr, int wc, int fr, int fq) const {
        EPI_ROWCOL; const int pn = u.pn; const int mode = pn < 8 ? 1 : (pn < 24 ? 0 : 2);
        bf16* base = (mode == 2) ? GATE : PROJ; const int colt = ((mode == 2) ? (pn - 24) : pn) * BM + colw;
        f32x4 bv[2][2];
#pragma unroll
        for (int bj = 0; bj < 2; ++bj)
#pragma unroll
            for (int n = 0; n < 2; ++n) { const f32x4 t = *(const f32x4*)(bgate + ((mode == 2) ? colt : colw) + bj * HALF + 4 * n); bv[bj][n] = (mode == 2) ? t : (f32x4){0.f, 0.f, 0.f, 0.f}; }
#pragma unroll
        for (int ai = 0; ai < 2; ++ai)
#pragma unroll
            for (int m = 0; m < 4; ++m) { bf16* rowp = base + (size_t)(row0 + ai * HALF + m * 16) * INC + colt;
#pragma unroll
                for (int bj = 0; bj < 2; ++bj) { f32x4 v0 = acc[ai][bj][m][0] + bv[bj][0], v1 = acc[ai][bj][m][1] + bv[bj][1];
                    if (mode == 1) { const f32x2 a = gelu_pk((f32x2){v0[0], v0[1]}), b = gelu_pk((f32x2){v0[2], v0[3]}), c = gelu_pk((f32x2){v1[0], v1[1]}), d = gelu_pk((f32x2){v1[2], v1[3]});
                        v0 = (f32x4){a.x, a.y, b.x, b.y}; v1 = (f32x4){c.x, c.y, d.x, d.y}; }
                    else if (mode == 2) {
#pragma unroll
                        for (int j = 0; j < 4; ++j) { v0[j] = fast_sigmoid(v0[j]); v1[j] = fast_sigmoid(v1[j]); } }
                    u32x4 w; w.x = cvt_pk_bf16(v0[0], v0[1]); w.y = cvt_pk_bf16(v0[2], v0[3]); w.z = cvt_pk_bf16(v1[0], v1[1]); w.w = cvt_pk_bf16(v1[2], v1[3]);
                    *(u32x4*)(rowp + bj * HALF) = w; } }
    }
};
struct EpiP3 {
    const bf16* GATE; float* MF; bf16* MG;
    __device__ __forceinline__ void operator()(const f32x4 (&acc)[2][2][4][2], const Unit& u, int wr, int wc, int fr, int fq) const {
        EPI_ROWCOL; const int seg = u.seg;
#pragma unroll
        for (int ai = 0; ai < 2; ++ai)
#pragma unroll
            for (int m = 0; m < 4; ++m) { const size_t r = (size_t)(row0 + ai * HALF + m * 16);
#pragma unroll
                for (int bj = 0; bj < 2; ++bj) { const int col = u.pn * BM + bj * HALF + colw;
                    const u32x4 gw = *(const u32x4*)(GATE + r * INC + seg * D + col);
                    f32x4 r0 = acc[ai][bj][m][0], r1 = acc[ai][bj][m][1];
                    r0[0] *= bflo(gw.x); r0[1] *= bfhi(gw.x); r0[2] *= bflo(gw.y); r0[3] *= bfhi(gw.y); r1[0] *= bflo(gw.z); r1[1] *= bfhi(gw.z); r1[2] *= bflo(gw.w); r1[3] *= bfhi(gw.w);
                    float* mp = MF + r * D + col;
                    if (seg > 0) { r0 += *(const f32x4*)mp; r1 += *(const f32x4*)(mp + 4); }
                    if (seg < 2) { *(f32x4*)mp = r0; *(f32x4*)(mp + 4) = r1; }
                    else { u32x4 w; w.x = cvt_pk_bf16(r0[0], r0[1]); w.y = cvt_pk_bf16(r0[2], r0[3]); w.z = cvt_pk_bf16(r1[0], r1[1]); w.w = cvt_pk_bf16(r1[2], r1[3]); *(u32x4*)(MG + r * D + col) = w; } }
                asm volatile("" ::: "memory"); }
    }
};
struct EpiP4 {
    const float* X; float* PRE;
    __device__ __forceinline__ void operator()(const f32x4 (&acc)[2][2][4][2], const Unit& u, int wr, int wc, int fr, int fq) const {
        EPI_ROWCOL;
#pragma unroll
        for (int ai = 0; ai < 2; ++ai)
#pragma unroll
            for (int m = 0; m < 4; ++m) { const size_t r = (size_t)(row0 + ai * HALF + m * 16);
#pragma unroll
                for (int bj = 0; bj < 2; ++bj) { const size_t o = r * D + u.pn * BM + bj * HALF + colw;
                    const f32x4 x0 = *(const f32x4*)(X + o), x1 = *(const f32x4*)(X + o + 4);
                    *(f32x4*)(PRE + o) = x0 * ALPHA + acc[ai][bj][m][0]; *(f32x4*)(PRE + o + 4) = x1 * ALPHA + acc[ai][bj][m][1]; }
                asm volatile("" ::: "memory"); }
    }
};
struct EpiP6 {
    bf16* H;
    __device__ __forceinline__ void operator()(const f32x4 (&acc)[2][2][4][2], const Unit& u, int wr, int wc, int fr, int fq) const {
        EPI_ROWCOL;
#pragma unroll
        for (int ai = 0; ai < 2; ++ai)
#pragma unroll
            for (int m = 0; m < 4; ++m) { const size_t r = (size_t)(row0 + ai * HALF + m * 16);
                float h[8];
#pragma unroll
                for (int n = 0; n < 2; ++n)
#pragma unroll
                    for (int j = 0; j < 4; ++j) { const float g = acc[ai][0][m][n][j], up = acc[ai][1][m][n][j]; h[4 * n + j] = g * fast_sigmoid(g) * up; }
                u32x4 w; w.x = cvt_pk_bf16(h[0], h[1]); w.y = cvt_pk_bf16(h[2], h[3]); w.z = cvt_pk_bf16(h[4], h[5]); w.w = cvt_pk_bf16(h[6], h[7]);
                *(u32x4*)(H + r * EH + u.pn * HALF + colw) = w; }
    }
};
struct EpiP7 {
    bf16* Y;
    __device__ __forceinline__ void operator()(const f32x4 (&acc)[2][2][4][2], const Unit& u, int wr, int wc, int fr, int fq) const {
        EPI_ROWCOL;
#pragma unroll
        for (int ai = 0; ai < 2; ++ai)
#pragma unroll
            for (int m = 0; m < 4; ++m) { bf16* rowp = Y + (size_t)(row0 + ai * HALF + m * 16) * D + u.pn * BM + colw;
#pragma unroll
                for (int bj = 0; bj < 2; ++bj) { const f32x4 v0 = acc[ai][bj][m][0], v1 = acc[ai][bj][m][1];
                    u32x4 w; w.x = cvt_pk_bf16(v0[0], v0[1]); w.y = cvt_pk_bf16(v0[2], v0[3]); w.z = cvt_pk_bf16(v1[0], v1[1]); w.w = cvt_pk_bf16(v1[2], v1[3]);
                    *(u32x4*)(rowp + bj * HALF) = w; } }
    }
};
}

#define XB_TMO      128
#define XB_XCNT(j)  (256  + 64 * (j))
#define XB_XSUB(j)  (1280 + 64 * (j))
#define XB_XGEN(j)  (2304 + 64 * (j))
#define XB_TOP      3328
#define XB_TOPGEN   3392
#define XCD_BAR_WORDS 3456
#define XB_SPIN_CAP (1u << 18)
__device__ __forceinline__ unsigned xb_ld(unsigned* p)              { return __hip_atomic_load(p, __ATOMIC_RELAXED, __HIP_MEMORY_SCOPE_AGENT); }
__device__ __forceinline__ unsigned xb_add(unsigned* p, unsigned v) { return __hip_atomic_fetch_add(p, v, __ATOMIC_RELAXED, __HIP_MEMORY_SCOPE_AGENT); }
__device__ __forceinline__ unsigned xb_xcc_id() { return (unsigned)__builtin_amdgcn_s_getreg((3 << 11) | 20) & 0xFu; }
#define XB_SPIN(cond, bar) do { unsigned _sp = 0; while (cond) { __builtin_amdgcn_s_sleep(1); \
    if ((++_sp & 255u) == 0u) { if (xb_ld(&(bar)[XB_TMO])) break; if (_sp > XB_SPIN_CAP) { atomicAdd(&(bar)[XB_TMO], 1u); break; } } } } while (0)
struct XcdBarrier { unsigned* bar; unsigned x; volatile LAS unsigned* st; };
__device__ __forceinline__ XcdBarrier xcd_barrier_post(unsigned* bar, volatile LAS unsigned* st) {
    XcdBarrier b; b.bar = bar; b.x = xb_xcc_id(); b.st = st;
    if (threadIdx.x == 0) (void)xb_add(&bar[XB_XCNT(b.x)], 1u);
    return b;
}
__device__ __forceinline__ void xcd_barrier_complete(unsigned* bar, unsigned x, unsigned& nloc, unsigned& nx) {
    const unsigned G = gridDim.x * gridDim.y * gridDim.z;
    unsigned sum, cnt, mine, sp = 0u;
    for (;;) {
        sum = 0u; cnt = 0u; mine = 0u;
#pragma unroll
        for (unsigned j = 0; j < 16; ++j) { const unsigned c = xb_ld(&bar[XB_XCNT(j)]); sum += c; cnt += (c > 0u) ? 1u : 0u; mine = (j == x) ? c : mine; }
        if (sum == G) break;
        __builtin_amdgcn_s_sleep(1);
        if ((++sp & 255u) == 0u) { if (xb_ld(&bar[XB_TMO])) break; if (sp > XB_SPIN_CAP) { atomicAdd(&bar[XB_TMO], 1u); break; } }
    }
    nloc = mine > 0u ? mine : 1u; nx = cnt > 0u ? cnt : 1u;
}
__device__ __forceinline__ void xcd_barrier(const XcdBarrier& b) {
    asm volatile("s_waitcnt vmcnt(0)" ::: "memory");
    __syncthreads();
    if (threadIdx.x == 0) {
        unsigned* bar = b.bar;
        __builtin_amdgcn_s_waitcnt(0);
        unsigned nloc = b.st[0], nx = b.st[1];
        if (nloc == 0u) { xcd_barrier_complete(bar, b.x, nloc, nx); b.st[0] = nloc; b.st[1] = nx; }
        const unsigned old = xb_add(&bar[XB_XSUB(b.x)], 1u);
        const unsigned gen = old / nloc;
        if (old + 1u == (gen + 1u) * nloc) {
            __builtin_amdgcn_fence(__ATOMIC_RELEASE, "agent");
            asm volatile("s_waitcnt vmcnt(0)" ::: "memory");
            const unsigned og = xb_add(&bar[XB_TOP], 1u);
            const unsigned tg = og / nx;
            if (og + 1u == (tg + 1u) * nx) xb_add(&bar[XB_TOPGEN], 1u);
            else XB_SPIN(xb_ld(&bar[XB_TOPGEN]) == tg, bar);
            __builtin_amdgcn_fence(__ATOMIC_ACQUIRE, "agent");
            xb_add(&bar[XB_XGEN(b.x)], 1u);
            asm volatile("s_waitcnt vmcnt(0)" ::: "memory");
        } else {
            XB_SPIN(xb_ld(&bar[XB_XGEN(b.x)]) == gen, bar);
            __builtin_amdgcn_fence(__ATOMIC_ACQUIRE, "agent");
            asm volatile("s_waitcnt vmcnt(0)" ::: "memory");
        }
    }
    __syncthreads();
}

template <int MAP>
__device__ __forceinline__ void ln_finish(float (&v)[32], const float* __restrict__ g, const float* __restrict__ b, float* xout, bf16* xbout, int lane) {
    float s = 0.f;
#pragma unroll
    for (int i = 0; i < 32; ++i) s += v[i];
    const float mean = wave_sum(s) * (1.0f / D);
    float q = 0.f;
#pragma unroll
    for (int i = 0; i < 32; ++i) { v[i] -= mean; q += v[i] * v[i]; }
    const float rstd = 1.0f / sqrtf(wave_sum(q) * (1.0f / D) + LN_EPS);
    if (MAP == 0) {
#pragma unroll
        for (int j = 0; j < 8; ++j) {
            const int c = 4 * (lane + 64 * j);
            const f32x4 gv = *(const f32x4*)(g + c), bv = *(const f32x4*)(b + c);
            f32x4 o; o.x = v[4 * j] * rstd * gv.x + bv.x; o.y = v[4 * j + 1] * rstd * gv.y + bv.y; o.z = v[4 * j + 2] * rstd * gv.z + bv.z; o.w = v[4 * j + 3] * rstd * gv.w + bv.w;
            *(f32x4*)(xout + c) = o;
            if (xbout) { u32x2 w; w.x = pk2(o.x, o.y); w.y = pk2(o.z, o.w); *(u32x2*)(xbout + c) = w; }
        }
    } else {
#pragma unroll
        for (int j = 0; j < 4; ++j) {
            const int c = 8 * (lane + 64 * j);
            const f32x4 g0 = *(const f32x4*)(g + c), g1 = *(const f32x4*)(g + c + 4), b0 = *(const f32x4*)(b + c), b1 = *(const f32x4*)(b + c + 4);
            f32x4 o0, o1;
            o0.x = v[8 * j] * rstd * g0.x + b0.x; o0.y = v[8 * j + 1] * rstd * g0.y + b0.y; o0.z = v[8 * j + 2] * rstd * g0.z + b0.z; o0.w = v[8 * j + 3] * rstd * g0.w + b0.w;
            o1.x = v[8 * j + 4] * rstd * g1.x + b1.x; o1.y = v[8 * j + 5] * rstd * g1.y + b1.y; o1.z = v[8 * j + 6] * rstd * g1.z + b1.z; o1.w = v[8 * j + 7] * rstd * g1.w + b1.w;
            *(f32x4*)(xout + c) = o0; *(f32x4*)(xout + c + 4) = o1;
            if (xbout) { u32x4 w; w.x = pk2(o0.x, o0.y); w.y = pk2(o0.z, o0.w); w.z = pk2(o1.x, o1.y); w.w = pk2(o1.z, o1.w); *(u32x4*)(xbout + c) = w; }
        }
    }
}
__device__ __forceinline__ void entry_ln_row(const Params& p, int t, int lane) {
    float* X = (float*)(p.ws + WS_X); bf16* XB = (bf16*)(p.ws + WS_XB);
    float v[32]; const float* xr = p.in[0] + (size_t)t * D;
#pragma unroll
    for (int j = 0; j < 8; ++j) { const f32x4 a = *(const f32x4*)(xr + 4 * (lane + 64 * j)); v[4 * j] = a.x; v[4 * j + 1] = a.y; v[4 * j + 2] = a.z; v[4 * j + 3] = a.w; }
    ln_finish<0>(v, p.in[1], p.in[2], X + (size_t)t * D, XB + (size_t)t * D, lane);
}

__device__ __forceinline__ void spatial_unit(const Params& p, int l, int unit, LAS unsigned char* lds, int tid) {
    const int nb = unit >> 2, g = unit & 3, lane = tid & 63, wid = __builtin_amdgcn_readfirstlane(tid >> 6), fr = lane & 15, fq = lane >> 4;
    LAS bf16* VT = (LAS bf16*)lds; LAS bf16* WM = (LAS bf16*)(lds + 69632);
    const bf16* PROJ = (const bf16*)(p.ws + WS_PROJ); bf16* YABC = (bf16*)(p.ws + WS_YABC);
    const float* ws = p.in[4] + ((size_t)l * 4 + g) * 128 * 128; const float* bs = p.in[5] + ((size_t)l * 4 + g) * 128;
#pragma unroll
    for (int q = 0; q < 8; ++q) { const int pc = tid + 512 * q, i = pc >> 5, j4 = (pc & 31) * 4; const f32x4 w = *(const f32x4*)(ws + i * 128 + j4);
        u32x2 o; o.x = pk2(w.x, w.y); o.y = pk2(w.z, w.w); *(LAS u32x2*)(WM + i * 136 + j4) = o; }
    {
        const int j = wid * 16 + fr; const bf16* vp = PROJ + ((size_t)nb * 128 + j) * INC + 1024 + g * 256 + fq * 8;
        float v[64];
#pragma unroll
        for (int q = 0; q < 8; ++q) { const u32x4 w = *(const u32x4*)(vp + q * 32);
            v[8 * q] = bflo(w.x); v[8 * q + 1] = bfhi(w.x); v[8 * q + 2] = bflo(w.y); v[8 * q + 3] = bfhi(w.y); v[8 * q + 4] = bflo(w.z); v[8 * q + 5] = bfhi(w.z); v[8 * q + 6] = bflo(w.w); v[8 * q + 7] = bfhi(w.w); }
        float sm = 0.f;
#pragma unroll
        for (int i = 0; i < 64; ++i) sm += v[i];
        sm += __shfl_xor(sm, 16); sm += __shfl_xor(sm, 32);
        const float mean = sm * (1.0f / 256.0f); float sq = 0.f;
#pragma unroll
        for (int i = 0; i < 64; ++i) { v[i] -= mean; sq += v[i] * v[i]; }
        sq += __shfl_xor(sq, 16); sq += __shfl_xor(sq, 32);
        const float rstd = 1.0f / sqrtf(sq * (1.0f / 256.0f) + LN_EPS);
#pragma unroll
        for (int q = 0; q < 8; ++q)
#pragma unroll
            for (int i = 0; i < 8; ++i) VT[(q * 32 + fq * 8 + i) * 136 + j] = (bf16)f2bf(v[8 * q + i] * rstd);
    }
    __syncthreads();
    f32x4 acc[2][8];
#pragma unroll
    for (int cf = 0; cf < 2; ++cf)
#pragma unroll
        for (int f = 0; f < 8; ++f) acc[cf][f] = (f32x4){0.f, 0.f, 0.f, 0.f};
#pragma unroll
    for (int ks = 0; ks < 4; ++ks) {
        bf16x8 a[2];
#pragma unroll
        for (int cf = 0; cf < 2; ++cf) a[cf] = *(const LAS bf16x8*)(VT + (wid * 32 + cf * 16 + fr) * 136 + ks * 32 + fq * 8);
#pragma unroll
        for (int f = 0; f < 8; ++f) {
            if (ks >= 2 && f < 4) continue;
            const bf16x8 b = *(const LAS bf16x8*)(WM + (f * 16 + fr) * 136 + ks * 32 + fq * 8);
#pragma unroll
            for (int cf = 0; cf < 2; ++cf) acc[cf][f] = __builtin_amdgcn_mfma_f32_16x16x32_bf16(a[cf], b, acc[cf][f], 0, 0, 0);
        }
    }
#pragma unroll
    for (int f = 0; f < 8; ++f) {
        const int i = f * 16 + fr; const size_t t = (size_t)nb * 128 + i; const float bias = bs[i];
#pragma unroll
        for (int cf = 0; cf < 2; ++cf) { const int c = g * 256 + wid * 32 + cf * 16 + 4 * fq;
            const u32x2 uw = *(const u32x2*)(PROJ + t * INC + c);
            u32x2 o; o.x = pk2(bflo(uw.x) * (acc[cf][f][0] + bias), bfhi(uw.x) * (acc[cf][f][1] + bias)); o.y = pk2(bflo(uw.y) * (acc[cf][f][2] + bias), bfhi(uw.y) * (acc[cf][f][3] + bias));
            *(u32x2*)(YABC + t * 3072 + c) = o; }
    }
    __syncthreads();
}
__device__ __forceinline__ void ld8(const bf16* ptr, float (&f)[8]) {
    const u32x4 w = *(const u32x4*)ptr;
    f[0] = bflo(w.x); f[1] = bfhi(w.x); f[2] = bflo(w.y); f[3] = bfhi(w.y); f[4] = bflo(w.z); f[5] = bfhi(w.z); f[6] = bflo(w.w); f[7] = bfhi(w.w);
}
__device__ __forceinline__ void st8(bf16* ptr, const float (&f)[8]) {
    u32x4 w; w.x = pk2(f[0], f[1]); w.y = pk2(f[2], f[3]); w.z = pk2(f[4], f[5]); w.w = pk2(f[6], f[7]); *(u32x4*)ptr = w;
}
__device__ __forceinline__ void conv_task(const Params& p, int l, int t0, int c) {
    const bf16* PROJ = (const bf16*)(p.ws + WS_PROJ); bf16* YABC = (bf16*)(p.ws + WS_YABC);
    float w0[8], w1[8], w2[8], z2[8], z1[8];
    { const float* wc = p.in[6] + (size_t)l * 3 * 1024 + c;
      const f32x4 a0 = *(const f32x4*)wc, a1 = *(const f32x4*)(wc + 4), b0 = *(const f32x4*)(wc + 1024), b1 = *(const f32x4*)(wc + 1028), c0 = *(const f32x4*)(wc + 2048), c1 = *(const f32x4*)(wc + 2052);
      w0[0] = a0.x; w0[1] = a0.y; w0[2] = a0.z; w0[3] = a0.w; w0[4] = a1.x; w0[5] = a1.y; w0[6] = a1.z; w0[7] = a1.w;
      w1[0] = b0.x; w1[1] = b0.y; w1[2] = b0.z; w1[3] = b0.w; w1[4] = b1.x; w1[5] = b1.y; w1[6] = b1.z; w1[7] = b1.w;
      w2[0] = c0.x; w2[1] = c0.y; w2[2] = c0.z; w2[3] = c0.w; w2[4] = c1.x; w2[5] = c1.y; w2[6] = c1.z; w2[7] = c1.w; }
#pragma unroll
    for (int i = 0; i < 8; ++i) { z2[i] = 0.f; z1[i] = 0.f; }
    if (t0 >= 2) { float cg[8], hh[8]; ld8(PROJ + (size_t)(t0 - 2) * INC + 3072 + c, cg); ld8(PROJ + (size_t)(t0 - 2) * INC + 4096 + c, hh);
#pragma unroll
        for (int i = 0; i < 8; ++i) z2[i] = cg[i] * hh[i];
        ld8(PROJ + (size_t)(t0 - 1) * INC + 3072 + c, cg); ld8(PROJ + (size_t)(t0 - 1) * INC + 4096 + c, hh);
#pragma unroll
        for (int i = 0; i < 8; ++i) z1[i] = cg[i] * hh[i]; }
#pragma unroll
    for (int k = 0; k < 16; ++k) { const size_t t = (size_t)(t0 + k);
        float bgv[8], cg[8], hh[8], o[8]; ld8(PROJ + t * INC + 2048 + c, bgv); ld8(PROJ + t * INC + 3072 + c, cg); ld8(PROJ + t * INC + 4096 + c, hh);
#pragma unroll
        for (int i = 0; i < 8; ++i) { const float z0 = cg[i] * hh[i]; o[i] = bgv[i] * (w0[i] * z2[i] + w1[i] * z1[i] + w2[i] * z0); z2[i] = z1[i]; z1[i] = z0; }
        st8(YABC + t * 3072 + 1024 + c, o); }
}
template <int WIN> __device__ __forceinline__ void pool_task(const Params& p, int t0, int c) {
    const bf16* PROJ = (const bf16*)(p.ws + WS_PROJ); bf16* YABC = (bf16*)(p.ws + WS_YABC);
    float ring[WIN][8], tot[8];
#pragma unroll
    for (int i = 0; i < 8; ++i) tot[i] = 0.f;
#pragma unroll
    for (int d = 1 - WIN; d < 0; ++d) {
        if (t0 > 0) { ld8(PROJ + (size_t)(t0 + d) * INC + 5120 + c, ring[(d + WIN) % WIN]);
#pragma unroll
            for (int i = 0; i < 8; ++i) tot[i] += ring[(d + WIN) % WIN][i]; }
        else {
#pragma unroll
            for (int i = 0; i < 8; ++i) ring[(d + WIN) % WIN][i] = 0.f; }
    }
#pragma unroll
    for (int k = 0; k < 16; ++k) { const int t = t0 + k;
        float cur[8], o[8]; ld8(PROJ + (size_t)t * INC + 5120 + c, cur);
        const float inv = (k + 1 < WIN && t0 == 0) ? 1.0f / (float)(k + 1) : 1.0f / (float)WIN;
#pragma unroll
        for (int i = 0; i < 8; ++i) { tot[i] += cur[i]; o[i] = tot[i] * inv - cur[i]; ring[k % WIN][i] = cur[i]; }
        st8(YABC + (size_t)t * 3072 + 2048 + c, o);
#pragma unroll
        for (int i = 0; i < 8; ++i) tot[i] -= ring[(k + 1) % WIN][i];
    }
}
__device__ __forceinline__ void convpool_task(const Params& p, int l, int task) {
    if (task < 65536) { conv_task(p, l, (task >> 7) * 16, (task & 127) * 8); return; }
    const int k = task - 65536, g = __builtin_amdgcn_readfirstlane((k >> 6) & 3), run = ((k >> 8) << 1) + ((k >> 5) & 1), c = (g * 32 + (k & 31)) * 8, t0 = run * 16;
    if (g == 0) pool_task<2>(p, t0, c); else if (g == 1) pool_task<4>(p, t0, c); else if (g == 2) pool_task<8>(p, t0, c); else pool_task<16>(p, t0, c);
}

__device__ __forceinline__ void ln1_router_unit(const Params& p, int l, int unit, LAS unsigned char* lds, int tid) {
    LAS float* xs = (LAS float*)lds; LAS float* lg = xs + 32 * 260; LAS float* gs = lg + 32 * 64; LAS int* le = (LAS int*)(gs + 32 * 8); LAS float* lw = (LAS float*)(le + 32 * 8);
    LAS int* cnt = (LAS int*)(lw + 32 * 8); LAS int* base = cnt + 64;
    const int lane = tid & 63, wid = tid >> 6; const int t0 = unit * 32;
    const float* PRE = (const float*)(p.ws + WS_PRE); float* X = (float*)(p.ws + WS_X); bf16* XB = (bf16*)(p.ws + WS_XB);
    for (int r = 0; r < 4; ++r) {
        const int t = t0 + wid * 4 + r; float v[32]; const float* xr = PRE + (size_t)t * D;
#pragma unroll
        for (int j = 0; j < 8; ++j) { const f32x4 a = *(const f32x4*)(xr + 4 * (lane + 64 * j)); v[4 * j] = a.x; v[4 * j + 1] = a.y; v[4 * j + 2] = a.z; v[4 * j + 3] = a.w; }
        ln_finish<0>(v, p.in[15] + (size_t)l * D, p.in[16] + (size_t)l * D, X + (size_t)t * D, XB + (size_t)t * D, lane);
    }
    if (tid < 64) cnt[tid] = 0;
    __threadfence_block();
    __syncthreads();
    const float* wr = p.in[17] + (size_t)l * D * NE;
    float a0 = 0.f, a1 = 0.f, a2 = 0.f, a3 = 0.f;
    for (int kc = 0; kc < D; kc += 256) {
#pragma unroll
        for (int i = 0; i < 4; ++i) { const int pc = tid + 512 * i, rr = pc >> 6, cc = (pc & 63) * 4; *(LAS f32x4*)(xs + rr * 260 + cc) = *(const f32x4*)(X + (size_t)(t0 + rr) * D + kc + cc); }
        __syncthreads();
        const LAS float* x0 = xs + (wid * 4) * 260;
        for (int k = 0; k < 256; k += 4) {
            const f32x4 xa = *(const LAS f32x4*)(x0 + k), xb = *(const LAS f32x4*)(x0 + 260 + k), xc = *(const LAS f32x4*)(x0 + 520 + k), xd = *(const LAS f32x4*)(x0 + 780 + k);
            const float w0 = wr[(size_t)(kc + k) * NE + lane], w1 = wr[(size_t)(kc + k + 1) * NE + lane], w2 = wr[(size_t)(kc + k + 2) * NE + lane], w3 = wr[(size_t)(kc + k + 3) * NE + lane];
            a0 += xa.x * w0; a0 += xa.y * w1; a0 += xa.z * w2; a0 += xa.w * w3;
            a1 += xb.x * w0; a1 += xb.y * w1; a1 += xb.z * w2; a1 += xb.w * w3;
            a2 += xc.x * w0; a2 += xc.y * w1; a2 += xc.z * w2; a2 += xc.w * w3;
            a3 += xd.x * w0; a3 += xd.y * w1; a3 += xd.z * w2; a3 += xd.w * w3;
        }
        __syncthreads();
    }
    lg[(wid * 4 + 0) * 64 + lane] = sigmoidf_(a0); lg[(wid * 4 + 1) * 64 + lane] = sigmoidf_(a1); lg[(wid * 4 + 2) * 64 + lane] = sigmoidf_(a2); lg[(wid * 4 + 3) * 64 + lane] = sigmoidf_(a3);
    __syncthreads();
    const float* rb = p.in[18] + (size_t)l * NE;
    if (tid < 32) {
        const LAS float* sc = lg + tid * 64;
        for (int g = 0; g < 8; ++g) { float m1 = -INFINITY, m2 = -INFINITY;
            for (int j = 0; j < 8; ++j) { const float s = sc[g * 8 + j] + rb[g * 8 + j]; if (s > m1) { m2 = m1; m1 = s; } else if (s > m2) m2 = s; }
            gs[tid * 8 + g] = m1 + m2; }
        unsigned gmask = 0;
        for (int it = 0; it < 4; ++it) { float best = -INFINITY; int bi = 0;
            for (int g = 0; g < 8; ++g) { const float s = gs[tid * 8 + g]; if (!((gmask >> g) & 1u) && s > best) { best = s; bi = g; } }
            gmask |= 1u << bi; }
        unsigned long long chosen = 0ull; float wsum = 0.f;
        for (int it = 0; it < 8; ++it) { float best = -INFINITY; int bi = -1;
            for (int e = 0; e < 64; ++e) { if (!((gmask >> (e >> 3)) & 1u) || ((chosen >> e) & 1ull)) continue; const float s = sc[e] + rb[e]; if (bi < 0 || s > best) { best = s; bi = e; } }
            chosen |= 1ull << bi; const float w = sc[bi]; wsum += w; le[tid * 8 + it] = bi; lw[tid * 8 + it] = w; }
        const float scale = ROUTED_SCALE / wsum;
        for (int it = 0; it < 8; ++it) { lw[tid * 8 + it] *= scale; }
    }
    __syncthreads();
    int myrank = 0, mye = 0;
    if (tid < 256) { mye = le[tid]; myrank = atomicAdd((int*)&cnt[mye], 1); }
    __syncthreads();
    if (tid < 64) { const int c = cnt[tid]; base[tid] = c ? (int)atomicAdd((unsigned*)(p.ws + WS_CTL) + CW_CNT + 64 * l + tid, (unsigned)c) : 0; }
    __syncthreads();
    if (tid < 256) {
        const int t = t0 + (tid >> 3), s = tid & 7, pos = base[mye] + myrank;
        ((int*)(p.ws + WS_TOPE))[t * 8 + s] = mye; ((int*)(p.ws + WS_TOPPOS))[t * 8 + s] = pos; ((float*)(p.ws + WS_TOPW))[t * 8 + s] = lw[tid];
        ((int*)(p.ws + WS_LIST))[((size_t)l * 64 + mye) * 8192 + pos] = t;
    }
    __syncthreads();
}

__device__ __forceinline__ void combine_ln2_row(const Params& p, int l, int t, const LAS MoeTab* tb, int lane, bool last) {
    const bf16* Y = (const bf16*)(p.ws + WS_Y); float* X = (float*)(p.ws + WS_X); bf16* XB = (bf16*)(p.ws + WS_XB);
    float v[32];
    const float* xr = X + (size_t)t * D;
#pragma unroll
    for (int j = 0; j < 4; ++j) { const int c = 8 * (lane + 64 * j); const f32x4 a = *(const f32x4*)(xr + c), b = *(const f32x4*)(xr + c + 4);
        v[8 * j] = ALPHA * a.x; v[8 * j + 1] = ALPHA * a.y; v[8 * j + 2] = ALPHA * a.z; v[8 * j + 3] = ALPHA * a.w; v[8 * j + 4] = ALPHA * b.x; v[8 * j + 5] = ALPHA * b.y; v[8 * j + 6] = ALPHA * b.z; v[8 * j + 7] = ALPHA * b.w; }
    for (int s = 0; s < 9; ++s) {
        int row; float w;
        if (s < 8) {
            const int e = (int)__hip_atomic_load((unsigned*)(p.ws + WS_TOPE) + t * 8 + s, __ATOMIC_RELAXED, __HIP_MEMORY_SCOPE_AGENT);
            row = tb->rb[e] + (int)__hip_atomic_load((unsigned*)(p.ws + WS_TOPPOS) + t * 8 + s, __ATOMIC_RELAXED, __HIP_MEMORY_SCOPE_AGENT);
            w = __uint_as_float(__hip_atomic_load((unsigned*)(p.ws + WS_TOPW) + t * 8 + s, __ATOMIC_RELAXED, __HIP_MEMORY_SCOPE_AGENT)); }
        else { row = tb->rb[64] + t; w = 1.0f; }
        const bf16* yr = Y + (size_t)row * D;
#pragma unroll
        for (int j = 0; j < 4; ++j) { float f[8]; ld8(yr + 8 * (lane + 64 * j), f);
#pragma unroll
            for (int i = 0; i < 8; ++i) v[8 * j + i] += w * f[i]; }
    }
    float* xo = last ? p.out + (size_t)t * D : X + (size_t)t * D;
    ln_finish<1>(v, p.in[25] + (size_t)l * D, p.in[26] + (size_t)l * D, xo, last ? nullptr : XB + (size_t)t * D, lane);
}

__device__ __forceinline__ void tr_item(const float* __restrict__ src, int ldsrc, bf16* dst, int lddst, LAS float* scr, int lane) {
    f32x4 v[16];
    const int kr = lane >> 4, n4 = (lane & 15) * 4;
#pragma unroll
    for (int q = 0; q < 16; ++q) v[q] = __builtin_nontemporal_load((const f32x4*)(src + (size_t)(4 * q + kr) * ldsrc + n4));
#pragma unroll
    for (int q = 0; q < 16; ++q) { const int k = 4 * q + kr; *(LAS f32x4*)(scr + k * 64 + (n4 ^ (8 * (k >> 3)))) = v[q]; }
    asm volatile("s_waitcnt lgkmcnt(0)" ::: "memory");
    const int kg = lane >> 3, r = lane & 7;
#pragma unroll
    for (int s = 0; s < 8; ++s) {
        const int n = 8 * s + r; const LAS float* sp = scr + (8 * kg) * 64 + (n ^ (8 * kg));
        u32x4 w; w.x = pk2(sp[0], sp[64]); w.y = pk2(sp[128], sp[192]); w.z = pk2(sp[256], sp[320]); w.w = pk2(sp[384], sp[448]);
        *(u32x4*)(dst + (size_t)n * lddst + 8 * kg) = w;
    }
    asm volatile("s_waitcnt lgkmcnt(0)" ::: "memory");
}
constexpr int I_IN = 32 * 96, I_PA = 16 * 32, I_O = 32 * 32, I_EX = 65 * 256, I_LAYER = 2 * I_IN + 2 * I_PA + I_O + 3 * I_EX;
__device__ __forceinline__ void prologue_item(const Params& p, int it, LAS float* scr, int lane) {
    const int l = it / I_LAYER; int r = it % I_LAYER;
    unsigned char* wl = p.ws + WS_W + (size_t)l * WL_BYTES;
    if (r < 2 * I_IN) {
        const int which = r / I_IN; r %= I_IN; const int kb = r / 96, nb = r % 96;
        const float* src = p.in[which ? 9 : 3] + (size_t)l * D * INC + (size_t)(kb * 64) * INC + nb * 64;
        tr_item(src, INC, (bf16*)(wl + WL_IG) + (size_t)(which * INC + nb * 64) * D + kb * 64, D, scr, lane); return; }
    r -= 2 * I_IN;
    if (r < 2 * I_PA) {
        const int which = r / I_PA; r %= I_PA; const int kb = r / 32, nb = r % 32;
        const float* src = p.in[11 + which] + (size_t)l * 1024 * D + (size_t)(kb * 64) * D + nb * 64;
        tr_item(src, D, (bf16*)(wl + WL_ABC) + (size_t)which * D * 1024 + (size_t)(nb * 64) * 1024 + kb * 64, 1024, scr, lane); return; }
    r -= 2 * I_PA;
    if (r < I_O) {
        const int kb = r / 32, nb = r % 32;
        const float* src = p.in[14] + (size_t)l * D * D + (size_t)(kb * 64) * D + nb * 64;
        tr_item(src, D, (bf16*)(wl + WL_O) + (size_t)(nb * 64) * D + kb * 64, D, scr, lane); return; }
    r -= I_O;
    const int kind = r / I_EX; r %= I_EX; const int e = r >> 8; r &= 255;
    if (kind < 2) {
        const int kb = r >> 3, nb = r & 7, n0 = nb * 64;
        const float* src = (e < 64 ? p.in[19 + kind] + ((size_t)l * 64 + e) * D * EH : p.in[22 + kind] + (size_t)l * D * EH) + (size_t)(kb * 64) * EH + n0;
        const int drow = (n0 >> 7) * 256 + kind * 128 + (n0 & 127);
        tr_item(src, EH, (bf16*)(wl + WL_GU) + (size_t)e * 1024 * D + (size_t)drow * D + kb * 64, D, scr, lane);
    } else {
        const int kb = r >> 5, nb = r & 31;
        const float* src = (e < 64 ? p.in[21] + ((size_t)l * 64 + e) * EH * D : p.in[24] + (size_t)l * EH * D) + (size_t)(kb * 64) * D + nb * 64;
        tr_item(src, D, (bf16*)(wl + WL_D) + (size_t)e * D * EH + (size_t)(nb * 64) * EH + kb * 64, EH, scr, lane);
    }
}
__device__ __forceinline__ void wcprime_tile(const Params& p, int tile, LAS bf16* sA, LAS bf16* sB, int tid) {
    const int l = tile >> 8, g = (tile >> 6) & 3, tm = (tile >> 5) & 1, tn = tile & 31;
    const int lane = tid & 63, wid = tid >> 6, wm = wid >> 1, wn = wid & 1, fr = lane & 15, fq = lane >> 4;
    const float* Ap = p.in[7] + ((size_t)l * 4 + g) * 256 * 256; const float* sc = p.in[8] + (size_t)l * 1024 + g * 256;
    const float* Wp = p.in[13] + (size_t)l * 1024 * D + (size_t)(g * 256) * D;
    bf16* dst = (bf16*)(p.ws + WS_W + (size_t)l * WL_BYTES + WL_ABC) + (size_t)2 * D * 1024;
    f32x4 acc[2][2];
#pragma unroll
    for (int a = 0; a < 2; ++a)
#pragma unroll
        for (int b = 0; b < 2; ++b) acc[a][b] = (f32x4){0.f, 0.f, 0.f, 0.f};
    const int ar = tid >> 2, akseg = (tid & 3) * 8, wk = tid >> 4, wns = (tid & 15) * 4;
    for (int k0 = 0; k0 < 256; k0 += 32) {
        const float* ap = Ap + (size_t)(tm * 128 + ar) * 256 + k0 + akseg;
        const f32x4 x0 = *(const f32x4*)ap, x1 = *(const f32x4*)(ap + 4), s0 = *(const f32x4*)(sc + k0 + akseg), s1 = *(const f32x4*)(sc + k0 + akseg + 4);
        u32x4 av; av.x = pk2(x0.x * s0.x, x0.y * s0.y); av.y = pk2(x0.z * s0.z, x0.w * s0.w); av.z = pk2(x1.x * s1.x, x1.y * s1.y); av.w = pk2(x1.z * s1.z, x1.w * s1.w);
        const f32x4 wv = *(const f32x4*)(Wp + (size_t)(k0 + wk) * D + tn * 64 + wns);
        *(LAS u32x4*)(sA + ar * 40 + akseg) = av;
        sB[(wns + 0) * 40 + wk] = (bf16)f2bf(wv.x); sB[(wns + 1) * 40 + wk] = (bf16)f2bf(wv.y); sB[(wns + 2) * 40 + wk] = (bf16)f2bf(wv.z); sB[(wns + 3) * 40 + wk] = (bf16)f2bf(wv.w);
        __syncthreads();
#pragma unroll
        for (int mi = 0; mi < 2; ++mi) {
            const bf16x8 a = *(const LAS bf16x8*)(sA + (wm * 32 + mi * 16 + fr) * 40 + fq * 8);
#pragma unroll
            for (int ni = 0; ni < 2; ++ni) {
                const bf16x8 b = *(const LAS bf16x8*)(sB + (wn * 32 + ni * 16 + fr) * 40 + fq * 8);
                acc[mi][ni] = __builtin_amdgcn_mfma_f32_16x16x32_bf16(a, b, acc[mi][ni], 0, 0, 0);
            }
        }
        __syncthreads();
    }
#pragma unroll
    for (int mi = 0; mi < 2; ++mi)
#pragma unroll
        for (int ni = 0; ni < 2; ++ni)
#pragma unroll
            for (int j = 0; j < 4; ++j) { const int c = tm * 128 + wm * 32 + mi * 16 + fq * 4 + j, n = tn * 64 + wn * 32 + ni * 16 + fr;
                dst[(size_t)n * 1024 + g * 256 + c] = (bf16)f2bf(acc[mi][ni][j]); }
}

__global__ void __launch_bounds__(512, 2) fwd(Params p) {
    extern __shared__ __attribute__((aligned(16))) unsigned char lds_raw[];
    LAS unsigned char* lds = (LAS unsigned char*)lds_raw;
    LAS MoeTab* tb = (LAS MoeTab*)(lds + LDSCTL_OFF);
    volatile LAS unsigned* MISC = (volatile LAS unsigned*)(lds + MISC_OFF);
    const int G = gridDim.x, bx = blockIdx.x; const int vcu = (G % 8 == 0) ? (bx % 8) * (G / 8) + bx / 8 : bx;
    if (threadIdx.x < 32) MISC[threadIdx.x] = 0u;
    __syncthreads();
    unsigned* ctl = (unsigned*)(p.ws + WS_CTL);
    XcdBarrier bar; bar.bar = ctl + CW_BAR; bar.x = 0; bar.st = nullptr;
    const int lo = p.ph_lo, hi = p.ph_hi;
    if (hi - lo > 1) bar = xcd_barrier_post(ctl + CW_BAR, MISC + 8);
#define IN(k) (lo <= (k) && (k) < hi)
#define SEAM(k) do { if (IN(k) && IN((k) + 1)) xcd_barrier(bar); } while (0)

    if (IN(0)) for (int rep = 0; rep < REPS(0); ++rep) {
        const int tid = ltid(), lane = tid & 63, wave = __builtin_amdgcn_readfirstlane(tid >> 6);
        LAS float* scr = (LAS float*)(lds + wave * 16384);
        const int gw = vcu * 8 + wave, NGW = G * 8;
        for (int it = gw; it < NL * I_LAYER; it += NGW) prologue_item(p, it, scr, lane);
        for (int t = gw; t < T; t += NGW) entry_ln_row(p, t, lane);
        __syncthreads();
        for (int tile = bx; tile < 512; tile += G) wcprime_tile(p, tile, (LAS bf16*)lds, (LAS bf16*)(lds + 16384), tid);
    }
    SEAM(0);

    for (int l = 0; l < NL; ++l) {
        const int pb = 1 + 8 * l;
        const char* wl = (const char*)(p.ws + WS_W + (size_t)l * WL_BYTES);
        if (IN(pb + 0)) for (int rep = 0; rep < REPS(1); ++rep) {
            pg8::DenseSched S; S.A = (const char*)(p.ws + WS_XB); S.B = wl + WL_IG; S.atile = (size_t)256 * D * 2; S.btile = (size_t)256 * D * 2; S.nM = 32; S.nN = 48; S.G = G; S.c = bx;
            pg8::EpiP1 E{(bf16*)(p.ws + WS_PROJ), (bf16*)(p.ws + WS_GATE), p.in[10] + (size_t)l * INC};
            pg8::gemm_phase<pg8::EpiP1, pg8::DenseSched, false>(lds, D, D, D, S, E);
        }
        SEAM(pb + 0);
        if (IN(pb + 1)) for (int rep = 0; rep < REPS(2); ++rep) {
            const int tid = ltid();
            for (int u = bx; u < 256; u += G) spatial_unit(p, l, u, lds, tid);
            for (int it = bx * 512 + tid; it < 131072; it += G * 512) convpool_task(p, l, it);
        }
        SEAM(pb + 1);
        if (IN(pb + 2)) for (int rep = 0; rep < REPS(3); ++rep) {
            pg8::ProjSched S; S.A = (const char*)(p.ws + WS_YABC); S.B = wl + WL_ABC; S.G = G; S.c = bx;
            pg8::EpiP3 E{(const bf16*)(p.ws + WS_GATE), (float*)(p.ws + WS_MF32), (bf16*)(p.ws + WS_MERGED)};
            pg8::gemm_phase<pg8::EpiP3, pg8::ProjSched, false>(lds, 1024, 3072, 1024, S, E);
        }
        SEAM(pb + 2);
        if (IN(pb + 3)) for (int rep = 0; rep < REPS(4); ++rep) {
            pg8::DenseSched S; S.A = (const char*)(p.ws + WS_MERGED); S.B = wl + WL_O; S.atile = (size_t)256 * D * 2; S.btile = (size_t)256 * D * 2; S.nM = 32; S.nN = 8; S.G = G; S.c = bx;
            pg8::EpiP4 E{(const float*)(p.ws + WS_X), (float*)(p.ws + WS_PRE)};
            pg8::gemm_phase<pg8::EpiP4, pg8::DenseSched, false>(lds, D, D, D, S, E);
        }
        SEAM(pb + 3);
        if (IN(pb + 4)) {
            const int tid = ltid();
            for (int u = bx; u < T / 32; u += G) ln1_router_unit(p, l, u, lds, tid);
        }
        SEAM(pb + 4);
        if (IN(pb + 5)) for (int rep = 0; rep < REPS(6); ++rep) {
            moe_tables(p, l, tb, ltid());
            pg8::MoeSched<4, true> S; S.tb = tb; S.A = (const char*)(p.ws + WS_XB); S.B = wl + WL_GU; S.bexp = (size_t)1024 * D * 2; S.btile = (size_t)256 * D * 2;
            S.list = (const int*)(p.ws + WS_LIST) + (size_t)l * 64 * 8192; S.G = G; S.vcu = vcu;
            pg8::EpiP6 E{(bf16*)(p.ws + WS_H)};
            pg8::gemm_phase<pg8::EpiP6, pg8::MoeSched<4, true>, true>(lds, D, D, D, S, E);
        }
        SEAM(pb + 5);
        if (IN(pb + 6)) for (int rep = 0; rep < REPS(7); ++rep) {
            moe_tables(p, l, tb, ltid());
            pg8::MoeSched<8, false> S; S.tb = tb; S.A = (const char*)(p.ws + WS_H); S.B = wl + WL_D; S.bexp = (size_t)D * EH * 2; S.btile = (size_t)256 * EH * 2;
            S.list = nullptr; S.G = G; S.vcu = vcu;
            pg8::EpiP7 E{(bf16*)(p.ws + WS_Y)};
            pg8::gemm_phase<pg8::EpiP7, pg8::MoeSched<8, false>, false>(lds, EH, EH, EH, S, E);
        }
        SEAM(pb + 6);
        if (IN(pb + 7)) {
            const int tid = ltid(), lane = tid & 63, wave = __builtin_amdgcn_readfirstlane(tid >> 6);
            moe_tables(p, l, tb, tid);
            const int gw = bx * 8 + wave, NGW = G * 8;
            for (int t = gw; t < T; t += NGW) combine_ln2_row(p, l, t, tb, lane, l == NL - 1);
        }
        SEAM(pb + 7);
    }
#undef IN
#undef SEAM
}

extern "C" void kernel_launch(void* const* d_in, const int* in_sizes, int n_in, void* d_out, int out_size, void* d_ws, size_t ws_size, hipStream_t stream) {
    static int grid = 0;
    if (grid == 0) {
        if (n_in != 27 || out_size != T * D || ws_size < WS_END) { fprintf(stderr, "kernel_launch: unexpected shapes (n_in %d out %d ws %zu, need %zu)\n", n_in, out_size, ws_size, (size_t)WS_END); grid = -1; return; }
        int dev = 0, cus = 0, per_cu = 0;
        if (hipGetDevice(&dev) != hipSuccess || hipDeviceGetAttribute(&cus, hipDeviceAttributeMultiprocessorCount, dev) != hipSuccess) { fprintf(stderr, "kernel_launch: device query failed\n"); grid = -1; return; }
        if (hipFuncSetAttribute((const void*)fwd, hipFuncAttributeMaxDynamicSharedMemorySize, LDS_BYTES) != hipSuccess) { fprintf(stderr, "kernel_launch: hipFuncSetAttribute failed\n"); grid = -1; return; }
        if (hipOccupancyMaxActiveBlocksPerMultiprocessor(&per_cu, (const void*)fwd, 512, LDS_BYTES) != hipSuccess || per_cu < 1) fprintf(stderr, "kernel_launch: note: occupancy query reports %d workgroups per CU\n", per_cu);
        (void)hipGetLastError();
        grid = cus;
    }
    if (grid < 0) return;
    if (hipMemsetAsync((char*)d_ws + WS_CTL, 0, 1 * MiB, stream) != hipSuccess) { fprintf(stderr, "kernel_launch: memset failed\n"); return; }
    Params p{};
    for (int i = 0; i < 27; ++i) p.in[i] = (const float*)d_in[i];
    p.out = (float*)d_out; p.ws = (unsigned char*)d_ws;
#if MK_N_LAUNCHES == 1
    p.ph_lo = 0; p.ph_hi = NPHASES;
    hipLaunchKernelGGL(fwd, dim3(grid), dim3(512), LDS_BYTES, stream, p);
#else
    for (int ph = 0; ph < NPHASES; ++ph) { p.ph_lo = ph; p.ph_hi = ph + 1; hipLaunchKernelGGL(fwd, dim3(grid), dim3(512), LDS_BYTES, stream, p); }
#endif
    const hipError_t le = hipPeekAtLastError();
    if (le != hipSuccess) fprintf(stderr, "kernel_launch: launch failed: %s\n", hipGetErrorName(le));
}
```

```cpp
#include <hip/hip_runtime.h>
#include <cstdio>
#include <cstdint>

#ifndef MK_N_LAUNCHES
#define MK_N_LAUNCHES 1
#endif

#ifndef REP_MASK
#define REP_MASK 0
#endif
#define REPS(k) (1 + ((REP_MASK >> (k)) & 1))
#define LAS __attribute__((address_space(3)))
typedef unsigned short bf16;
typedef short bf16x8 __attribute__((ext_vector_type(8)));
typedef float f32x4 __attribute__((ext_vector_type(4)));
typedef float f32x2 __attribute__((ext_vector_type(2)));
typedef unsigned u32x4 __attribute__((ext_vector_type(4)));
typedef unsigned u32x2 __attribute__((ext_vector_type(2)));

constexpr int T = 8192, D = 2048, NL = 2, INC = 6144, NE = 64, EH = 512;
constexpr float ALPHA = 1.41421356237309515f;
constexpr float LN_EPS = 1e-5f;
constexpr float ROUTED_SCALE = 2.5f;
constexpr int NPHASES = 1 + 8 * NL;

constexpr size_t MiB = 1ull << 20;
constexpr size_t WS_CTL = 0;
constexpr size_t WS_TOPE = 1 * MiB, WS_TOPPOS = WS_TOPE + 256 * 1024, WS_TOPW = WS_TOPPOS + 256 * 1024;
constexpr size_t WS_LIST = 2 * MiB;
constexpr size_t WS_X = 8 * MiB;
constexpr size_t WS_XB = 72 * MiB;
constexpr size_t WS_PROJ = 104 * MiB;
constexpr size_t WS_GATE = 200 * MiB;
constexpr size_t WS_YABC = 296 * MiB;
constexpr size_t WS_MERGED = 360 * MiB;
constexpr size_t WS_MF32 = 392 * MiB;
constexpr size_t WS_PRE = 456 * MiB;
constexpr size_t WS_H = 520 * MiB;
constexpr size_t WS_Y = 608 * MiB;
constexpr size_t WS_W = 960 * MiB;
constexpr int HROWS = 90112;
constexpr size_t WL_IG = 0;
constexpr size_t WL_ABC = 48 * MiB;
constexpr size_t WL_O = 60 * MiB;
constexpr size_t WL_GU = 68 * MiB;
constexpr size_t WL_D = 328 * MiB;
constexpr size_t WL_BYTES = 458 * MiB;
constexpr size_t WS_END = WS_W + 2 * WL_BYTES;
constexpr int CW_CNT = 1024;
constexpr int CW_BAR = 4096;
constexpr int LDS_BYTES = 147456;
constexpr int LDSCTL_OFF = 143360;
constexpr int MISC_OFF = LDSCTL_OFF + 2048;

struct Params { const float* in[27]; float* out; unsigned char* ws; int ph_lo, ph_hi; };

__device__ __forceinline__ float bf2f(unsigned b) { return __uint_as_float(b << 16); }
__device__ __forceinline__ float bflo(unsigned w) { return __uint_as_float(w << 16); }
__device__ __forceinline__ float bfhi(unsigned w) { return __uint_as_float(w & 0xffff0000u); }
__device__ __forceinline__ unsigned f2bf(float f) { unsigned u = __float_as_uint(f); return (u + 0x7fffu + ((u >> 16) & 1u)) >> 16; }
__device__ __forceinline__ unsigned pk2(float lo, float hi) { return f2bf(lo) | (f2bf(hi) << 16); }
__device__ __forceinline__ unsigned cvt_pk_bf16(float lo, float hi) { unsigned r; asm volatile("v_cvt_pk_bf16_f32 %0, %1, %2" : "=v"(r) : "v"(lo), "v"(hi)); return r; }
__device__ __forceinline__ float wave_sum(float v) {
#pragma unroll
    for (int o = 1; o < 64; o <<= 1) v += __shfl_xor(v, o);
    return v;
}
__device__ __forceinline__ int ltid() { int t = threadIdx.x; asm volatile("" : "+v"(t)); return t; }
__device__ __forceinline__ float sigmoidf_(float v) { return 1.0f / (1.0f + __expf(-v)); }
__device__ __forceinline__ float fast_sigmoid(float v) { return __builtin_amdgcn_rcpf(1.0f + __builtin_amdgcn_exp2f(v * -1.44269504089f)); }
__device__ __forceinline__ f32x2 gelu_pk(f32x2 v) {
    const f32x2 av = __builtin_elementwise_abs(v), d = av * 0.2316418882f + 1.0f;
    f32x2 t; t.x = __builtin_amdgcn_rcpf(d.x); t.y = __builtin_amdgcn_rcpf(d.y);
    f32x2 q = t * 0.5307027145f + (-0.7265760135f); q = q * t + 0.7107068705f; q = q * t + (-0.142248368f); q = q * t + 0.127414796f; q = q * t;
    const f32x2 s = (v * v) * (-0.72134752044f);
    f32x2 e; e.x = __builtin_amdgcn_exp2f(s.x); e.y = __builtin_amdgcn_exp2f(s.y);
    const f32x2 m = v * (q * e), r = v - m;
    f32x2 o; o.x = v.x < 0.f ? m.x : r.x; o.y = v.y < 0.f ? m.y : r.y; return o;
}

struct MoeTab { int cnt[65]; int rb[66]; int tq[66]; int pad[3]; };
__device__ __forceinline__ void moe_tables(const Params& p, int l, LAS MoeTab* tb, int tid) {
    __syncthreads();
    if (tid < 65) tb->cnt[tid] = (tid < 64) ? (int)__hip_atomic_load((unsigned*)(p.ws + WS_CTL) + CW_CNT + 64 * l + tid, __ATOMIC_RELAXED, __HIP_MEMORY_SCOPE_AGENT) : T;
    __syncthreads();
    if (tid == 0) { int rb = 0, tq = 0;
        for (int e = 0; e < 65; ++e) { const int n = tb->cnt[e]; tb->rb[e] = rb; tb->tq[e] = tq; rb += ((n + 255) >> 8) << 8; tq += (n + 255) >> 8; }
        tb->rb[65] = rb; tb->tq[65] = tq; }
    __syncthreads();
}

namespace pg8 {
constexpr int BM = 256, BK = 64, HALF = 128, HTB = HALF * BK * 2, STAGE_BYTES = 8 * HTB, NXCD = 8, WGM = 8;
__device__ __forceinline__ int lds_byte(int r, int c) { const int st = (r >> 4) * 2 + (c >> 5), rr = r & 15, cc = c & 31, ob = rr * 64 + cc * 2; return st * 1024 + (ob ^ (((ob >> 9) & 1) << 5)); }
__device__ __forceinline__ void stage_rc(int b, int& R, int& C) { const int st = b / 1024, sb = b % 1024, swz = sb ^ (((sb >> 9) & 1) << 5); R = (st >> 1) * 16 + swz / 64; C = (st & 1) * 32 + (swz % 64) / 2; }
__device__ __forceinline__ int perm32(int rho) { const int n = rho >> 4, i = rho & 15; return 8 * (i >> 2) + 4 * n + (i & 3); }

struct Unit { const char* A; const char* B; int orow, pn, seg, e, m0; };

__device__ __forceinline__ void tile_of(int L, int nM, int nN, int& pm, int& pn) {
    const int nwg = nM * nN; int wgid = L; { const int q = nwg / NXCD, r = nwg % NXCD, xcd = wgid % NXCD, off = wgid / NXCD; wgid = (xcd < r ? xcd * (q + 1) : r * (q + 1) + (xcd - r) * q) + off; }
    const int nig = WGM * nN, gid = wgid / nig, fm = gid * WGM, gsz = (nM - fm) < WGM ? (nM - fm) : WGM;
    pm = fm + ((wgid % nig) % gsz); pn = (wgid % nig) / gsz;
}
struct DenseSched {
    const char* A; const char* B; size_t atile, btile; int nM, nN, G, c;
    __device__ __forceinline__ bool next(int i, Unit& u) const {
        const int L = i * G + c; if (L >= nM * nN) return false;
        int pm, pn; tile_of(L, nM, nN, pm, pn);
        u.A = A + (size_t)pm * atile; u.B = B + (size_t)pn * btile; u.orow = pm * BM; u.pn = pn; u.seg = 0; u.e = 0; u.m0 = 0; return true; }
    __device__ __forceinline__ int row(const Unit&, int) const { return 0; }
};
struct ProjSched {
    const char* A; const char* B; int G, c;
    __device__ __forceinline__ bool next(int i, Unit& u) const {
        const int L = (i / 3) * G + c; if (L >= 32 * 8) return false;
        int pm, pn; tile_of(L, 32, 8, pm, pn); const int seg = i % 3;
        u.A = A + ((size_t)pm * BM * 3072 + (size_t)seg * 1024) * 2; u.B = B + ((size_t)seg * 2048 * 1024 + (size_t)pn * BM * 1024) * 2; u.orow = pm * BM; u.pn = pn; u.seg = seg; u.e = 0; u.m0 = 0; return true; }
    __device__ __forceinline__ int row(const Unit&, int) const { return 0; }
};
template <int NT, bool GATH> struct MoeSched {
    const LAS MoeTab* tb; const char* A; const char* B; size_t bexp, btile; const int* list; int G, vcu;
    __device__ __forceinline__ bool next(int i, Unit& u) const {
        const int L = i * G + vcu; if (L >= tb->tq[65] * NT) return false;
        const int mt = L / NT, pn = L % NT; int e = 0; while (tb->tq[e + 1] <= mt) ++e;
        const int m0 = (mt - tb->tq[e]) * BM;
        u.e = e; u.m0 = m0; u.orow = tb->rb[e] + m0; u.pn = pn; u.seg = 0;
        u.B = B + (size_t)e * bexp + (size_t)pn * btile;
        u.A = GATH ? A : A + (size_t)u.orow * EH * 2; return true; }
    __device__ __forceinline__ int row(const Unit& u, int r) const { const int idx = u.m0 + r; if (u.e == 64) return idx; return idx < tb->cnt[u.e] ? list[u.e * 8192 + idx] : 0; }
};

template <class Epi, class Sched, bool GATHER>
__device__ __forceinline__ void gemm_phase(LAS unsigned char* lds, const int K, const int lda, const int ldb, const Sched& S, const Epi& E) {
    const int tid = ltid(), wid = __builtin_amdgcn_readfirstlane(tid >> 6), lane = tid & 63, wr = wid >> 2, wc = wid & 3, fr = lane & 15, fq = lane >> 4;
    const int nt = K / BK;
    unsigned voffB[2], voffA[2][2], voffN[2][2]; int Rr[2], Cc[2];
#pragma unroll
    for (int i = 0; i < 2; ++i) { int R, C; stage_rc(tid * 16 + i * 8192, R, C); const int Rb = (R & ~31) + perm32(R & 31);
        Rr[i] = R; Cc[i] = C; voffB[i] = (unsigned)(Rb * ldb + C) * 2u;
        voffA[0][i] = (unsigned)(R * lda + C) * 2u; voffA[1][i] = (unsigned)((R + HALF) * lda + C) * 2u; voffN[0][i] = voffA[0][i]; voffN[1][i] = voffA[1][i]; }
    const size_t kstep = (size_t)(BK * 2);
    const size_t hstepB = (size_t)HALF * ldb * 2;
    const unsigned ldsw = (unsigned)wid * 1024u;
    const int aoff = lds_byte(wr * 64 + fr, fq * 8), boff = lds_byte(wc * 32 + fr, fq * 8);
#define PG8_SA(b, h) (((b) * 2 + (h)) * HTB)
#define PG8_SB(b, h) ((4 + (b) * 2 + (h)) * HTB)
#define PG8_STAGE_B(bufoff, gbase) do { _Pragma("unroll") for (int _i = 0; _i < 2; ++_i) \
        __builtin_amdgcn_global_load_lds((const unsigned*)((const char*)(gbase) + voffB[_i]), (LAS unsigned*)(lds + (bufoff) + ldsw + _i * 8192), 16, 0, 0); } while (0)
#define PG8_STAGE_A(bufoff, gbase, VO, h) do { _Pragma("unroll") for (int _i = 0; _i < 2; ++_i) \
        __builtin_amdgcn_global_load_lds((const unsigned*)((const char*)(gbase) + (VO)[h][_i]), (LAS unsigned*)(lds + (bufoff) + ldsw + _i * 8192), 16, 0, 0); } while (0)
#define PG8_LDA(dst, b, h) do { _Pragma("unroll") for (int m = 0; m < 4; ++m) _Pragma("unroll") for (int k = 0; k < 2; ++k) dst[m][k] = *(const LAS bf16x8*)(lds + PG8_SA(b, h) + aoff + m * 2048 + k * 1024); } while (0)
#define PG8_LDB(dst, b, h) do { _Pragma("unroll") for (int n = 0; n < 2; ++n) _Pragma("unroll") for (int k = 0; k < 2; ++k) dst[n][k] = *(const LAS bf16x8*)(lds + PG8_SB(b, h) + boff + n * 2048 + k * 1024); } while (0)
#define PG8_MMA(ai, bj, At, Bt) do { __builtin_amdgcn_s_setprio(1); _Pragma("unroll") for (int m = 0; m < 4; ++m) _Pragma("unroll") for (int n = 0; n < 2; ++n) _Pragma("unroll") for (int k = 0; k < 2; ++k) \
        acc[ai][bj][m][n] = __builtin_amdgcn_mfma_f32_16x16x32_bf16(Bt[n][k], At[m][k], acc[ai][bj][m][n], 0, 0, 0); __builtin_amdgcn_s_setprio(0); } while (0)
#define PG8_WAIT_V(n) asm volatile("s_waitcnt vmcnt(" #n ")" ::: "memory")
#define PG8_WAIT_L(n) asm volatile("s_waitcnt lgkmcnt(" #n ")" ::: "memory")
#define PG8_BAR __builtin_amdgcn_s_barrier()
#define PG8_SCHED __builtin_amdgcn_sched_barrier(0)
    Unit cur, nxt; int ui = 0;
    if (!S.next(0, cur)) return;
    if constexpr (GATHER) {
#pragma unroll
        for (int h = 0; h < 2; ++h)
#pragma unroll
            for (int i = 0; i < 2; ++i) voffA[h][i] = (unsigned)(S.row(cur, Rr[i] + h * HALF) * lda + Cc[i]) * 2u;
    }
    f32x4 acc[2][2][4][2];
#pragma unroll
    for (int a = 0; a < 2; ++a)
#pragma unroll
        for (int b = 0; b < 2; ++b)
#pragma unroll
            for (int m = 0; m < 4; ++m)
#pragma unroll
                for (int n = 0; n < 2; ++n) acc[a][b][m][n] = (f32x4){0.f, 0.f, 0.f, 0.f};
    bf16x8 At[4][2], B0[2][2], B1[2][2];
    const char* cA = cur.A; const char* cB = cur.B;
    PG8_STAGE_B(PG8_SB(0, 0), cB); PG8_STAGE_B(PG8_SB(0, 1), cB + hstepB); PG8_STAGE_A(PG8_SA(0, 0), cA, voffA, 0); PG8_STAGE_A(PG8_SA(0, 1), cA, voffA, 1);
    if (wr == 1) PG8_BAR;
    PG8_WAIT_V(2); PG8_BAR;
    PG8_STAGE_B(PG8_SB(1, 0), cB + kstep); PG8_STAGE_A(PG8_SA(1, 0), cA + kstep, voffA, 0); PG8_STAGE_B(PG8_SB(1, 1), cB + hstepB + kstep);
    PG8_WAIT_V(6); PG8_BAR;
    for (;;) {
        const bool has_next = S.next(ui + 1, nxt);
        if constexpr (GATHER) {
            if (has_next) {
#pragma unroll
                for (int h = 0; h < 2; ++h)
#pragma unroll
                    for (int i = 0; i < 2; ++i) voffN[h][i] = (unsigned)(S.row(nxt, Rr[i] + h * HALF) * lda + Cc[i]) * 2u;
            } else {
#pragma unroll
                for (int h = 0; h < 2; ++h)
#pragma unroll
                    for (int i = 0; i < 2; ++i) voffN[h][i] = voffA[h][i];
            }
        }
        const char* nA = has_next ? nxt.A : cA; const char* nB = has_next ? nxt.B : cB;
        for (int t = 0; t < nt; t += 2) {
            const bool last = (t == nt - 2);
            const char* a1 = cA + (size_t)(t + 1) * kstep;
            const char* a2 = last ? nA : cA + (size_t)(t + 2) * kstep; const char* b2 = last ? nB : cB + (size_t)(t + 2) * kstep;
            const char* a3 = a2 + kstep; const char* b3 = b2 + kstep;
            unsigned vo2[2][2];
#pragma unroll
            for (int h = 0; h < 2; ++h)
#pragma unroll
                for (int i = 0; i < 2; ++i) vo2[h][i] = (GATHER && last) ? voffN[h][i] : voffA[h][i];
            PG8_LDB(B0, 0, 0); PG8_LDB(B1, 0, 1); PG8_SCHED; PG8_LDA(At, 0, 0); PG8_STAGE_A(PG8_SA(1, 1), a1, voffA, 1);
            PG8_WAIT_V(8); PG8_WAIT_L(0); PG8_BAR; PG8_MMA(0, 0, At, B0); PG8_MMA(0, 1, At, B1); PG8_BAR; PG8_SCHED;
            PG8_LDA(At, 0, 1); PG8_STAGE_B(PG8_SB(0, 0), b2); PG8_STAGE_B(PG8_SB(0, 1), b2 + hstepB); PG8_STAGE_A(PG8_SA(0, 0), a2, vo2, 0);
            PG8_WAIT_V(8); PG8_WAIT_L(0); PG8_BAR; PG8_MMA(1, 0, At, B0); PG8_MMA(1, 1, At, B1); PG8_BAR; PG8_SCHED;
            PG8_LDB(B0, 1, 0); PG8_LDB(B1, 1, 1); PG8_SCHED; PG8_LDA(At, 1, 0); PG8_STAGE_A(PG8_SA(0, 1), a2, vo2, 1);
            PG8_WAIT_V(8); PG8_WAIT_L(0); PG8_BAR; PG8_MMA(0, 0, At, B0); PG8_MMA(0, 1, At, B1); PG8_BAR; PG8_SCHED;
            PG8_LDA(At, 1, 1); PG8_STAGE_B(PG8_SB(1, 0), b3); PG8_STAGE_B(PG8_SB(1, 1), b3 + hstepB); PG8_STAGE_A(PG8_SA(1, 0), a3, vo2, 0);
            PG8_WAIT_V(8); PG8_WAIT_L(0); PG8_BAR; PG8_MMA(1, 0, At, B0); PG8_MMA(1, 1, At, B1); PG8_BAR; PG8_SCHED;
        }
        if (wr == 0) PG8_BAR;
        E(acc, cur, wr, wc, fr, fq);
        if (!has_next) break;
#pragma unroll
        for (int a = 0; a < 2; ++a)
#pragma unroll
            for (int b = 0; b < 2; ++b)
#pragma unroll
                for (int m = 0; m < 4; ++m)
#pragma unroll
                    for (int n = 0; n < 2; ++n) acc[a][b][m][n] = (f32x4){0.f, 0.f, 0.f, 0.f};
        cur = nxt; cA = nA; cB = nB; ++ui;
        if constexpr (GATHER) {
#pragma unroll
            for (int h = 0; h < 2; ++h)
#pragma unroll
                for (int i = 0; i < 2; ++i) voffA[h][i] = voffN[h][i];
        }
        if (wr == 1) PG8_BAR;
    }
    PG8_WAIT_V(0);
    PG8_BAR;
#undef PG8_SA
#undef PG8_SB
#undef PG8_STAGE_A
#undef PG8_STAGE_B
#undef PG8_LDA
#undef PG8_LDB
#undef PG8_MMA
#undef PG8_WAIT_V
#undef PG8_WAIT_L
#undef PG8_BAR
#undef PG8_SCHED
}

#define EPI_ROWCOL const int row0 = u.orow + wr * 64 + fr, colw = wc * 32 + 8 * fq
struct EpiP1 {
    bf16* PROJ; bf16* GATE; const float* bgate;
    __device__ __forceinline__ void operator()(const f32x4 (&acc)[2][2][4][2], const Unit& u, int wr, int wc, int fr, int fq) const {
        EPI_ROWCOL; const int pn = u.pn; const int mode = pn < 8 ? 1 : (pn < 24 ? 0 : 2);
        bf16* base = (mode == 2) ? GATE : PROJ; const int colt = ((mode == 2) ? (pn - 24) : pn) * BM + colw;
        f32x4 bv[2][2];
#pragma unroll
        for (int bj = 0; bj < 2; ++bj)
#pragma unroll
            for (int n = 0; n < 2; ++n) { const f32x4 t = *(const f32x4*)(bgate + ((mode == 2) ? colt : colw) + bj * HALF + 4 * n); bv[bj][n] = (mode == 2) ? t : (f32x4){0.f, 0.f, 0.f, 0.f}; }
#pragma unroll
        for (int ai = 0; ai < 2; ++ai)
#pragma unroll
            for (int m = 0; m < 4; ++m) { bf16* rowp = base + (size_t)(row0 + ai * HALF + m * 16) * INC + colt;
#pragma unroll
                for (int bj = 0; bj < 2; ++bj) { f32x4 v0 = acc[ai][bj][m][0] + bv[bj][0], v1 = acc[ai][bj][m][1] + bv[bj][1];
                    if (mode == 1) { const f32x2 a = gelu_pk((f32x2){v0[0], v0[1]}), b = gelu_pk((f32x2){v0[2], v0[3]}), c = gelu_pk((f32x2){v1[0], v1[1]}), d = gelu_pk((f32x2){v1[2], v1[3]});
                        v0 = (f32x4){a.x, a.y, b.x, b.y}; v1 = (f32x4){c.x, c.y, d.x, d.y}; }
                    else if (mode == 2) {
#pragma unroll
                        for (int j = 0; j < 4; ++j) { v0[j] = fast_sigmoid(v0[j]); v1[j] = fast_sigmoid(v1[j]); } }
                    u32x4 w; w.x = cvt_pk_bf16(v0[0], v0[1]); w.y = cvt_pk_bf16(v0[2], v0[3]); w.z = cvt_pk_bf16(v1[0], v1[1]); w.w = cvt_pk_bf16(v1[2], v1[3]);
                    *(u32x4*)(rowp + bj * HALF) = w; } }
    }
};
struct EpiP3 {
    const bf16* GATE; float* MF; bf16* MG;
    __device__ __forceinline__ void operator()(const f32x4 (&acc)[2][2][4][2], const Unit& u, int wr, int wc, int fr, int fq) const {
        EPI_ROWCOL; const int seg = u.seg;
#pragma unroll
        for (int ai = 0; ai < 2; ++ai)
#pragma unroll
            for (int m = 0; m < 4; ++m) { const size_t r = (size_t)(row0 + ai * HALF + m * 16);
#pragma unroll
                for (int bj = 0; bj < 2; ++bj) { const int col = u.pn * BM + bj * HALF + colw;
                    const u32x4 gw = *(const u32x4*)(GATE + r * INC + seg * D + col);
                    f32x4 r0 = acc[ai][bj][m][0], r1 = acc[ai][bj][m][1];
                    r0[0] *= bflo(gw.x); r0[1] *= bfhi(gw.x); r0[2] *= bflo(gw.y); r0[3] *= bfhi(gw.y); r1[0] *= bflo(gw.z); r1[1] *= bfhi(gw.z); r1[2] *= bflo(gw.w); r1[3] *= bfhi(gw.w);
                    float* mp = MF + r * D + col;
                    if (seg > 0) { r0 += *(const f32x4*)mp; r1 += *(const f32x4*)(mp + 4); }
                    if (seg < 2) { *(f32x4*)mp = r0; *(f32x4*)(mp + 4) = r1; }
                    else { u32x4 w; w.x = cvt_pk_bf16(r0[0], r0[1]); w.y = cvt_pk_bf16(r0[2], r0[3]); w.z = cvt_pk_bf16(r1[0], r1[1]); w.w = cvt_pk_bf16(r1[2], r1[3]); *(u32x4*)(MG + r * D + col) = w; } }
                asm volatile("" ::: "memory"); }
    }
};
struct EpiP4 {
    const float* X; float* PRE;
    __device__ __forceinline__ void operator()(const f32x4 (&acc)[2][2][4][2], const Unit& u, int wr, int wc, int fr, int fq) const {
        EPI_ROWCOL;
#pragma unroll
        for (int ai = 0; ai < 2; ++ai)
#pragma unroll
            for (int m = 0; m < 4; ++m) { const size_t r = (size_t)(row0 + ai * HALF + m * 16);
#pragma unroll
                for (int bj = 0; bj < 2; ++bj) { const size_t o = r * D + u.pn * BM + bj * HALF + colw;
                    const f32x4 x0 = *(const f32x4*)(X + o), x1 = *(const f32x4*)(X + o + 4);
                    *(f32x4*)(PRE + o) = x0 * ALPHA + acc[ai][bj][m][0]; *(f32x4*)(PRE + o + 4) = x1 * ALPHA + acc[ai][bj][m][1]; }
                asm volatile("" ::: "memory"); }
    }
};
struct EpiP6 {
    bf16* H;
    __device__ __forceinline__ void operator()(const f32x4 (&acc)[2][2][4][2], const Unit& u, int wr, int wc, int fr, int fq) const {
        EPI_ROWCOL;
#pragma unroll
        for (int ai = 0; ai < 2; ++ai)
#pragma unroll
            for (int m = 0; m < 4; ++m) { const size_t r = (size_t)(row0 + ai * HALF + m * 16);
                float h[8];
#pragma unroll
                for (int n = 0; n < 2; ++n)
#pragma unroll
                    for (int j = 0; j < 4; ++j) { const float g = acc[ai][0][m][n][j], up = acc[ai][1][m][n][j]; h[4 * n + j] = g * fast_sigmoid(g) * up; }
                u32x4 w; w.x = cvt_pk_bf16(h[0], h[1]); w.y = cvt_pk_bf16(h[2], h[3]); w.z = cvt_pk_bf16(h[4], h[5]); w.w = cvt_pk_bf16(h[6], h[7]);
                *(u32x4*)(H + r * EH + u.pn * HALF + colw) = w; }
    }
};
struct EpiP7 {
    bf16* Y;
    __device__ __forceinline__ void operator()(const f32x4 (&acc)[2][2][4][2], const Unit& u, int wr, int wc, int fr, int fq) const {
        EPI_ROWCOL;
#pragma unroll
        for (int ai = 0; ai < 2; ++ai)
#pragma unroll
            for (int m = 0; m < 4; ++m) { bf16* rowp = Y + (size_t)(row0 + ai * HALF + m * 16) * D + u.pn * BM + colw;
#pragma unroll
                for (int bj = 0; bj < 2; ++bj) { const f32x4 v0 = acc[ai][bj][m][0], v1 = acc[ai][bj][m][1];
                    u32x4 w; w.x = cvt_pk_bf16(v0[0], v0[1]); w.y = cvt_pk_bf16(v0[2], v0[3]); w.z = cvt_pk_bf16(v1[0], v1[1]); w.w = cvt_pk_bf16(v1[2], v1[3]);
                    *(u32x4*)(rowp + bj * HALF) = w; } }
    }
};
}

#define XB_TMO      128
#define XB_XCNT(j)  (256  + 64 * (j))
#define XB_XSUB(j)  (1280 + 64 * (j))
#define XB_XGEN(j)  (2304 + 64 * (j))
#define XB_TOP      3328
#define XB_TOPGEN   3392
#define XCD_BAR_WORDS 3456
#define XB_SPIN_CAP (1u << 18)
__device__ __forceinline__ unsigned xb_ld(unsigned* p)              { return __hip_atomic_load(p, __ATOMIC_RELAXED, __HIP_MEMORY_SCOPE_AGENT); }
__device__ __forceinline__ unsigned xb_add(unsigned* p, unsigned v) { return __hip_atomic_fetch_add(p, v, __ATOMIC_RELAXED, __HIP_MEMORY_SCOPE_AGENT); }
__device__ __forceinline__ unsigned xb_xcc_id() { return (unsigned)__builtin_amdgcn_s_getreg((3 << 11) | 20) & 0xFu; }
#define XB_SPIN(cond, bar) do { unsigned _sp = 0; while (cond) { __builtin_amdgcn_s_sleep(1); \
    if ((++_sp & 255u) == 0u) { if (xb_ld(&(bar)[XB_TMO])) break; if (_sp > XB_SPIN_CAP) { atomicAdd(&(bar)[XB_TMO], 1u); break; } } } } while (0)
struct XcdBarrier { unsigned* bar; unsigned x; volatile LAS unsigned* st; };
__device__ __forceinline__ XcdBarrier xcd_barrier_post(unsigned* bar, volatile LAS unsigned* st) {
    XcdBarrier b; b.bar = bar; b.x = xb_xcc_id(); b.st = st;
    if (threadIdx.x == 0) (void)xb_add(&bar[XB_XCNT(b.x)], 1u);
    return b;
}
__device__ __forceinline__ void xcd_barrier_complete(unsigned* bar, unsigned x, unsigned& nloc, unsigned& nx) {
    const unsigned G = gridDim.x * gridDim.y * gridDim.z;
    unsigned sum, cnt, mine, sp = 0u;
    for (;;) {
        sum = 0u; cnt = 0u; mine = 0u;
#pragma unroll
        for (unsigned j = 0; j < 16; ++j) { const unsigned c = xb_ld(&bar[XB_XCNT(j)]); sum += c; cnt += (c > 0u) ? 1u : 0u; mine = (j == x) ? c : mine; }
        if (sum == G) break;
        __builtin_amdgcn_s_sleep(1);
        if ((++sp & 255u) == 0u) { if (xb_ld(&bar[XB_TMO])) break; if (sp > XB_SPIN_CAP) { atomicAdd(&bar[XB_TMO], 1u); break; } }
    }
    nloc = mine > 0u ? mine : 1u; nx = cnt > 0u ? cnt : 1u;
}
__device__ __forceinline__ void xcd_barrier(const XcdBarrier& b) {
    asm volatile("s_waitcnt vmcnt(0)" ::: "memory");
    __syncthreads();
    if (threadIdx.x == 0) {
        unsigned* bar = b.bar;
        __builtin_amdgcn_s_waitcnt(0);
        unsigned nloc = b.st[0], nx = b.st[1];
        if (nloc == 0u) { xcd_barrier_complete(bar, b.x, nloc, nx); b.st[0] = nloc; b.st[1] = nx; }
        const unsigned old = xb_add(&bar[XB_XSUB(b.x)], 1u);
        const unsigned gen = old / nloc;
        if (old + 1u == (gen + 1u) * nloc) {
            __builtin_amdgcn_fence(__ATOMIC_RELEASE, "agent");
            asm volatile("s_waitcnt vmcnt(0)" ::: "memory");
            const unsigned og = xb_add(&bar[XB_TOP], 1u);
            const unsigned tg = og / nx;
            if (og + 1u == (tg + 1u) * nx) xb_add(&bar[XB_TOPGEN], 1u);
            else XB_SPIN(xb_ld(&bar[XB_TOPGEN]) == tg, bar);
            __builtin_amdgcn_fence(__ATOMIC_ACQUIRE, "agent");
            xb_add(&bar[XB_XGEN(b.x)], 1u);
            asm volatile("s_waitcnt vmcnt(0)" ::: "memory");
        } else {
            XB_SPIN(xb_ld(&bar[XB_XGEN(b.x)]) == gen, bar);
            __builtin_amdgcn_fence(__ATOMIC_ACQUIRE, "agent");
            asm volatile("s_waitcnt vmcnt(0)" ::: "memory");
        }
    }
    __syncthreads();
}

template <int MAP>
__device__ __forceinline__ void ln_finish(float (&v)[32], const float* __restrict__ g, const float* __restrict__ b, float* xout, bf16* xbout, int lane) {
    float s = 0.f;
#pragma unroll
    for (int i = 0; i < 32; ++i) s += v[i];
    const float mean = wave_sum(s) * (1.0f / D);
    float q = 0.f;
#pragma unroll
    for (int i = 0; i < 32; ++i) { v[i] -= mean; q += v[i] * v[i]; }
    const float rstd = 1.0f / sqrtf(wave_sum(q) * (1.0f / D) + LN_EPS);
    if (MAP == 0) {
#pragma unroll
        for (int j = 0; j < 8; ++j) {
            const int c = 4 * (lane + 64 * j);
            const f32x4 gv = *(const f32x4*)(g + c), bv = *(const f32x4*)(b + c);
            f32x4 o; o.x = v[4 * j] * rstd * gv.x + bv.x; o.y = v[4 * j + 1] * rstd * gv.y + bv.y; o.z = v[4 * j + 2] * rstd * gv.z + bv.z; o.w = v[4 * j + 3] * rstd * gv.w + bv.w;
            *(f32x4*)(xout + c) = o;
            if (xbout) { u32x2 w; w.x = pk2(o.x, o.y); w.y = pk2(o.z, o.w); *(u32x2*)(xbout + c) = w; }
        }
    } else {
#pragma unroll
        for (int j = 0; j < 4; ++j) {
            const int c = 8 * (lane + 64 * j);
            const f32x4 g0 = *(const f32x4*)(g + c), g1 = *(const f32x4*)(g + c + 4), b0 = *(const f32x4*)(b + c), b1 = *(const f32x4*)(b + c + 4);
            f32x4 o0, o1;
            o0.x = v[8 * j] * rstd * g0.x + b0.x; o0.y = v[8 * j + 1] * rstd * g0.y + b0.y; o0.z = v[8 * j + 2] * rstd * g0.z + b0.z; o0.w = v[8 * j + 3] * rstd * g0.w + b0.w;
            o1.x = v[8 * j + 4] * rstd * g1.x + b1.x; o1.y = v[8 * j + 5] * rstd * g1.y + b1.y; o1.z = v[8 * j + 6] * rstd * g1.z + b1.z; o1.w = v[8 * j + 7] * rstd * g1.w + b1.w;
            *(f32x4*)(xout + c) = o0; *(f32x4*)(xout + c + 4) = o1;
            if (xbout) { u32x4 w; w.x = pk2(o0.x, o0.y); w.y = pk2(o0.z, o0.w); w.z = pk2(o1.x, o1.y); w.w = pk2(o1.z, o1.w); *(u32x4*)(xbout + c) = w; }
        }
    }
}
__device__ __forceinline__ void entry_ln_row(const Params& p, int t, int lane) {
    float* X = (float*)(p.ws + WS_X); bf16* XB = (bf16*)(p.ws + WS_XB);
    float v[32]; const float* xr = p.in[0] + (size_t)t * D;
#pragma unroll
    for (int j = 0; j < 8; ++j) { const f32x4 a = *(const f32x4*)(xr + 4 * (lane + 64 * j)); v[4 * j] = a.x; v[4 * j + 1] = a.y; v[4 * j + 2] = a.z; v[4 * j + 3] = a.w; }
    ln_finish<0>(v, p.in[1], p.in[2], X + (size_t)t * D, XB + (size_t)t * D, lane);
}

__device__ __forceinline__ void spatial_unit(const Params& p, int l, int unit, LAS unsigned char* lds, int tid) {
    const int nb = unit >> 2, g = unit & 3, lane = tid & 63, wid = __builtin_amdgcn_readfirstlane(tid >> 6), fr = lane & 15, fq = lane >> 4;
    LAS bf16* VT = (LAS bf16*)lds; LAS bf16* WM = (LAS bf16*)(lds + 69632);
    const bf16* PROJ = (const bf16*)(p.ws + WS_PROJ); bf16* YABC = (bf16*)(p.ws + WS_YABC);
    const float* ws = p.in[4] + ((size_t)l * 4 + g) * 128 * 128; const float* bs = p.in[5] + ((size_t)l * 4 + g) * 128;
#pragma unroll
    for (int q = 0; q < 8; ++q) { const int pc = tid + 512 * q, i = pc >> 5, j4 = (pc & 31) * 4; const f32x4 w = *(const f32x4*)(ws + i * 128 + j4);
        u32x2 o; o.x = pk2(w.x, w.y); o.y = pk2(w.z, w.w); *(LAS u32x2*)(WM + i * 136 + j4) = o; }
    {
        const int j = wid * 16 + fr; const bf16* vp = PROJ + ((size_t)nb * 128 + j) * INC + 1024 + g * 256 + fq * 8;
        float v[64];
#pragma unroll
        for (int q = 0; q < 8; ++q) { const u32x4 w = *(const u32x4*)(vp + q * 32);
            v[8 * q] = bflo(w.x); v[8 * q + 1] = bfhi(w.x); v[8 * q + 2] = bflo(w.y); v[8 * q + 3] = bfhi(w.y); v[8 * q + 4] = bflo(w.z); v[8 * q + 5] = bfhi(w.z); v[8 * q + 6] = bflo(w.w); v[8 * q + 7] = bfhi(w.w); }
        float sm = 0.f;
#pragma unroll
        for (int i = 0; i < 64; ++i) sm += v[i];
        sm += __shfl_xor(sm, 16); sm += __shfl_xor(sm, 32);
        const float mean = sm * (1.0f / 256.0f); float sq = 0.f;
#pragma unroll
        for (int i = 0; i < 64; ++i) { v[i] -= mean; sq += v[i] * v[i]; }
        sq += __shfl_xor(sq, 16); sq += __shfl_xor(sq, 32);
        const float rstd = 1.0f / sqrtf(sq * (1.0f / 256.0f) + LN_EPS);
#pragma unroll
        for (int q = 0; q < 8; ++q)
#pragma unroll
            for (int i = 0; i < 8; ++i) VT[(q * 32 + fq * 8 + i) * 136 + j] = (bf16)f2bf(v[8 * q + i] * rstd);
    }
    __syncthreads();
    f32x4 acc[2][8];
#pragma unroll
    for (int cf = 0; cf < 2; ++cf)
#pragma unroll
        for (int f = 0; f < 8; ++f) acc[cf][f] = (f32x4){0.f, 0.f, 0.f, 0.f};
#pragma unroll
    for (int ks = 0; ks < 4; ++ks) {
        bf16x8 a[2];
#pragma unroll
        for (int cf = 0; cf < 2; ++cf) a[cf] = *(const LAS bf16x8*)(VT + (wid * 32 + cf * 16 + fr) * 136 + ks * 32 + fq * 8);
#pragma unroll
        for (int f = 0; f < 8; ++f) {
            if (ks >= 2 && f < 4) continue;
            const bf16x8 b = *(const LAS bf16x8*)(WM + (f * 16 + fr) * 136 + ks * 32 + fq * 8);
#pragma unroll
            for (int cf = 0; cf < 2; ++cf) acc[cf][f] = __builtin_amdgcn_mfma_f32_16x16x32_bf16(a[cf], b, acc[cf][f], 0, 0, 0);
        }
    }
#pragma unroll
    for (int f = 0; f < 8; ++f) {
        const int i = f * 16 + fr; const size_t t = (size_t)nb * 128 + i; const float bias = bs[i];
#pragma unroll
        for (int cf = 0; cf < 2; ++cf) { const int c = g * 256 + wid * 32 + cf * 16 + 4 * fq;
            const u32x2 uw = *(const u32x2*)(PROJ + t * INC + c);
            u32x2 o; o.x = pk2(bflo(uw.x) * (acc[cf][f][0] + bias), bfhi(uw.x) * (acc[cf][f][1] + bias)); o.y = pk2(bflo(uw.y) * (acc[cf][f][2] + bias), bfhi(uw.y) * (acc[cf][f][3] + bias));
            *(u32x2*)(YABC + t * 3072 + c) = o; }
    }
    __syncthreads();
}
__device__ __forceinline__ void ld8(const bf16* ptr, float (&f)[8]) {
    const u32x4 w = *(const u32x4*)ptr;
    f[0] = bflo(w.x); f[1] = bfhi(w.x); f[2] = bflo(w.y); f[3] = bfhi(w.y); f[4] = bflo(w.z); f[5] = bfhi(w.z); f[6] = bflo(w.w); f[7] = bfhi(w.w);
}
__device__ __forceinline__ void st8(bf16* ptr, const float (&f)[8]) {
    u32x4 w; w.x = pk2(f[0], f[1]); w.y = pk2(f[2], f[3]); w.z = pk2(f[4], f[5]); w.w = pk2(f[6], f[7]); *(u32x4*)ptr = w;
}
__device__ __forceinline__ void conv_task(const Params& p, int l, int t0, int c) {
    const bf16* PROJ = (const bf16*)(p.ws + WS_PROJ); bf16* YABC = (bf16*)(p.ws + WS_YABC);
    float w0[8], w1[8], w2[8], z2[8], z1[8];
    { const float* wc = p.in[6] + (size_t)l * 3 * 1024 + c;
      const f32x4 a0 = *(const f32x4*)wc, a1 = *(const f32x4*)(wc + 4), b0 = *(const f32x4*)(wc + 1024), b1 = *(const f32x4*)(wc + 1028), c0 = *(const f32x4*)(wc + 2048), c1 = *(const f32x4*)(wc + 2052);
      w0[0] = a0.x; w0[1] = a0.y; w0[2] = a0.z; w0[3] = a0.w; w0[4] = a1.x; w0[5] = a1.y; w0[6] = a1.z; w0[7] = a1.w;
      w1[0] = b0.x; w1[1] = b0.y; w1[2] = b0.z; w1[3] = b0.w; w1[4] = b1.x; w1[5] = b1.y; w1[6] = b1.z; w1[7] = b1.w;
      w2[0] = c0.x; w2[1] = c0.y; w2[2] = c0.z; w2[3] = c0.w; w2[4] = c1.x; w2[5] = c1.y; w2[6] = c1.z; w2[7] = c1.w; }
#pragma unroll
    for (int i = 0; i < 8; ++i) { z2[i] = 0.f; z1[i] = 0.f; }
    if (t0 >= 2) { float cg[8], hh[8]; ld8(PROJ + (size_t)(t0 - 2) * INC + 3072 + c, cg); ld8(PROJ + (size_t)(t0 - 2) * INC + 4096 + c, hh);
#pragma unroll
        for (int i = 0; i < 8; ++i) z2[i] = cg[i] * hh[i];
        ld8(PROJ + (size_t)(t0 - 1) * INC + 3072 + c, cg); ld8(PROJ + (size_t)(t0 - 1) * INC + 4096 + c, hh);
#pragma unroll
        for (int i = 0; i < 8; ++i) z1[i] = cg[i] * hh[i]; }
#pragma unroll
    for (int k = 0; k < 16; ++k) { const size_t t = (size_t)(t0 + k);
        float bgv[8], cg[8], hh[8], o[8]; ld8(PROJ + t * INC + 2048 + c, bgv); ld8(PROJ + t * INC + 3072 + c, cg); ld8(PROJ + t * INC + 4096 + c, hh);
#pragma unroll
        for (int i = 0; i < 8; ++i) { const float z0 = cg[i] * hh[i]; o[i] = bgv[i] * (w0[i] * z2[i] + w1[i] * z1[i] + w2[i] * z0); z2[i] = z1[i]; z1[i] = z0; }
        st8(YABC + t * 3072 + 1024 + c, o); }
}
template <int WIN> __device__ __forceinline__ void pool_task(const Params& p, int t0, int c) {
    const bf16* PROJ = (const bf16*)(p.ws + WS_PROJ); bf16* YABC = (bf16*)(p.ws + WS_YABC);
    float ring[WIN][8], tot[8];
#pragma unroll
    for (int i = 0; i < 8; ++i) tot[i] = 0.f;
#pragma unroll
    for (int d = 1 - WIN; d < 0; ++d) {
        if (t0 > 0) { ld8(PROJ + (size_t)(t0 + d) * INC + 5120 + c, ring[(d + WIN) % WIN]);
#pragma unroll
            for (int i = 0; i < 8; ++i) tot[i] += ring[(d + WIN) % WIN][i]; }
        else {
#pragma unroll
            for (int i = 0; i < 8; ++i) ring[(d + WIN) % WIN][i] = 0.f; }
    }
#pragma unroll
    for (int k = 0; k < 16; ++k) { const int t = t0 + k;
        float cur[8], o[8]; ld8(PROJ + (size_t)t * INC + 5120 + c, cur);
        const float inv = (k + 1 < WIN && t0 == 0) ? 1.0f / (float)(k + 1) : 1.0f / (float)WIN;
#pragma unroll
        for (int i = 0; i < 8; ++i) { tot[i] += cur[i]; o[i] = tot[i] * inv - cur[i]; ring[k % WIN][i] = cur[i]; }
        st8(YABC + (size_t)t * 3072 + 2048 + c, o);
#pragma unroll
        for (int i = 0; i < 8; ++i) tot[i] -= ring[(k + 1) % WIN][i];
    }
}
__device__ __forceinline__ void convpool_task(const Params& p, int l, int task) {
    if (task < 65536) { conv_task(p, l, (task >> 7) * 16, (task & 127) * 8); return; }
    const int k = task - 65536, g = __builtin_amdgcn_readfirstlane((k >> 6) & 3), run = ((k >> 8) << 1) + ((k >> 5) & 1), c = (g * 32 + (k & 31)) * 8, t0 = run * 16;
    if (g == 0) pool_task<2>(p, t0, c); else if (g == 1) pool_task<4>(p, t0, c); else if (g == 2) pool_task<8>(p, t0, c); else pool_task<16>(p, t0, c);
}

typedef float f32x16 __attribute__((ext_vector_type(16)));
__device__ __forceinline__ void ln1_router_unit(const Params& p, int l, int unit, LAS unsigned char* lds, int tid) {
    LAS float* part = (LAS float*)lds; LAS float* lg = (LAS float*)(lds + 65536); LAS float* sl = (LAS float*)(lds + 73728); LAS int* le = (LAS int*)(lds + 75776); LAS float* lw = (LAS float*)(lds + 76800);
    LAS int* cnt = (LAS int*)(lds + 77824); LAS int* base = cnt + 64;
    const int lane = tid & 63, wid = __builtin_amdgcn_readfirstlane(tid >> 6); const int t0 = unit * 32;
    const float* PRE = (const float*)(p.ws + WS_PRE); float* X = (float*)(p.ws + WS_X); bf16* XB = (bf16*)(p.ws + WS_XB);
    for (int r = 0; r < 4; ++r) {
        const int t = t0 + wid * 4 + r; float v[32]; const float* xr = PRE + (size_t)t * D;
#pragma unroll
        for (int j = 0; j < 8; ++j) { const f32x4 a = *(const f32x4*)(xr + 4 * (lane + 64 * j)); v[4 * j] = a.x; v[4 * j + 1] = a.y; v[4 * j + 2] = a.z; v[4 * j + 3] = a.w; }
        ln_finish<0>(v, p.in[15] + (size_t)l * D, p.in[16] + (size_t)l * D, X + (size_t)t * D, XB + (size_t)t * D, lane);
    }
    if (tid < 64) cnt[tid] = 0;
    __threadfence_block();
    __syncthreads();
    {
        const int m = lane & 31, ks = lane >> 5;
        const float* xrow = X + (size_t)(t0 + m) * D + 256 * wid + 4 * ks;
        const float* wcol = p.in[17] + (size_t)l * D * NE + (size_t)(256 * wid + 4 * ks) * NE + m;
        f32x16 acc0, acc1;
#pragma unroll
        for (int r = 0; r < 16; ++r) { acc0[r] = 0.f; acc1[r] = 0.f; }
#pragma unroll 4
        for (int kb = 0; kb < 256; kb += 8) {
            const f32x4 a = *(const f32x4*)(xrow + kb);
            float b0[4], b1[4];
#pragma unroll
            for (int s = 0; s < 4; ++s) { b0[s] = wcol[(size_t)(kb + s) * NE]; b1[s] = wcol[(size_t)(kb + s) * NE + 32]; }
#pragma unroll
            for (int s = 0; s < 4; ++s) { acc0 = __builtin_amdgcn_mfma_f32_32x32x2f32(a[s], b0[s], acc0, 0, 0, 0); acc1 = __builtin_amdgcn_mfma_f32_32x32x2f32(a[s], b1[s], acc1, 0, 0, 0); }
        }
#pragma unroll
        for (int r = 0; r < 16; ++r) { const int row = (r & 3) + 8 * (r >> 2) + 4 * ks; part[(wid * 32 + row) * 64 + m] = acc0[r]; part[(wid * 32 + row) * 64 + 32 + m] = acc1[r]; }
    }
    __syncthreads();
    { f32x4 sm = *(const LAS f32x4*)(part + tid * 4);
#pragma unroll
      for (int w = 1; w < 8; ++w) sm += *(const LAS f32x4*)(part + w * 2048 + tid * 4);
      *(LAS f32x4*)(lg + tid * 4) = (f32x4){sigmoidf_(sm.x), sigmoidf_(sm.y), sigmoidf_(sm.z), sigmoidf_(sm.w)}; }
    __syncthreads();
    {
        const float rbias = p.in[18][(size_t)l * NE + lane]; const int gi = lane >> 3;
        for (int tt = 0; tt < 4; ++tt) {
            const int tok = wid * 4 + tt;
            const float sc = lg[tok * 64 + lane], sel = sc + rbias;
            float m1 = sel; m1 = fmaxf(m1, __shfl_xor(m1, 1)); m1 = fmaxf(m1, __shfl_xor(m1, 2)); m1 = fmaxf(m1, __shfl_xor(m1, 4));
            const unsigned long long eq = __ballot(sel == m1);
            const int first = __ffs((unsigned)(eq >> (gi * 8)) & 0xffu) - 1;
            float m2 = ((lane & 7) == first) ? -INFINITY : sel; m2 = fmaxf(m2, __shfl_xor(m2, 1)); m2 = fmaxf(m2, __shfl_xor(m2, 2)); m2 = fmaxf(m2, __shfl_xor(m2, 4));
            const float gscore = m1 + m2;
            int grank = 0;
#pragma unroll
            for (int g2 = 0; g2 < 8; ++g2) { const float v = __shfl(gscore, g2 * 8); grank += ((v > gscore) || (v == gscore && g2 < gi)) ? 1 : 0; }
            const bool gsel = grank < 4;
            const unsigned long long selmask = __ballot(gsel);
            sl[wid * 64 + lane] = sel;
            asm volatile("s_waitcnt lgkmcnt(0)" ::: "memory");
            int rank = 0;
#pragma unroll
            for (int e4 = 0; e4 < 16; ++e4) { const f32x4 v = *(const LAS f32x4*)(sl + wid * 64 + e4 * 4);
#pragma unroll
                for (int j = 0; j < 4; ++j) { const int e2 = e4 * 4 + j; const bool ok = (selmask >> e2) & 1ull; rank += (ok && ((v[j] > sel) || (v[j] == sel && e2 < lane))) ? 1 : 0; } }
            asm volatile("s_waitcnt lgkmcnt(0)" ::: "memory");
            const bool chosen = gsel && rank < 8;
            const float wsum = wave_sum(chosen ? sc : 0.f);
            if (chosen) { le[tok * 8 + rank] = lane; lw[tok * 8 + rank] = sc * (ROUTED_SCALE / wsum); }
        }
    }
    __syncthreads();
    int myrank = 0, mye = 0;
    if (tid < 256) { mye = le[tid]; myrank = atomicAdd((int*)&cnt[mye], 1); }
    __syncthreads();
    if (tid < 64) { const int c = cnt[tid]; base[tid] = c ? (int)atomicAdd((unsigned*)(p.ws + WS_CTL) + CW_CNT + 64 * l + tid, (unsigned)c) : 0; }
    __syncthreads();
    if (tid < 256) {
        const int t = t0 + (tid >> 3), s = tid & 7, pos = base[mye] + myrank;
        ((int*)(p.ws + WS_TOPE))[t * 8 + s] = mye; ((int*)(p.ws + WS_TOPPOS))[t * 8 + s] = pos; ((float*)(p.ws + WS_TOPW))[t * 8 + s] = lw[tid];
        ((int*)(p.ws + WS_LIST))[((size_t)l * 64 + mye) * 8192 + pos] = t;
    }
    __syncthreads();
}

__device__ __forceinline__ void combine_ln2_row(const Params& p, int l, int t, const LAS MoeTab* tb, int lane, bool last) {
    const bf16* Y = (const bf16*)(p.ws + WS_Y); float* X = (float*)(p.ws + WS_X); bf16* XB = (bf16*)(p.ws + WS_XB);
    int row_l; float w_l;
    { const int s = lane & 15;
      if (s < 8) { const int e = ((const int*)(p.ws + WS_TOPE))[t * 8 + s]; row_l = tb->rb[e] + ((const int*)(p.ws + WS_TOPPOS))[t * 8 + s]; w_l = ((const float*)(p.ws + WS_TOPW))[t * 8 + s]; }
      else { row_l = tb->rb[64] + t; w_l = 1.0f; } }
    float v[32];
    const float* xr = X + (size_t)t * D;
#pragma unroll
    for (int j = 0; j < 4; ++j) { const int c = 8 * (lane + 64 * j); const f32x4 a = *(const f32x4*)(xr + c), b = *(const f32x4*)(xr + c + 4);
        v[8 * j] = ALPHA * a.x; v[8 * j + 1] = ALPHA * a.y; v[8 * j + 2] = ALPHA * a.z; v[8 * j + 3] = ALPHA * a.w; v[8 * j + 4] = ALPHA * b.x; v[8 * j + 5] = ALPHA * b.y; v[8 * j + 6] = ALPHA * b.z; v[8 * j + 7] = ALPHA * b.w; }
#pragma unroll
    for (int s = 0; s < 9; ++s) {
        const int row = __builtin_amdgcn_readlane(row_l, s); const float w = __uint_as_float(__builtin_amdgcn_readlane(__float_as_uint(w_l), s));
        const bf16* yr = Y + (size_t)row * D;
#pragma unroll
        for (int j = 0; j < 4; ++j) { float f[8]; ld8(yr + 8 * (lane + 64 * j), f);
#pragma unroll
            for (int i = 0; i < 8; ++i) v[8 * j + i] += w * f[i]; }
    }
    float* xo = last ? p.out + (size_t)t * D : X + (size_t)t * D;
    ln_finish<1>(v, p.in[25] + (size_t)l * D, p.in[26] + (size_t)l * D, xo, last ? nullptr : XB + (size_t)t * D, lane);
}

__device__ __forceinline__ void tr_item(const float* __restrict__ src, int ldsrc, bf16* dst, int lddst, LAS float* scr, int lane) {
    f32x4 v[16];
    const int kr = lane >> 4, n4 = (lane & 15) * 4;
#pragma unroll
    for (int q = 0; q < 16; ++q) v[q] = __builtin_nontemporal_load((const f32x4*)(src + (size_t)(4 * q + kr) * ldsrc + n4));
#pragma unroll
    for (int q = 0; q < 16; ++q) { const int k = 4 * q + kr; *(LAS f32x4*)(scr + k * 64 + (n4 ^ (8 * (k >> 3)))) = v[q]; }
    asm volatile("s_waitcnt lgkmcnt(0)" ::: "memory");
    const int kg = lane >> 3, r = lane & 7;
#pragma unroll
    for (int s = 0; s < 8; ++s) {
        const int n = 8 * s + r; const LAS float* sp = scr + (8 * kg) * 64 + (n ^ (8 * kg));
        u32x4 w; w.x = pk2(sp[0], sp[64]); w.y = pk2(sp[128], sp[192]); w.z = pk2(sp[256], sp[320]); w.w = pk2(sp[384], sp[448]);
        *(u32x4*)(dst + (size_t)n * lddst + 8 * kg) = w;
    }
    asm volatile("s_waitcnt lgkmcnt(0)" ::: "memory");
}
constexpr int I_IN = 32 * 96, I_PA = 16 * 32, I_O = 32 * 32, I_EX = 65 * 256, I_LAYER = 2 * I_IN + 2 * I_PA + I_O + 3 * I_EX;
__device__ __forceinline__ void prologue_item(const Params& p, int it, LAS float* scr, int lane) {
    const int l = it / I_LAYER; int r = it % I_LAYER;
    unsigned char* wl = p.ws + WS_W + (size_t)l * WL_BYTES;
    if (r < 2 * I_IN) {
        const int which = r / I_IN; r %= I_IN; const int kb = r / 96, nb = r % 96;
        const float* src = p.in[which ? 9 : 3] + (size_t)l * D * INC + (size_t)(kb * 64) * INC + nb * 64;
        tr_item(src, INC, (bf16*)(wl + WL_IG) + (size_t)(which * INC + nb * 64) * D + kb * 64, D, scr, lane); return; }
    r -= 2 * I_IN;
    if (r < 2 * I_PA) {
        const int which = r / I_PA; r %= I_PA; const int kb = r / 32, nb = r % 32;
        const float* src = p.in[11 + which] + (size_t)l * 1024 * D + (size_t)(kb * 64) * D + nb * 64;
        tr_item(src, D, (bf16*)(wl + WL_ABC) + (size_t)which * D * 1024 + (size_t)(nb * 64) * 1024 + kb * 64, 1024, scr, lane); return; }
    r -= 2 * I_PA;
    if (r < I_O) {
        const int kb = r / 32, nb = r % 32;
        const float* src = p.in[14] + (size_t)l * D * D + (size_t)(kb * 64) * D + nb * 64;
        tr_item(src, D, (bf16*)(wl + WL_O) + (size_t)(nb * 64) * D + kb * 64, D, scr, lane); return; }
    r -= I_O;
    const int kind = r / I_EX; r %= I_EX; const int e = r >> 8; r &= 255;
    if (kind < 2) {
        const int kb = r >> 3, nb = r & 7, n0 = nb * 64;
        const float* src = (e < 64 ? p.in[19 + kind] + ((size_t)l * 64 + e) * D * EH : p.in[22 + kind] + (size_t)l * D * EH) + (size_t)(kb * 64) * EH + n0;
        const int drow = (n0 >> 7) * 256 + kind * 128 + (n0 & 127);
        tr_item(src, EH, (bf16*)(wl + WL_GU) + (size_t)e * 1024 * D + (size_t)drow * D + kb * 64, D, scr, lane);
    } else {
        const int kb = r >> 5, nb = r & 31;
        const float* src = (e < 64 ? p.in[21] + ((size_t)l * 64 + e) * EH * D : p.in[24] + (size_t)l * EH * D) + (size_t)(kb * 64) * D + nb * 64;
        tr_item(src, D, (bf16*)(wl + WL_D) + (size_t)e * D * EH + (size_t)(nb * 64) * EH + kb * 64, EH, scr, lane);
    }
}
__device__ __forceinline__ void wcprime_tile(const Params& p, int tile, LAS bf16* sA, LAS bf16* sB, int tid) {
    const int l = tile >> 8, g = (tile >> 6) & 3, tm = (tile >> 5) & 1, tn = tile & 31;
    const int lane = tid & 63, wid = tid >> 6, wm = wid >> 1, wn = wid & 1, fr = lane & 15, fq = lane >> 4;
    const float* Ap = p.in[7] + ((size_t)l * 4 + g) * 256 * 256; const float* sc = p.in[8] + (size_t)l * 1024 + g * 256;
    const float* Wp = p.in[13] + (size_t)l * 1024 * D + (size_t)(g * 256) * D;
    bf16* dst = (bf16*)(p.ws + WS_W + (size_t)l * WL_BYTES + WL_ABC) + (size_t)2 * D * 1024;
    f32x4 acc[2][2];
#pragma unroll
    for (int a = 0; a < 2; ++a)
#pragma unroll
        for (int b = 0; b < 2; ++b) acc[a][b] = (f32x4){0.f, 0.f, 0.f, 0.f};
    const int ar = tid >> 2, akseg = (tid & 3) * 8, wk = tid >> 4, wns = (tid & 15) * 4;
    for (int k0 = 0; k0 < 256; k0 += 32) {
        const float* ap = Ap + (size_t)(tm * 128 + ar) * 256 + k0 + akseg;
        const f32x4 x0 = *(const f32x4*)ap, x1 = *(const f32x4*)(ap + 4), s0 = *(const f32x4*)(sc + k0 + akseg), s1 = *(const f32x4*)(sc + k0 + akseg + 4);
        u32x4 av; av.x = pk2(x0.x * s0.x, x0.y * s0.y); av.y = pk2(x0.z * s0.z, x0.w * s0.w); av.z = pk2(x1.x * s1.x, x1.y * s1.y); av.w = pk2(x1.z * s1.z, x1.w * s1.w);
        const f32x4 wv = *(const f32x4*)(Wp + (size_t)(k0 + wk) * D + tn * 64 + wns);
        *(LAS u32x4*)(sA + ar * 40 + akseg) = av;
        sB[(wns + 0) * 40 + wk] = (bf16)f2bf(wv.x); sB[(wns + 1) * 40 + wk] = (bf16)f2bf(wv.y); sB[(wns + 2) * 40 + wk] = (bf16)f2bf(wv.z); sB[(wns + 3) * 40 + wk] = (bf16)f2bf(wv.w);
        __syncthreads();
#pragma unroll
        for (int mi = 0; mi < 2; ++mi) {
            const bf16x8 a = *(const LAS bf16x8*)(sA + (wm * 32 + mi * 16 + fr) * 40 + fq * 8);
#pragma unroll
            for (int ni = 0; ni < 2; ++ni) {
                const bf16x8 b = *(const LAS bf16x8*)(sB + (wn * 32 + ni * 16 + fr) * 40 + fq * 8);
                acc[mi][ni] = __builtin_amdgcn_mfma_f32_16x16x32_bf16(a, b, acc[mi][ni], 0, 0, 0);
            }
        }
        __syncthreads();
    }
#pragma unroll
    for (int mi = 0; mi < 2; ++mi)
#pragma unroll
        for (int ni = 0; ni < 2; ++ni)
#pragma unroll
            for (int j = 0; j < 4; ++j) { const int c = tm * 128 + wm * 32 + mi * 16 + fq * 4 + j, n = tn * 64 + wn * 32 + ni * 16 + fr;
                dst[(size_t)n * 1024 + g * 256 + c] = (bf16)f2bf(acc[mi][ni][j]); }
}

__global__ void __launch_bounds__(512, 2) fwd(Params p) {
    extern __shared__ __attribute__((aligned(16))) unsigned char lds_raw[];
    LAS unsigned char* lds = (LAS unsigned char*)lds_raw;
    LAS MoeTab* tb = (LAS MoeTab*)(lds + LDSCTL_OFF);
    volatile LAS unsigned* MISC = (volatile LAS unsigned*)(lds + MISC_OFF);
    const int G = gridDim.x, bx = blockIdx.x; const int vcu = (G % 8 == 0) ? (bx % 8) * (G / 8) + bx / 8 : bx;
    if (threadIdx.x < 32) MISC[threadIdx.x] = 0u;
    __syncthreads();
    unsigned* ctl = (unsigned*)(p.ws + WS_CTL);
    XcdBarrier bar; bar.bar = ctl + CW_BAR; bar.x = 0; bar.st = nullptr;
    const int lo = p.ph_lo, hi = p.ph_hi;
    if (hi - lo > 1) bar = xcd_barrier_post(ctl + CW_BAR, MISC + 8);
#define IN(k) (lo <= (k) && (k) < hi)
#define SEAM(k) do { if (IN(k) && IN((k) + 1)) xcd_barrier(bar); } while (0)

    if (IN(0)) for (int rep = 0; rep < REPS(0); ++rep) {
        const int tid = ltid(), lane = tid & 63, wave = __builtin_amdgcn_readfirstlane(tid >> 6);
        LAS float* scr = (LAS float*)(lds + wave * 16384);
        const int gw = vcu * 8 + wave, NGW = G * 8;
        for (int it = gw; it < NL * I_LAYER; it += NGW) prologue_item(p, it, scr, lane);
        for (int t = gw; t < T; t += NGW) entry_ln_row(p, t, lane);
        __syncthreads();
        for (int tile = bx; tile < 512; tile += G) wcprime_tile(p, tile, (LAS bf16*)lds, (LAS bf16*)(lds + 16384), tid);
    }
    SEAM(0);

    for (int l = 0; l < NL; ++l) {
        const int pb = 1 + 8 * l;
        const char* wl = (const char*)(p.ws + WS_W + (size_t)l * WL_BYTES);
        if (IN(pb + 0)) for (int rep = 0; rep < REPS(1); ++rep) {
            pg8::DenseSched S; S.A = (const char*)(p.ws + WS_XB); S.B = wl + WL_IG; S.atile = (size_t)256 * D * 2; S.btile = (size_t)256 * D * 2; S.nM = 32; S.nN = 48; S.G = G; S.c = bx;
            pg8::EpiP1 E{(bf16*)(p.ws + WS_PROJ), (bf16*)(p.ws + WS_GATE), p.in[10] + (size_t)l * INC};
            pg8::gemm_phase<pg8::EpiP1, pg8::DenseSched, false>(lds, D, D, D, S, E);
        }
        SEAM(pb + 0);
        if (IN(pb + 1)) for (int rep = 0; rep < REPS(2); ++rep) {
            const int tid = ltid();
            for (int u = bx; u < 256; u += G) spatial_unit(p, l, u, lds, tid);
            for (int it = bx * 512 + tid; it < 131072; it += G * 512) convpool_task(p, l, it);
        }
        SEAM(pb + 1);
        if (IN(pb + 2)) for (int rep = 0; rep < REPS(3); ++rep) {
            pg8::ProjSched S; S.A = (const char*)(p.ws + WS_YABC); S.B = wl + WL_ABC; S.G = G; S.c = bx;
            pg8::EpiP3 E{(const bf16*)(p.ws + WS_GATE), (float*)(p.ws + WS_MF32), (bf16*)(p.ws + WS_MERGED)};
            pg8::gemm_phase<pg8::EpiP3, pg8::ProjSched, false>(lds, 1024, 3072, 1024, S, E);
        }
        SEAM(pb + 2);
        if (IN(pb + 3)) for (int rep = 0; rep < REPS(4); ++rep) {
            pg8::DenseSched S; S.A = (const char*)(p.ws + WS_MERGED); S.B = wl + WL_O; S.atile = (size_t)256 * D * 2; S.btile = (size_t)256 * D * 2; S.nM = 32; S.nN = 8; S.G = G; S.c = bx;
            pg8::EpiP4 E{(const float*)(p.ws + WS_X), (float*)(p.ws + WS_PRE)};
            pg8::gemm_phase<pg8::EpiP4, pg8::DenseSched, false>(lds, D, D, D, S, E);
        }
        SEAM(pb + 3);
        if (IN(pb + 4)) {
            const int tid = ltid();
            for (int u = bx; u < T / 32; u += G) ln1_router_unit(p, l, u, lds, tid);
        }
        SEAM(pb + 4);
        if (IN(pb + 5)) for (int rep = 0; rep < REPS(6); ++rep) {
            moe_tables(p, l, tb, ltid());
            pg8::MoeSched<4, true> S; S.tb = tb; S.A = (const char*)(p.ws + WS_XB); S.B = wl + WL_GU; S.bexp = (size_t)1024 * D * 2; S.btile = (size_t)256 * D * 2;
            S.list = (const int*)(p.ws + WS_LIST) + (size_t)l * 64 * 8192; S.G = G; S.vcu = vcu;
            pg8::EpiP6 E{(bf16*)(p.ws + WS_H)};
            pg8::gemm_phase<pg8::EpiP6, pg8::MoeSched<4, true>, true>(lds, D, D, D, S, E);
        }
        SEAM(pb + 5);
        if (IN(pb + 6)) for (int rep = 0; rep < REPS(7); ++rep) {
            moe_tables(p, l, tb, ltid());
            pg8::MoeSched<8, false> S; S.tb = tb; S.A = (const char*)(p.ws + WS_H); S.B = wl + WL_D; S.bexp = (size_t)D * EH * 2; S.btile = (size_t)256 * EH * 2;
            S.list = nullptr; S.G = G; S.vcu = vcu;
            pg8::EpiP7 E{(bf16*)(p.ws + WS_Y)};
            pg8::gemm_phase<pg8::EpiP7, pg8::MoeSched<8, false>, false>(lds, EH, EH, EH, S, E);
        }
        SEAM(pb + 6);
        if (IN(pb + 7)) {
            const int tid = ltid(), lane = tid & 63, wave = __builtin_amdgcn_readfirstlane(tid >> 6);
            moe_tables(p, l, tb, tid);
            const int gw = bx * 8 + wave, NGW = G * 8;
            for (int t = gw; t < T; t += NGW) combine_ln2_row(p, l, t, tb, lane, l == NL - 1);
        }
        SEAM(pb + 7);
    }
#undef IN
#undef SEAM
}

extern "C" void kernel_launch(void* const* d_in, const int* in_sizes, int n_in, void* d_out, int out_size, void* d_ws, size_t ws_size, hipStream_t stream) {
    static int grid = 0;
    if (grid == 0) {
        if (n_in != 27 || out_size != T * D || ws_size < WS_END) { fprintf(stderr, "kernel_launch: unexpected shapes (n_in %d out %d ws %zu, need %zu)\n", n_in, out_size, ws_size, (size_t)WS_END); grid = -1; return; }
        int dev = 0, cus = 0, per_cu = 0;
        if (hipGetDevice(&dev) != hipSuccess || hipDeviceGetAttribute(&cus, hipDeviceAttributeMultiprocessorCount, dev) != hipSuccess) { fprintf(stderr, "kernel_launch: device query failed\n"); grid = -1; return; }
        if (hipFuncSetAttribute((const void*)fwd, hipFuncAttributeMaxDynamicSharedMemorySize, LDS_BYTES) != hipSuccess) { fprintf(stderr, "kernel_launch: hipFuncSetAttribute failed\n"); grid = -1; return; }
        if (hipOccupancyMaxActiveBlocksPerMultiprocessor(&per_cu, (const void*)fwd, 512, LDS_BYTES) != hipSuccess || per_cu < 1) fprintf(stderr, "kernel_launch: note: occupancy query reports %d workgroups per CU\n", per_cu);
        (void)hipGetLastError();
        grid = cus;
    }
    if (grid < 0) return;
    if (hipMemsetAsync((char*)d_ws + WS_CTL, 0, 1 * MiB, stream) != hipSuccess) { fprintf(stderr, "kernel_launch: memset failed\n"); return; }
    Params p{};
    for (int i = 0; i < 27; ++i) p.in[i] = (const float*)d_in[i];
    p.out = (float*)d_out; p.ws = (unsigned char*)d_ws;
#if MK_N_LAUNCHES == 1
    p.ph_lo = 0; p.ph_hi = NPHASES;
    hipLaunchKernelGGL(fwd, dim3(grid), dim3(512), LDS_BYTES, stream, p);
#else
    for (int ph = 0; ph < NPHASES; ++ph) { p.ph_lo = ph; p.ph_hi = ph + 1; hipLaunchKernelGGL(fwd, dim3(grid), dim3(512), LDS_BYTES, stream, p); }
#endif
    const hipError_t le = hipPeekAtLastError();
    if (le != hipSuccess) fprintf(stderr, "kernel_launch: launch failed: %s\n", hipGetErrorName(le));
}
```

```cpp
#include <hip/hip_runtime.h>
#include <cstdio>
#include <cstdint>

#ifndef MK_N_LAUNCHES
#define MK_N_LAUNCHES 1
#endif

#ifndef REP_MASK
#define REP_MASK 0
#endif
#define REPS(k) (1 + ((REP_MASK >> (k)) & 1))
#define LAS __attribute__((address_space(3)))
typedef unsigned short bf16;
typedef short bf16x8 __attribute__((ext_vector_type(8)));
typedef float f32x4 __attribute__((ext_vector_type(4)));
typedef float f32x2 __attribute__((ext_vector_type(2)));
typedef unsigned u32x4 __attribute__((ext_vector_type(4)));
typedef unsigned u32x2 __attribute__((ext_vector_type(2)));

constexpr int T = 8192, D = 2048, NL = 2, INC = 6144, NE = 64, EH = 512;
constexpr float ALPHA = 1.41421356237309515f;
constexpr float LN_EPS = 1e-5f;
constexpr float ROUTED_SCALE = 2.5f;
constexpr int NPHASES = 1 + 8 * NL;

constexpr size_t MiB = 1ull << 20;
constexpr size_t WS_CTL = 0;
constexpr size_t WS_TOPE = 1 * MiB, WS_TOPPOS = WS_TOPE + 256 * 1024, WS_TOPW = WS_TOPPOS + 256 * 1024;
constexpr size_t WS_LIST = 2 * MiB;
constexpr size_t WS_X = 8 * MiB;
constexpr size_t WS_XB = 72 * MiB;
constexpr size_t WS_PROJ = 104 * MiB;
constexpr size_t WS_GATE = 200 * MiB;
constexpr size_t WS_YABC = 296 * MiB;
constexpr size_t WS_MERGED = 360 * MiB;
constexpr size_t WS_MF32 = 392 * MiB;
constexpr size_t WS_PRE = 456 * MiB;
constexpr size_t WS_H = 520 * MiB;
constexpr size_t WS_Y = 608 * MiB;
constexpr size_t WS_W = 960 * MiB;
constexpr int HROWS = 90112;
constexpr size_t WL_IG = 0;
constexpr size_t WL_ABC = 48 * MiB;
constexpr size_t WL_O = 60 * MiB;
constexpr size_t WL_GU = 68 * MiB;
constexpr size_t WL_D = 328 * MiB;
constexpr size_t WL_BYTES = 458 * MiB;
constexpr size_t WS_END = WS_W + 2 * WL_BYTES;
constexpr int CW_CNT = 1024;
constexpr int CW_BAR = 4096;
constexpr int LDS_BYTES = 147456;
constexpr int LDSCTL_OFF = 143360;
constexpr int MISC_OFF = LDSCTL_OFF + 2048;

struct Params { const float* in[27]; float* out; unsigned char* ws; int ph_lo, ph_hi; };

__device__ __forceinline__ float bf2f(unsigned b) { return __uint_as_float(b << 16); }
__device__ __forceinline__ float bflo(unsigned w) { return __uint_as_float(w << 16); }
__device__ __forceinline__ float bfhi(unsigned w) { return __uint_as_float(w & 0xffff0000u); }
__device__ __forceinline__ unsigned f2bf(float f) { unsigned u = __float_as_uint(f); return (u + 0x7fffu + ((u >> 16) & 1u)) >> 16; }
__device__ __forceinline__ unsigned cvt_pk_bf16(float lo, float hi) { unsigned r; asm volatile("v_cvt_pk_bf16_f32 %0, %1, %2" : "=v"(r) : "v"(lo), "v"(hi)); return r; }
__device__ __forceinline__ unsigned pk2(float lo, float hi) { return f2bf(lo) | (f2bf(hi) << 16); }
__device__ __forceinline__ float wave_sum(float v) {
#pragma unroll
    for (int o = 1; o < 64; o <<= 1) v += __shfl_xor(v, o);
    return v;
}
__device__ __forceinline__ int ltid(int wave0) { int t; asm volatile("v_mbcnt_lo_u32_b32 %0, -1, 0\n\tv_mbcnt_hi_u32_b32 %0, -1, %0" : "=v"(t)); return (wave0 << 6) | t; }
__device__ __forceinline__ float sigmoidf_(float v) { return 1.0f / (1.0f + __expf(-v)); }
__device__ __forceinline__ float fast_sigmoid(float v) { return __builtin_amdgcn_rcpf(1.0f + __builtin_amdgcn_exp2f(v * -1.44269504089f)); }
__device__ __forceinline__ f32x2 gelu_pk(f32x2 v) {
    const f32x2 av = __builtin_elementwise_abs(v), d = av * 0.2316418882f + 1.0f;
    f32x2 t; t.x = __builtin_amdgcn_rcpf(d.x); t.y = __builtin_amdgcn_rcpf(d.y);
    f32x2 q = t * 0.5307027145f + (-0.7265760135f); q = q * t + 0.7107068705f; q = q * t + (-0.142248368f); q = q * t + 0.127414796f; q = q * t;
    const f32x2 s = (v * v) * (-0.72134752044f);
    f32x2 e; e.x = __builtin_amdgcn_exp2f(s.x); e.y = __builtin_amdgcn_exp2f(s.y);
    const f32x2 m = v * (q * e), r = v - m;
    f32x2 o; o.x = v.x < 0.f ? m.x : r.x; o.y = v.y < 0.f ? m.y : r.y; return o;
}

struct MoeTab { int cnt[65]; int rb[66]; int tq[66]; int pad[3]; unsigned char tile_e[384]; };
__device__ __forceinline__ void moe_tables(const Params& p, int l, LAS MoeTab* tb, int tid) {
    __syncthreads();
    if (tid < 65) tb->cnt[tid] = (tid < 64) ? (int)__hip_atomic_load((unsigned*)(p.ws + WS_CTL) + CW_CNT + 64 * l + tid, __ATOMIC_RELAXED, __HIP_MEMORY_SCOPE_AGENT) : T;
    __syncthreads();
    if (tid == 0) { int rb = 0, tq = 0;
        for (int e = 0; e < 65; ++e) { const int n = tb->cnt[e]; tb->rb[e] = rb; tb->tq[e] = tq; rb += ((n + 255) >> 8) << 8; tq += (n + 255) >> 8; }
        tb->rb[65] = rb; tb->tq[65] = tq; }
    __syncthreads();
    if (tid < 65) { const int a = tb->tq[tid], b = tb->tq[tid + 1]; for (int k = a; k < b; ++k) tb->tile_e[k] = (unsigned char)tid; }
    __syncthreads();
}

#ifndef CONVMODE
#define CONVMODE 0
#endif
#ifndef STAG1
#define STAG1 0
#define STAG3 0
#define STAG6 0
#define STAG7 0
#endif
#define STAGGER(step) ((unsigned)(((bx * 7) & 15) * (step)))
#ifndef PG8_ALIGN
#define PG8_ALIGN true
#endif
namespace pg8 {
constexpr bool ALIGN_EPI = PG8_ALIGN;
constexpr int BM = 256, BK = 64, HALF = 128, HTB = HALF * BK * 2, STAGE_BYTES = 8 * HTB, NXCD = 8, WGM = 8;
__device__ __forceinline__ int lds_byte(int r, int c) { const int st = (r >> 4) * 2 + (c >> 5), rr = r & 15, cc = c & 31, ob = rr * 64 + cc * 2; return st * 1024 + (ob ^ (((ob >> 9) & 1) << 5)); }
__device__ __forceinline__ void stage_rc(int b, int& R, int& C) { const int st = b / 1024, sb = b % 1024, swz = sb ^ (((sb >> 9) & 1) << 5); R = (st >> 1) * 16 + swz / 64; C = (st & 1) * 32 + (swz % 64) / 2; }
__device__ __forceinline__ int perm32(int rho) { const int n = rho >> 4, i = rho & 15; return 8 * (i >> 2) + 4 * n + (i & 3); }

struct Unit { const char* A; const char* B; int orow, pn, seg, e, m0; };

__device__ __forceinline__ void tile_of(int L, int nM, int nN, int& pm, int& pn) {
    const int nwg = nM * nN; int wgid = L; { const int q = nwg / NXCD, r = nwg % NXCD, xcd = wgid % NXCD, off = wgid / NXCD; wgid = (xcd < r ? xcd * (q + 1) : r * (q + 1) + (xcd - r) * q) + off; }
    const int nig = WGM * nN, gid = wgid / nig, fm = gid * WGM, gsz = (nM - fm) < WGM ? (nM - fm) : WGM;
    pm = fm + ((wgid % nig) % gsz); pn = (wgid % nig) / gsz;
}
struct DenseSched {
    const char* A; const char* B; size_t atile, btile; int nM, nN, G, c;
    __device__ __forceinline__ bool next(int i, Unit& u) const {
        const int L = i * G + c; if (L >= nM * nN) return false;
        int pm, pn; tile_of(L, nM, nN, pm, pn);
        u.A = A + (size_t)pm * atile; u.B = B + (size_t)pn * btile; u.orow = pm * BM; u.pn = pn; u.seg = 0; u.e = 0; u.m0 = 0; return true; }
    __device__ __forceinline__ int row(const Unit&, int) const { return 0; }
};
struct ProjSched {
    const char* A; const char* B; int G, c;
    __device__ __forceinline__ bool next(int i, Unit& u) const {
        const int L = (i / 3) * G + c; if (L >= 32 * 8) return false;
        int pm, pn; tile_of(L, 32, 8, pm, pn); const int seg = i % 3;
        u.A = A + ((size_t)pm * BM * 3072 + (size_t)seg * 1024) * 2; u.B = B + ((size_t)seg * 2048 * 1024 + (size_t)pn * BM * 1024) * 2; u.orow = pm * BM; u.pn = pn; u.seg = seg; u.e = 0; u.m0 = 0; return true; }
    __device__ __forceinline__ int row(const Unit&, int) const { return 0; }
};
template <int NT, bool GATH> struct MoeSched {
    const LAS MoeTab* tb; const char* A; const char* B; size_t bexp, btile; const int* list; const LAS int* rows; int G, vcu;
    __device__ __forceinline__ bool next(int i, Unit& u) const {
        const int L = i * G + vcu; if (L >= tb->tq[65] * NT) return false;
        const int mt = L / NT, pn = L % NT; const int e = tb->tile_e[mt];
        const int m0 = (mt - tb->tq[e]) * BM;
        u.e = e; u.m0 = m0; u.orow = tb->rb[e] + m0; u.pn = pn; u.seg = i;
        u.B = B + (size_t)e * bexp + (size_t)pn * btile;
        u.A = GATH ? A : A + (size_t)u.orow * EH * 2; return true; }
    __device__ __forceinline__ int row_global(const Unit& u, int r) const { const int idx = u.m0 + r; if (u.e == 64) return idx; return idx < tb->cnt[u.e] ? list[u.e * 8192 + idx] : 0; }
    __device__ __forceinline__ int row(const Unit& u, int r) const { return rows[u.seg * 256 + r]; }
    __device__ __forceinline__ void preload_rows(LAS int* dst, int tid) const {
        int v[8]; bool ok[8];
#pragma unroll
        for (int i = 0; i < 8; ++i) { Unit u; ok[i] = next(i, u); v[i] = (ok[i] && tid < 256) ? row_global(u, tid) : 0; }
#pragma unroll
        for (int i = 0; i < 8; ++i) if (ok[i] && tid < 256) dst[i * 256 + tid] = v[i];
        __syncthreads();
    }
};

template <class Epi, class Sched, bool GATHER>
__device__ __forceinline__ void gemm_phase(LAS unsigned char* lds, const int K, const int lda, const int ldb, const Sched& S, const Epi& E, const int wave0, const unsigned stagger_ticks = 0u) {
    if (stagger_ticks) { const unsigned long long t0 = __builtin_amdgcn_s_memrealtime(); while (__builtin_amdgcn_s_memrealtime() - t0 < (unsigned long long)stagger_ticks) __builtin_amdgcn_s_sleep(4); }
    const int tid = ltid(wave0), wid = wave0, lane = tid & 63, wr = wid >> 2, wc = wid & 3, fr = lane & 15, fq = lane >> 4;
    const int nt = K / BK;
    unsigned voffB[2], voffA[2][2], voffN[2][2]; int Rr[2], Cc[2];
#pragma unroll
    for (int i = 0; i < 2; ++i) { int R, C; stage_rc(tid * 16 + i * 8192, R, C); const int Rb = (R & ~31) + perm32(R & 31);
        Rr[i] = R; Cc[i] = C; voffB[i] = (unsigned)(Rb * ldb + C) * 2u;
        voffA[0][i] = (unsigned)(R * lda + C) * 2u; voffA[1][i] = (unsigned)((R + HALF) * lda + C) * 2u; voffN[0][i] = voffA[0][i]; voffN[1][i] = voffA[1][i]; }
    const size_t kstep = (size_t)(BK * 2);
    const size_t hstepB = (size_t)HALF * ldb * 2;
    const unsigned ldsw = (unsigned)wid * 1024u;
    const int aoff = lds_byte(wr * 64 + fr, fq * 8), boff = lds_byte(wc * 32 + fr, fq * 8);
#define PG8_SA(b, h) (((b) * 2 + (h)) * HTB)
#define PG8_SB(b, h) ((4 + (b) * 2 + (h)) * HTB)
#define PG8_STAGE_B(bufoff, gbase) do { _Pragma("unroll") for (int _i = 0; _i < 2; ++_i) \
        __builtin_amdgcn_global_load_lds((const unsigned*)((const char*)(gbase) + voffB[_i]), (LAS unsigned*)(lds + (bufoff) + ldsw + _i * 8192), 16, 0, 0); } while (0)
#define PG8_STAGE_A(bufoff, gbase, VO, h) do { _Pragma("unroll") for (int _i = 0; _i < 2; ++_i) \
        __builtin_amdgcn_global_load_lds((const unsigned*)((const char*)(gbase) + (VO)[h][_i]), (LAS unsigned*)(lds + (bufoff) + ldsw + _i * 8192), 16, 0, 0); } while (0)
#define PG8_LDA(dst, b, h) do { _Pragma("unroll") for (int m = 0; m < 4; ++m) _Pragma("unroll") for (int k = 0; k < 2; ++k) dst[m][k] = *(const LAS bf16x8*)(lds + PG8_SA(b, h) + aoff + m * 2048 + k * 1024); } while (0)
#define PG8_LDB(dst, b, h) do { _Pragma("unroll") for (int n = 0; n < 2; ++n) _Pragma("unroll") for (int k = 0; k < 2; ++k) dst[n][k] = *(const LAS bf16x8*)(lds + PG8_SB(b, h) + boff + n * 2048 + k * 1024); } while (0)
#define PG8_MMA(ai, bj, At, Bt) do { __builtin_amdgcn_s_setprio(1); _Pragma("unroll") for (int m = 0; m < 4; ++m) _Pragma("unroll") for (int n = 0; n < 2; ++n) _Pragma("unroll") for (int k = 0; k < 2; ++k) \
        acc[ai][bj][m][n] = __builtin_amdgcn_mfma_f32_16x16x32_bf16(Bt[n][k], At[m][k], acc[ai][bj][m][n], 0, 0, 0); __builtin_amdgcn_s_setprio(0); } while (0)
#define PG8_WAIT_V(n) asm volatile("s_waitcnt vmcnt(" #n ")" ::: "memory")
#define PG8_WAIT_L(n) asm volatile("s_waitcnt lgkmcnt(" #n ")" ::: "memory")
#define PG8_WAIT_VX(rx) do { if (rx) asm volatile("s_waitcnt vmcnt(%0)" :: "n"(8 + Epi::NVM) : "memory"); else asm volatile("s_waitcnt vmcnt(8)" ::: "memory"); } while (0)
#define PG8_BAR __builtin_amdgcn_s_barrier()
#define PG8_SCHED __builtin_amdgcn_sched_barrier(0)
    Unit cur, nxt; int ui = 0;
    if (!S.next(0, cur)) return;
    if constexpr (GATHER) {
#pragma unroll
        for (int h = 0; h < 2; ++h)
#pragma unroll
            for (int i = 0; i < 2; ++i) voffA[h][i] = (unsigned)(S.row(cur, Rr[i] + h * HALF) * lda + Cc[i]) * 2u;
    }
    f32x4 acc[2][2][4][2];
#pragma unroll
    for (int a = 0; a < 2; ++a)
#pragma unroll
        for (int b = 0; b < 2; ++b)
#pragma unroll
            for (int m = 0; m < 4; ++m)
#pragma unroll
                for (int n = 0; n < 2; ++n) acc[a][b][m][n] = (f32x4){0.f, 0.f, 0.f, 0.f};
    bf16x8 At[4][2], B0[2][2], B1[2][2];
    const char* cA = cur.A; const char* cB = cur.B;
    PG8_STAGE_B(PG8_SB(0, 0), cB); PG8_STAGE_B(PG8_SB(0, 1), cB + hstepB); PG8_STAGE_A(PG8_SA(0, 0), cA, voffA, 0); PG8_STAGE_A(PG8_SA(0, 1), cA, voffA, 1);
    if (wr == 1) PG8_BAR;
    PG8_WAIT_V(2); PG8_BAR;
    PG8_STAGE_B(PG8_SB(1, 0), cB + kstep); PG8_STAGE_A(PG8_SA(1, 0), cA + kstep, voffA, 0); PG8_STAGE_B(PG8_SB(1, 1), cB + hstepB + kstep);
    PG8_WAIT_V(6); PG8_BAR;
    bool relax = false;
    for (;;) {
        const bool has_next = S.next(ui + 1, nxt);
        if constexpr (GATHER) {
            if (has_next) {
#pragma unroll
                for (int h = 0; h < 2; ++h)
#pragma unroll
                    for (int i = 0; i < 2; ++i) voffN[h][i] = (unsigned)(S.row(nxt, Rr[i] + h * HALF) * lda + Cc[i]) * 2u;
            } else {
#pragma unroll
                for (int h = 0; h < 2; ++h)
#pragma unroll
                    for (int i = 0; i < 2; ++i) voffN[h][i] = voffA[h][i];
            }
        }
        const char* nA = has_next ? nxt.A : cA; const char* nB = has_next ? nxt.B : cB;
        for (int t = 0; t < nt; t += 2) {
            const bool last = (t == nt - 2); int rxi = (relax && t == 0) ? 1 : 0; asm volatile("" : "+v"(rxi)); const bool rx = __builtin_amdgcn_readfirstlane(rxi) != 0;
            if constexpr (Epi::HAS_MID) { if (t == 16 || t == 32) { PG8_SCHED; E.mid(acc, cur, t >> 4, wr, wc, fr, fq); PG8_SCHED; } }
            const char* a1 = cA + (size_t)(t + 1) * kstep;
            const char* a2 = last ? nA : cA + (size_t)(t + 2) * kstep; const char* b2 = last ? nB : cB + (size_t)(t + 2) * kstep;
            const char* a3 = a2 + kstep; const char* b3 = b2 + kstep;
            unsigned vo2[2][2];
#pragma unroll
            for (int h = 0; h < 2; ++h)
#pragma unroll
                for (int i = 0; i < 2; ++i) vo2[h][i] = (GATHER && last) ? voffN[h][i] : voffA[h][i];
            PG8_LDB(B0, 0, 0); PG8_LDB(B1, 0, 1); PG8_SCHED; PG8_LDA(At, 0, 0); if (!rx) PG8_STAGE_A(PG8_SA(1, 1), a1, voffA, 1);
            PG8_WAIT_VX(rx); PG8_WAIT_L(0); PG8_BAR; PG8_MMA(0, 0, At, B0); PG8_MMA(0, 1, At, B1); PG8_BAR; PG8_SCHED;
            PG8_LDA(At, 0, 1); PG8_STAGE_B(PG8_SB(0, 0), b2); PG8_STAGE_B(PG8_SB(0, 1), b2 + hstepB); PG8_STAGE_A(PG8_SA(0, 0), a2, vo2, 0);
            PG8_WAIT_VX(rx); PG8_WAIT_L(0); PG8_BAR; PG8_MMA(1, 0, At, B0); PG8_MMA(1, 1, At, B1); PG8_BAR; PG8_SCHED;
            PG8_LDB(B0, 1, 0); PG8_LDB(B1, 1, 1); PG8_SCHED; PG8_LDA(At, 1, 0); PG8_STAGE_A(PG8_SA(0, 1), a2, vo2, 1);
            PG8_WAIT_VX(rx); PG8_WAIT_L(0); PG8_BAR; PG8_MMA(0, 0, At, B0); PG8_MMA(0, 1, At, B1); PG8_BAR; PG8_SCHED;
            PG8_LDA(At, 1, 1); PG8_STAGE_B(PG8_SB(1, 0), b3); PG8_STAGE_B(PG8_SB(1, 1), b3 + hstepB); PG8_STAGE_A(PG8_SA(1, 0), a3, vo2, 0);
            PG8_WAIT_V(8); PG8_WAIT_L(0); PG8_BAR; PG8_MMA(1, 0, At, B0); PG8_MMA(1, 1, At, B1); PG8_BAR; PG8_SCHED;
        }
        if (ALIGN_EPI) { if (wr == 0) PG8_BAR; }
        if (ALIGN_EPI && has_next) { if constexpr (GATHER) PG8_STAGE_A(PG8_SA(1, 1), nA + kstep, voffN, 1); else PG8_STAGE_A(PG8_SA(1, 1), nA + kstep, voffA, 1); }
        E(acc, cur, wr, wc, fr, fq);
        if (!has_next) break;
#pragma unroll
        for (int a = 0; a < 2; ++a)
#pragma unroll
            for (int b = 0; b < 2; ++b)
#pragma unroll
                for (int m = 0; m < 4; ++m)
#pragma unroll
                    for (int n = 0; n < 2; ++n) acc[a][b][m][n] = (f32x4){0.f, 0.f, 0.f, 0.f};
        cur = nxt; cA = nA; cB = nB; ++ui; relax = ALIGN_EPI;
        if constexpr (GATHER) {
#pragma unroll
            for (int h = 0; h < 2; ++h)
#pragma unroll
                for (int i = 0; i < 2; ++i) voffA[h][i] = voffN[h][i];
        }
        if (ALIGN_EPI) { if (wr == 1) PG8_BAR; }
    }
    PG8_WAIT_V(0);
    if (!ALIGN_EPI) { if (wr == 0) PG8_BAR; }
    PG8_BAR;
#undef PG8_SA
#undef PG8_SB
#undef PG8_STAGE_A
#undef PG8_STAGE_B
#undef PG8_LDA
#undef PG8_LDB
#undef PG8_MMA
#undef PG8_WAIT_V
#undef PG8_WAIT_L
#undef PG8_WAIT_VX
#undef PG8_BAR
#undef PG8_SCHED
}

#define EPI_ROWCOL const int row0 = u.orow + wr * 64 + fr, colw = wc * 32 + 8 * fq
struct EpiP1 {
    static constexpr int NVM = 16;
    static constexpr bool HAS_MID = false;
    bf16* PROJ; bf16* GATE; const float* bgate;
    __device__ __forceinline__ void operator()(const f32x4 (&acc)[2][2][4][2], const Unit& u, int wr, int wc, int fr, int fq) const {
        EPI_ROWCOL; const int pn = u.pn; const int mode = pn < 8 ? 1 : (pn < 24 ? 0 : 2);
        bf16* base = (mode == 2) ? GATE : PROJ; const int colt = ((mode == 2) ? (pn - 24) : pn) * BM + colw;
        f32x4 bv[2][2];
#pragma unroll
        for (int bj = 0; bj < 2; ++bj)
#pragma unroll
            for (int n = 0; n < 2; ++n) { const f32x4 t = *(const f32x4*)(bgate + ((mode == 2) ? colt : colw) + bj * HALF + 4 * n); bv[bj][n] = (mode == 2) ? t : (f32x4){0.f, 0.f, 0.f, 0.f}; }
#pragma unroll
        for (int ai = 0; ai < 2; ++ai)
#pragma unroll
            for (int m = 0; m < 4; ++m) { bf16* rowp = base + (size_t)(row0 + ai * HALF + m * 16) * INC + colt;
#pragma unroll
                for (int bj = 0; bj < 2; ++bj) { f32x4 v0 = acc[ai][bj][m][0] + bv[bj][0], v1 = acc[ai][bj][m][1] + bv[bj][1];
                    if (mode == 1) { const f32x2 a = gelu_pk((f32x2){v0[0], v0[1]}), b = gelu_pk((f32x2){v0[2], v0[3]}), c = gelu_pk((f32x2){v1[0], v1[1]}), d = gelu_pk((f32x2){v1[2], v1[3]});
                        v0 = (f32x4){a.x, a.y, b.x, b.y}; v1 = (f32x4){c.x, c.y, d.x, d.y}; }
                    else if (mode == 2) {
#pragma unroll
                        for (int j = 0; j < 4; ++j) { v0[j] = fast_sigmoid(v0[j]); v1[j] = fast_sigmoid(v1[j]); } }
                    u32x4 w; w.x = cvt_pk_bf16(v0[0], v0[1]); w.y = cvt_pk_bf16(v0[2], v0[3]); w.z = cvt_pk_bf16(v1[0], v1[1]); w.w = cvt_pk_bf16(v1[2], v1[3]);
                    *(u32x4*)(rowp + bj * HALF) = w; } }
    }
};
struct EpiP3 {
    static constexpr int NVM = 16;
    static constexpr bool HAS_MID = true;
    const bf16* GATE; bf16* MG;
    __device__ __forceinline__ void mid(f32x4 (&acc)[2][2][4][2], const Unit& u, int seg, int wr, int wc, int fr, int fq) const {
        int opq = 0; asm volatile("" : "+v"(opq));
        const int row0 = u.orow + wr * 64 + fr + opq, colw = wc * 32 + 8 * fq;
#pragma unroll
        for (int ai = 0; ai < 2; ++ai)
#pragma unroll
            for (int m = 0; m < 4; ++m) { const bf16* gp = GATE + (size_t)(row0 + ai * HALF + m * 16) * INC + (size_t)(seg - 1) * D + u.pn * BM + colw;
#pragma unroll
                for (int bj = 0; bj < 2; ++bj) { const u32x4 a = *(const u32x4*)(gp + bj * HALF), b = *(const u32x4*)(gp + D + bj * HALF);
                    f32x4 r0, r1;
                    r0[0] = bflo(a.x) * __builtin_amdgcn_rcpf(fmaxf(bflo(b.x), 1e-30f)); r0[1] = bfhi(a.x) * __builtin_amdgcn_rcpf(fmaxf(bfhi(b.x), 1e-30f));
                    r0[2] = bflo(a.y) * __builtin_amdgcn_rcpf(fmaxf(bflo(b.y), 1e-30f)); r0[3] = bfhi(a.y) * __builtin_amdgcn_rcpf(fmaxf(bfhi(b.y), 1e-30f));
                    r1[0] = bflo(a.z) * __builtin_amdgcn_rcpf(fmaxf(bflo(b.z), 1e-30f)); r1[1] = bfhi(a.z) * __builtin_amdgcn_rcpf(fmaxf(bfhi(b.z), 1e-30f));
                    r1[2] = bflo(a.w) * __builtin_amdgcn_rcpf(fmaxf(bflo(b.w), 1e-30f)); r1[3] = bfhi(a.w) * __builtin_amdgcn_rcpf(fmaxf(bfhi(b.w), 1e-30f));
                    acc[ai][bj][m][0] *= r0; acc[ai][bj][m][1] *= r1; }
                asm volatile("" ::: "memory"); }
    }
    __device__ __forceinline__ void operator()(const f32x4 (&acc)[2][2][4][2], const Unit& u, int wr, int wc, int fr, int fq) const {
        EPI_ROWCOL;
#pragma unroll
        for (int ai = 0; ai < 2; ++ai)
#pragma unroll
            for (int m = 0; m < 4; ++m) { const size_t r = (size_t)(row0 + ai * HALF + m * 16);
#pragma unroll
                for (int bj = 0; bj < 2; ++bj) { const int col = u.pn * BM + bj * HALF + colw;
                    const u32x4 gw = *(const u32x4*)(GATE + r * INC + 2 * D + col);
                    f32x4 r0 = acc[ai][bj][m][0], r1 = acc[ai][bj][m][1];
                    r0[0] *= bflo(gw.x); r0[1] *= bfhi(gw.x); r0[2] *= bflo(gw.y); r0[3] *= bfhi(gw.y); r1[0] *= bflo(gw.z); r1[1] *= bfhi(gw.z); r1[2] *= bflo(gw.w); r1[3] *= bfhi(gw.w);
                    u32x4 w; w.x = cvt_pk_bf16(r0[0], r0[1]); w.y = cvt_pk_bf16(r0[2], r0[3]); w.z = cvt_pk_bf16(r1[0], r1[1]); w.w = cvt_pk_bf16(r1[2], r1[3]); *(u32x4*)(MG + r * D + col) = w; }
                asm volatile("" ::: "memory"); }
    }
};
struct EpiP4 {
    static constexpr int NVM = 16;
    static constexpr bool HAS_MID = false;
    bf16* MIX;
    __device__ __forceinline__ void operator()(const f32x4 (&acc)[2][2][4][2], const Unit& u, int wr, int wc, int fr, int fq) const {
        EPI_ROWCOL;
#pragma unroll
        for (int ai = 0; ai < 2; ++ai)
#pragma unroll
            for (int m = 0; m < 4; ++m) { bf16* rowp = MIX + (size_t)(row0 + ai * HALF + m * 16) * D + u.pn * BM + colw;
#pragma unroll
                for (int bj = 0; bj < 2; ++bj) { const f32x4 v0 = acc[ai][bj][m][0], v1 = acc[ai][bj][m][1];
                    u32x4 w; w.x = cvt_pk_bf16(v0[0], v0[1]); w.y = cvt_pk_bf16(v0[2], v0[3]); w.z = cvt_pk_bf16(v1[0], v1[1]); w.w = cvt_pk_bf16(v1[2], v1[3]);
                    *(u32x4*)(rowp + bj * HALF) = w; } }
    }
};
struct EpiP6 {
    static constexpr int NVM = 8;
    static constexpr bool HAS_MID = false;
    bf16* H;
    __device__ __forceinline__ void operator()(const f32x4 (&acc)[2][2][4][2], const Unit& u, int wr, int wc, int fr, int fq) const {
        EPI_ROWCOL;
#pragma unroll
        for (int ai = 0; ai < 2; ++ai)
#pragma unroll
            for (int m = 0; m < 4; ++m) { const size_t r = (size_t)(row0 + ai * HALF + m * 16);
                float h[8];
#pragma unroll
                for (int n = 0; n < 2; ++n)
#pragma unroll
                    for (int j = 0; j < 4; ++j) { const float g = acc[ai][0][m][n][j], up = acc[ai][1][m][n][j]; h[4 * n + j] = g * fast_sigmoid(g) * up; }
                u32x4 w; w.x = cvt_pk_bf16(h[0], h[1]); w.y = cvt_pk_bf16(h[2], h[3]); w.z = cvt_pk_bf16(h[4], h[5]); w.w = cvt_pk_bf16(h[6], h[7]);
                *(u32x4*)(H + r * EH + u.pn * HALF + colw) = w; }
    }
};
struct EpiP7 {
    static constexpr int NVM = 16;
    static constexpr bool HAS_MID = false;
    unsigned char* Y;
    __device__ __forceinline__ void operator()(const f32x4 (&acc)[2][2][4][2], const Unit& u, int wr, int wc, int fr, int fq) const {
        EPI_ROWCOL;
#pragma unroll
        for (int ai = 0; ai < 2; ++ai)
#pragma unroll
            for (int m = 0; m < 4; ++m) { unsigned char* rowp = Y + (size_t)(row0 + ai * HALF + m * 16) * D + u.pn * BM + colw;
#pragma unroll
                for (int bj = 0; bj < 2; ++bj) { const f32x4 v0 = acc[ai][bj][m][0], v1 = acc[ai][bj][m][1];
                    u32x2 w; w.x = 0u; w.y = 0u;
                    w.x = __builtin_amdgcn_cvt_pk_fp8_f32(v0[0] * 8.0f, v0[1] * 8.0f, w.x, false); w.x = __builtin_amdgcn_cvt_pk_fp8_f32(v0[2] * 8.0f, v0[3] * 8.0f, w.x, true);
                    w.y = __builtin_amdgcn_cvt_pk_fp8_f32(v1[0] * 8.0f, v1[1] * 8.0f, w.y, false); w.y = __builtin_amdgcn_cvt_pk_fp8_f32(v1[2] * 8.0f, v1[3] * 8.0f, w.y, true);
                    *(u32x2*)(rowp + bj * HALF) = w; }
                asm volatile("" ::: "memory"); }
    }
};
}

#define XB_TMO      128
#define XB_XCNT(j)  (256  + 64 * (j))
#define XB_XSUB(j)  (1280 + 64 * (j))
#define XB_XGEN(j)  (2304 + 64 * (j))
#define XB_TOP      3328
#define XB_TOPGEN   3392
#define XCD_BAR_WORDS 3456
#define XB_SPIN_CAP (1u << 18)
__device__ __forceinline__ unsigned xb_ld(unsigned* p)              { return __hip_atomic_load(p, __ATOMIC_RELAXED, __HIP_MEMORY_SCOPE_AGENT); }
__device__ __forceinline__ unsigned xb_add(unsigned* p, unsigned v) { return __hip_atomic_fetch_add(p, v, __ATOMIC_RELAXED, __HIP_MEMORY_SCOPE_AGENT); }
__device__ __forceinline__ unsigned xb_xcc_id() { return (unsigned)__builtin_amdgcn_s_getreg((3 << 11) | 20) & 0xFu; }
#define XB_SPIN(cond, bar) do { unsigned _sp = 0; while (cond) { __builtin_amdgcn_s_sleep(1); \
    if ((++_sp & 255u) == 0u) { if (xb_ld(&(bar)[XB_TMO])) break; if (_sp > XB_SPIN_CAP) { atomicAdd(&(bar)[XB_TMO], 1u); break; } } } } while (0)
struct XcdBarrier { unsigned* bar; unsigned x; volatile LAS unsigned* st; };
__device__ __forceinline__ XcdBarrier xcd_barrier_post(unsigned* bar, volatile LAS unsigned* st) {
    XcdBarrier b; b.bar = bar; b.x = xb_xcc_id(); b.st = st;
    if (threadIdx.x == 0) (void)xb_add(&bar[XB_XCNT(b.x)], 1u);
    return b;
}
__device__ __forceinline__ void xcd_barrier_complete(unsigned* bar, unsigned x, unsigned& nloc, unsigned& nx) {
    const unsigned G = gridDim.x * gridDim.y * gridDim.z;
    unsigned sum, cnt, mine, sp = 0u;
    for (;;) {
        sum = 0u; cnt = 0u; mine = 0u;
#pragma unroll
        for (unsigned j = 0; j < 16; ++j) { const unsigned c = xb_ld(&bar[XB_XCNT(j)]); sum += c; cnt += (c > 0u) ? 1u : 0u; mine = (j == x) ? c : mine; }
        if (sum == G) break;
        __builtin_amdgcn_s_sleep(1);
        if ((++sp & 255u) == 0u) { if (xb_ld(&bar[XB_TMO])) break; if (sp > XB_SPIN_CAP) { atomicAdd(&bar[XB_TMO], 1u); break; } }
    }
    nloc = mine > 0u ? mine : 1u; nx = cnt > 0u ? cnt : 1u;
}
__device__ __forceinline__ void xcd_barrier(const XcdBarrier& b) {
    asm volatile("s_waitcnt vmcnt(0)" ::: "memory");
    __syncthreads();
    if (threadIdx.x == 0) {
        unsigned* bar = b.bar;
        __builtin_amdgcn_s_waitcnt(0);
        unsigned nloc = b.st[0], nx = b.st[1];
        if (nloc == 0u) { xcd_barrier_complete(bar, b.x, nloc, nx); b.st[0] = nloc; b.st[1] = nx; }
        const unsigned old = xb_add(&bar[XB_XSUB(b.x)], 1u);
        const unsigned gen = old / nloc;
        if (old + 1u == (gen + 1u) * nloc) {
            __builtin_amdgcn_fence(__ATOMIC_RELEASE, "agent");
            asm volatile("s_waitcnt vmcnt(0)" ::: "memory");
            const unsigned og = xb_add(&bar[XB_TOP], 1u);
            const unsigned tg = og / nx;
            if (og + 1u == (tg + 1u) * nx) xb_add(&bar[XB_TOPGEN], 1u);
            else XB_SPIN(xb_ld(&bar[XB_TOPGEN]) == tg, bar);
            __builtin_amdgcn_fence(__ATOMIC_ACQUIRE, "agent");
            xb_add(&bar[XB_XGEN(b.x)], 1u);
            asm volatile("s_waitcnt vmcnt(0)" ::: "memory");
        } else {
            XB_SPIN(xb_ld(&bar[XB_XGEN(b.x)]) == gen, bar);
            __builtin_amdgcn_fence(__ATOMIC_ACQUIRE, "agent");
            asm volatile("s_waitcnt vmcnt(0)" ::: "memory");
        }
    }
    __syncthreads();
}

template <int MAP>
__device__ __forceinline__ void ln_finish(float (&v)[32], const float* __restrict__ g, const float* __restrict__ b, float* xout, bf16* xbout, int lane) {
    float s = 0.f;
#pragma unroll
    for (int i = 0; i < 32; ++i) s += v[i];
    const float mean = wave_sum(s) * (1.0f / D);
    float q = 0.f;
#pragma unroll
    for (int i = 0; i < 32; ++i) { v[i] -= mean; q += v[i] * v[i]; }
    const float rstd = 1.0f / sqrtf(wave_sum(q) * (1.0f / D) + LN_EPS);
    if (MAP == 0) {
#pragma unroll
        for (int j = 0; j < 8; ++j) {
            const int c = 4 * (lane + 64 * j);
            const f32x4 gv = *(const f32x4*)(g + c), bv = *(const f32x4*)(b + c);
            f32x4 o; o.x = v[4 * j] * rstd * gv.x + bv.x; o.y = v[4 * j + 1] * rstd * gv.y + bv.y; o.z = v[4 * j + 2] * rstd * gv.z + bv.z; o.w = v[4 * j + 3] * rstd * gv.w + bv.w;
            if (xout) *(f32x4*)(xout + c) = o;
            if (xbout) { u32x2 w; w.x = pk2(o.x, o.y); w.y = pk2(o.z, o.w); *(u32x2*)(xbout + c) = w; }
        }
    } else {
#pragma unroll
        for (int j = 0; j < 4; ++j) {
            const int c = 8 * (lane + 64 * j);
            const f32x4 g0 = *(const f32x4*)(g + c), g1 = *(const f32x4*)(g + c + 4), b0 = *(const f32x4*)(b + c), b1 = *(const f32x4*)(b + c + 4);
            f32x4 o0, o1;
            o0.x = v[8 * j] * rstd * g0.x + b0.x; o0.y = v[8 * j + 1] * rstd * g0.y + b0.y; o0.z = v[8 * j + 2] * rstd * g0.z + b0.z; o0.w = v[8 * j + 3] * rstd * g0.w + b0.w;
            o1.x = v[8 * j + 4] * rstd * g1.x + b1.x; o1.y = v[8 * j + 5] * rstd * g1.y + b1.y; o1.z = v[8 * j + 6] * rstd * g1.z + b1.z; o1.w = v[8 * j + 7] * rstd * g1.w + b1.w;
            if (xout) { *(f32x4*)(xout + c) = o0; *(f32x4*)(xout + c + 4) = o1; }
            if (xbout) { u32x4 w; w.x = pk2(o0.x, o0.y); w.y = pk2(o0.z, o0.w); w.z = pk2(o1.x, o1.y); w.w = pk2(o1.z, o1.w); *(u32x4*)(xbout + c) = w; }
        }
    }
}
__device__ __forceinline__ void entry_ln_row(const Params& p, int t, int lane) {
    float* X = (float*)(p.ws + WS_X); bf16* XB = (bf16*)(p.ws + WS_XB);
    float v[32]; const float* xr = p.in[0] + (size_t)t * D;
#pragma unroll
    for (int j = 0; j < 8; ++j) { const f32x4 a = *(const f32x4*)(xr + 4 * (lane + 64 * j)); v[4 * j] = a.x; v[4 * j + 1] = a.y; v[4 * j + 2] = a.z; v[4 * j + 3] = a.w; }
    ln_finish<0>(v, p.in[1], p.in[2], nullptr, XB + (size_t)t * D, lane);
}

__device__ __forceinline__ void spatial_unit(const Params& p, int l, int unit, LAS unsigned char* lds, int tid) {
    const int nb = unit >> 2, g = unit & 3, lane = tid & 63, wid = __builtin_amdgcn_readfirstlane(tid >> 6), fr = lane & 15, fq = lane >> 4;
    LAS bf16* VT = (LAS bf16*)lds; LAS bf16* WM = (LAS bf16*)(lds + 69632);
    const bf16* PROJ = (const bf16*)(p.ws + WS_PROJ); bf16* YABC = (bf16*)(p.ws + WS_YABC);
    const float* ws = p.in[4] + ((size_t)l * 4 + g) * 128 * 128; const float* bs = p.in[5] + ((size_t)l * 4 + g) * 128;
#pragma unroll
    for (int q = 0; q < 8; ++q) { const int pc = tid + 512 * q, i = pc >> 5, j4 = (pc & 31) * 4; const f32x4 w = *(const f32x4*)(ws + i * 128 + j4);
        u32x2 o; o.x = pk2(w.x, w.y); o.y = pk2(w.z, w.w); *(LAS u32x2*)(WM + i * 136 + j4) = o; }
    {
        const int j = wid * 16 + fr; const bf16* vp = PROJ + ((size_t)nb * 128 + j) * INC + 1024 + g * 256 + fq * 8;
        float v[64];
#pragma unroll
        for (int q = 0; q < 8; ++q) { const u32x4 w = *(const u32x4*)(vp + q * 32);
            v[8 * q] = bflo(w.x); v[8 * q + 1] = bfhi(w.x); v[8 * q + 2] = bflo(w.y); v[8 * q + 3] = bfhi(w.y); v[8 * q + 4] = bflo(w.z); v[8 * q + 5] = bfhi(w.z); v[8 * q + 6] = bflo(w.w); v[8 * q + 7] = bfhi(w.w); }
        float sm = 0.f;
#pragma unroll
        for (int i = 0; i < 64; ++i) sm += v[i];
        sm += __shfl_xor(sm, 16); sm += __shfl_xor(sm, 32);
        const float mean = sm * (1.0f / 256.0f); float sq = 0.f;
#pragma unroll
        for (int i = 0; i < 64; ++i) { v[i] -= mean; sq += v[i] * v[i]; }
        sq += __shfl_xor(sq, 16); sq += __shfl_xor(sq, 32);
        const float rstd = 1.0f / sqrtf(sq * (1.0f / 256.0f) + LN_EPS);
#pragma unroll
        for (int q = 0; q < 8; ++q)
#pragma unroll
            for (int i = 0; i < 8; ++i) VT[(q * 32 + fq * 8 + i) * 136 + j] = (bf16)f2bf(v[8 * q + i] * rstd);
    }
    __syncthreads();
    f32x4 acc[2][8];
#pragma unroll
    for (int cf = 0; cf < 2; ++cf)
#pragma unroll
        for (int f = 0; f < 8; ++f) acc[cf][f] = (f32x4){0.f, 0.f, 0.f, 0.f};
#pragma unroll
    for (int ks = 0; ks < 4; ++ks) {
        bf16x8 a[2];
#pragma unroll
        for (int cf = 0; cf < 2; ++cf) a[cf] = *(const LAS bf16x8*)(VT + (wid * 32 + cf * 16 + fr) * 136 + ks * 32 + fq * 8);
#pragma unroll
        for (int f = 0; f < 8; ++f) {
            if (ks >= 2 && f < 4) continue;
            const bf16x8 b = *(const LAS bf16x8*)(WM + (f * 16 + fr) * 136 + ks * 32 + fq * 8);
#pragma unroll
            for (int cf = 0; cf < 2; ++cf) acc[cf][f] = __builtin_amdgcn_mfma_f32_16x16x32_bf16(a[cf], b, acc[cf][f], 0, 0, 0);
        }
    }
#pragma unroll
    for (int f = 0; f < 8; ++f) {
        const int i = f * 16 + fr; const size_t t = (size_t)nb * 128 + i; const float bias = bs[i];
#pragma unroll
        for (int cf = 0; cf < 2; ++cf) { const int c = g * 256 + wid * 32 + cf * 16 + 4 * fq;
            const u32x2 uw = *(const u32x2*)(PROJ + t * INC + c);
            u32x2 o; o.x = pk2(bflo(uw.x) * (acc[cf][f][0] + bias), bfhi(uw.x) * (acc[cf][f][1] + bias)); o.y = pk2(bflo(uw.y) * (acc[cf][f][2] + bias), bfhi(uw.y) * (acc[cf][f][3] + bias));
            *(u32x2*)(YABC + t * 3072 + c) = o; }
    }
    __syncthreads();
}
__device__ __forceinline__ void ld8(const bf16* ptr, float (&f)[8]) {
    const u32x4 w = *(const u32x4*)ptr;
    f[0] = bflo(w.x); f[1] = bfhi(w.x); f[2] = bflo(w.y); f[3] = bfhi(w.y); f[4] = bflo(w.z); f[5] = bfhi(w.z); f[6] = bflo(w.w); f[7] = bfhi(w.w);
}
__device__ __forceinline__ void st8(bf16* ptr, const float (&f)[8]) {
    u32x4 w; w.x = pk2(f[0], f[1]); w.y = pk2(f[2], f[3]); w.z = pk2(f[4], f[5]); w.w = pk2(f[6], f[7]); *(u32x4*)ptr = w;
}
__device__ __forceinline__ void conv_task(const Params& p, int l, int t0, int c) {
    const bf16* PROJ = (const bf16*)(p.ws + WS_PROJ); bf16* YABC = (bf16*)(p.ws + WS_YABC);
    float w0[8], w1[8], w2[8], z2[8], z1[8];
    { const float* wc = p.in[6] + (size_t)l * 3 * 1024 + c;
      const f32x4 a0 = *(const f32x4*)wc, a1 = *(const f32x4*)(wc + 4), b0 = *(const f32x4*)(wc + 1024), b1 = *(const f32x4*)(wc + 1028), c0 = *(const f32x4*)(wc + 2048), c1 = *(const f32x4*)(wc + 2052);
      w0[0] = a0.x; w0[1] = a0.y; w0[2] = a0.z; w0[3] = a0.w; w0[4] = a1.x; w0[5] = a1.y; w0[6] = a1.z; w0[7] = a1.w;
      w1[0] = b0.x; w1[1] = b0.y; w1[2] = b0.z; w1[3] = b0.w; w1[4] = b1.x; w1[5] = b1.y; w1[6] = b1.z; w1[7] = b1.w;
      w2[0] = c0.x; w2[1] = c0.y; w2[2] = c0.z; w2[3] = c0.w; w2[4] = c1.x; w2[5] = c1.y; w2[6] = c1.z; w2[7] = c1.w; }
#pragma unroll
    for (int i = 0; i < 8; ++i) { z2[i] = 0.f; z1[i] = 0.f; }
    if (t0 >= 2) { float cg[8], hh[8]; ld8(PROJ + (size_t)(t0 - 2) * INC + 3072 + c, cg); ld8(PROJ + (size_t)(t0 - 2) * INC + 4096 + c, hh);
#pragma unroll
        for (int i = 0; i < 8; ++i) z2[i] = cg[i] * hh[i];
        ld8(PROJ + (size_t)(t0 - 1) * INC + 3072 + c, cg); ld8(PROJ + (size_t)(t0 - 1) * INC + 4096 + c, hh);
#pragma unroll
        for (int i = 0; i < 8; ++i) z1[i] = cg[i] * hh[i]; }
#pragma unroll
    for (int k = 0; k < 16; ++k) { const size_t t = (size_t)(t0 + k);
        float bgv[8], cg[8], hh[8], o[8]; ld8(PROJ + t * INC + 2048 + c, bgv); ld8(PROJ + t * INC + 3072 + c, cg); ld8(PROJ + t * INC + 4096 + c, hh);
#pragma unroll
        for (int i = 0; i < 8; ++i) { const float z0 = cg[i] * hh[i]; o[i] = bgv[i] * (w0[i] * z2[i] + w1[i] * z1[i] + w2[i] * z0); z2[i] = z1[i]; z1[i] = z0; }
        st8(YABC + t * 3072 + 1024 + c, o); }
}
template <int WIN> __device__ __forceinline__ void pool_task(const Params& p, int t0, int c) {
    const bf16* PROJ = (const bf16*)(p.ws + WS_PROJ); bf16* YABC = (bf16*)(p.ws + WS_YABC);
    float ring[WIN][8], tot[8];
#pragma unroll
    for (int i = 0; i < 8; ++i) tot[i] = 0.f;
#pragma unroll
    for (int d = 1 - WIN; d < 0; ++d) {
        if (t0 > 0) { ld8(PROJ + (size_t)(t0 + d) * INC + 5120 + c, ring[(d + WIN) % WIN]);
#pragma unroll
            for (int i = 0; i < 8; ++i) tot[i] += ring[(d + WIN) % WIN][i]; }
        else {
#pragma unroll
            for (int i = 0; i < 8; ++i) ring[(d + WIN) % WIN][i] = 0.f; }
    }
#pragma unroll
    for (int k = 0; k < 16; ++k) { const int t = t0 + k;
        float cur[8], o[8]; ld8(PROJ + (size_t)t * INC + 5120 + c, cur);
        const float inv = (k + 1 < WIN && t0 == 0) ? 1.0f / (float)(k + 1) : 1.0f / (float)WIN;
#pragma unroll
        for (int i = 0; i < 8; ++i) { tot[i] += cur[i]; o[i] = tot[i] * inv - cur[i]; ring[k % WIN][i] = cur[i]; }
        st8(YABC + (size_t)t * 3072 + 2048 + c, o);
#pragma unroll
        for (int i = 0; i < 8; ++i) tot[i] -= ring[(k + 1) % WIN][i];
    }
}
__device__ __forceinline__ void convpool_task(const Params& p, int l, int task) {
    if (task < 65536) { conv_task(p, l, (task >> 7) * 16, (task & 127) * 8); return; }
    const int k = task - 65536, g = __builtin_amdgcn_readfirstlane((k >> 6) & 3), run = ((k >> 8) << 1) + ((k >> 5) & 1), c = (g * 32 + (k & 31)) * 8, t0 = run * 16;
    if (g == 0) pool_task<2>(p, t0, c); else if (g == 1) pool_task<4>(p, t0, c); else if (g == 2) pool_task<8>(p, t0, c); else pool_task<16>(p, t0, c);
}

typedef float f32x16 __attribute__((ext_vector_type(16)));
__device__ __forceinline__ void ln1_router_unit(const Params& p, int l, int unit, LAS unsigned char* lds, int tid, bool dry = false) {
    LAS float* part = (LAS float*)lds; LAS float* lg = (LAS float*)(lds + 65536); LAS float* sl = (LAS float*)(lds + 73728); LAS int* le = (LAS int*)(lds + 75776); LAS float* lw = (LAS float*)(lds + 76800);
    LAS int* cnt = (LAS int*)(lds + 77824); LAS int* base = cnt + 64;
    const int lane = tid & 63, wid = __builtin_amdgcn_readfirstlane(tid >> 6); const int t0 = unit * 32;
    const bf16* MIX = (const bf16*)(p.ws + WS_PRE); float* X = (float*)(p.ws + WS_X); bf16* XB = (bf16*)(p.ws + WS_XB);
    for (int r = 0; r < 4; ++r) {
        const int t = t0 + wid * 4 + r; float v[32]; const bf16* xr = XB + (size_t)t * D; const bf16* mr = MIX + (size_t)t * D;
#pragma unroll
        for (int j = 0; j < 8; ++j) { const int c = 4 * (lane + 64 * j); const u32x2 a = *(const u32x2*)(xr + c); const u32x2 mw = *(const u32x2*)(mr + c);
            v[4 * j] = ALPHA * bflo(a.x) + bflo(mw.x); v[4 * j + 1] = ALPHA * bfhi(a.x) + bfhi(mw.x); v[4 * j + 2] = ALPHA * bflo(a.y) + bflo(mw.y); v[4 * j + 3] = ALPHA * bfhi(a.y) + bfhi(mw.y); }
        ln_finish<0>(v, p.in[15] + (size_t)l * D, p.in[16] + (size_t)l * D, X + (size_t)t * D, XB + (size_t)t * D, lane);
    }
    if (tid < 64) cnt[tid] = 0;
    __threadfence_block();
    __syncthreads();
    {
        const int m = lane & 31, ks = lane >> 5;
        const float* xrow = X + (size_t)(t0 + m) * D + 256 * wid + 4 * ks;
        const float* wcol = p.in[17] + (size_t)l * D * NE + (size_t)(256 * wid + 4 * ks) * NE + m;
        f32x16 acc0, acc1;
#pragma unroll
        for (int r = 0; r < 16; ++r) { acc0[r] = 0.f; acc1[r] = 0.f; }
#pragma unroll 4
        for (int kb = 0; kb < 256; kb += 8) {
            const f32x4 a = *(const f32x4*)(xrow + kb);
            float b0[4], b1[4];
#pragma unroll
            for (int s = 0; s < 4; ++s) { b0[s] = wcol[(size_t)(kb + s) * NE]; b1[s] = wcol[(size_t)(kb + s) * NE + 32]; }
#pragma unroll
            for (int s = 0; s < 4; ++s) { acc0 = __builtin_amdgcn_mfma_f32_32x32x2f32(a[s], b0[s], acc0, 0, 0, 0); acc1 = __builtin_amdgcn_mfma_f32_32x32x2f32(a[s], b1[s], acc1, 0, 0, 0); }
        }
#pragma unroll
        for (int r = 0; r < 16; ++r) { const int row = (r & 3) + 8 * (r >> 2) + 4 * ks; part[(wid * 32 + row) * 64 + m] = acc0[r]; part[(wid * 32 + row) * 64 + 32 + m] = acc1[r]; }
    }
    __syncthreads();
    { f32x4 sm = *(const LAS f32x4*)(part + tid * 4);
#pragma unroll
      for (int w = 1; w < 8; ++w) sm += *(const LAS f32x4*)(part + w * 2048 + tid * 4);
      *(LAS f32x4*)(lg + tid * 4) = (f32x4){sigmoidf_(sm.x), sigmoidf_(sm.y), sigmoidf_(sm.z), sigmoidf_(sm.w)}; }
    __syncthreads();
    {
        const float rbias = p.in[18][(size_t)l * NE + lane]; const int gi = lane >> 3;
        for (int tt = 0; tt < 4; ++tt) {
            const int tok = wid * 4 + tt;
            const float sc = lg[tok * 64 + lane], sel = sc + rbias;
            float m1 = sel; m1 = fmaxf(m1, __shfl_xor(m1, 1)); m1 = fmaxf(m1, __shfl_xor(m1, 2)); m1 = fmaxf(m1, __shfl_xor(m1, 4));
            const unsigned long long eq = __ballot(sel == m1);
            const int first = __ffs((unsigned)(eq >> (gi * 8)) & 0xffu) - 1;
            float m2 = ((lane & 7) == first) ? -INFINITY : sel; m2 = fmaxf(m2, __shfl_xor(m2, 1)); m2 = fmaxf(m2, __shfl_xor(m2, 2)); m2 = fmaxf(m2, __shfl_xor(m2, 4));
            const float gscore = m1 + m2;
            int grank = 0;
#pragma unroll
            for (int g2 = 0; g2 < 8; ++g2) { const float v = __shfl(gscore, g2 * 8); grank += ((v > gscore) || (v == gscore && g2 < gi)) ? 1 : 0; }
            const bool gsel = grank < 4;
            const unsigned long long selmask = __ballot(gsel);
            sl[wid * 64 + lane] = sel;
            asm volatile("s_waitcnt lgkmcnt(0)" ::: "memory");
            int rank = 0;
#pragma unroll
            for (int e4 = 0; e4 < 16; ++e4) { const f32x4 v = *(const LAS f32x4*)(sl + wid * 64 + e4 * 4);
#pragma unroll
                for (int j = 0; j < 4; ++j) { const int e2 = e4 * 4 + j; const bool ok = (selmask >> e2) & 1ull; rank += (ok && ((v[j] > sel) || (v[j] == sel && e2 < lane))) ? 1 : 0; } }
            asm volatile("s_waitcnt lgkmcnt(0)" ::: "memory");
            const bool chosen = gsel && rank < 8;
            const float wsum = wave_sum(chosen ? sc : 0.f);
            if (chosen) { le[tok * 8 + rank] = lane; lw[tok * 8 + rank] = sc * (ROUTED_SCALE / wsum); }
        }
    }
    __syncthreads();
    if (dry) return;
    int myrank = 0, mye = 0;
    if (tid < 256) { mye = le[tid]; myrank = atomicAdd((int*)&cnt[mye], 1); }
    __syncthreads();
    if (tid < 64) { const int c = cnt[tid]; base[tid] = c ? (int)atomicAdd((unsigned*)(p.ws + WS_CTL) + CW_CNT + 64 * l + tid, (unsigned)c) : 0; }
    __syncthreads();
    if (tid < 256) {
        const int t = t0 + (tid >> 3), s = tid & 7, pos = base[mye] + myrank;
        ((int*)(p.ws + WS_TOPE))[t * 8 + s] = mye; ((int*)(p.ws + WS_TOPPOS))[t * 8 + s] = pos; ((float*)(p.ws + WS_TOPW))[t * 8 + s] = lw[tid];
        ((int*)(p.ws + WS_LIST))[((size_t)l * 64 + mye) * 8192 + pos] = t;
    }
    __syncthreads();
}

__device__ __forceinline__ void combine_ln2_row(const Params& p, int l, int t, const LAS MoeTab* tb, int lane, bool last, bool dry = false) {
    const unsigned char* Y = p.ws + WS_Y; bf16* XB = (bf16*)(p.ws + WS_XB);
    int row_l; float w_l;
    { const int s = lane & 15;
      if (s < 8) { const int e = ((const int*)(p.ws + WS_TOPE))[t * 8 + s]; row_l = tb->rb[e] + ((const int*)(p.ws + WS_TOPPOS))[t * 8 + s]; w_l = ((const float*)(p.ws + WS_TOPW))[t * 8 + s]; }
      else { row_l = tb->rb[64] + t; w_l = 1.0f; } }
    float v[32];
    const bf16* xr = XB + (size_t)t * D;
#pragma unroll
    for (int j = 0; j < 4; ++j) { float f[8]; ld8(xr + 8 * (lane + 64 * j), f);
#pragma unroll
        for (int i = 0; i < 8; ++i) v[8 * j + i] = ALPHA * f[i]; }
    int rows[9]; float ws[9];
#pragma unroll
    for (int s = 0; s < 9; ++s) { rows[s] = __builtin_amdgcn_readlane(row_l, s); ws[s] = 0.125f * __uint_as_float(__builtin_amdgcn_readlane(__float_as_uint(w_l), s)); }
#pragma unroll
    for (int j = 0; j < 4; ++j) {
        u32x2 q[9];
#pragma unroll
        for (int s = 0; s < 9; ++s) q[s] = *(const u32x2*)(Y + (size_t)rows[s] * D + 8 * (lane + 64 * j));
#pragma unroll
        for (int s = 0; s < 9; ++s) { const float w = ws[s];
            const f32x2 a = __builtin_amdgcn_cvt_pk_f32_fp8(q[s].x, false), b = __builtin_amdgcn_cvt_pk_f32_fp8(q[s].x, true), c = __builtin_amdgcn_cvt_pk_f32_fp8(q[s].y, false), d = __builtin_amdgcn_cvt_pk_f32_fp8(q[s].y, true);
            v[8 * j] += w * a.x; v[8 * j + 1] += w * a.y; v[8 * j + 2] += w * b.x; v[8 * j + 3] += w * b.y; v[8 * j + 4] += w * c.x; v[8 * j + 5] += w * c.y; v[8 * j + 6] += w * d.x; v[8 * j + 7] += w * d.y; }
    }
    float* xo = dry ? (float*)(p.ws + WS_PRE) + (size_t)t * D : (last ? p.out + (size_t)t * D : nullptr);
    ln_finish<1>(v, p.in[25] + (size_t)l * D, p.in[26] + (size_t)l * D, xo, (last || dry) ? nullptr : XB + (size_t)t * D, lane);
}

struct TrJob { const float* src; bf16* dst; int ldsrc, lddst; };
__device__ __forceinline__ void tr_load(const TrJob& j, f32x4 (&v)[16], int lane) {
    const int kr = lane >> 4, n4 = (lane & 15) * 4;
#pragma unroll
    for (int q = 0; q < 16; ++q) v[q] = __builtin_nontemporal_load((const f32x4*)(j.src + (size_t)(4 * q + kr) * j.ldsrc + n4));
}
__device__ __forceinline__ void tr_store(const TrJob& j, const f32x4 (&v)[16], LAS float* scr, int lane) {
    const int kr = lane >> 4, n4 = (lane & 15) * 4;
#pragma unroll
    for (int q = 0; q < 16; ++q) { const int k = 4 * q + kr; *(LAS f32x4*)(scr + k * 64 + (n4 ^ (8 * (k >> 3)))) = v[q]; }
    asm volatile("s_waitcnt lgkmcnt(0)" ::: "memory");
    const int kg = lane >> 3, r = lane & 7;
#pragma unroll
    for (int s = 0; s < 8; ++s) {
        const int n = 8 * s + r; const LAS float* sp = scr + (8 * kg) * 64 + (n ^ (8 * kg));
        u32x4 w; w.x = cvt_pk_bf16(sp[0], sp[64]); w.y = cvt_pk_bf16(sp[128], sp[192]); w.z = cvt_pk_bf16(sp[256], sp[320]); w.w = cvt_pk_bf16(sp[384], sp[448]);
        __builtin_nontemporal_store(w, (u32x4*)(j.dst + (size_t)n * j.lddst + 8 * kg));
    }
    asm volatile("s_waitcnt lgkmcnt(0)" ::: "memory");
}
constexpr int I_IN = 32 * 96, I_PA = 16 * 32, I_O = 32 * 32, I_EX = 65 * 256, I_LAYER = 2 * I_IN + 2 * I_PA + I_O + 3 * I_EX;
__device__ __forceinline__ TrJob prologue_job(const Params& p, int it) {
    const int l = it / I_LAYER; int r = it % I_LAYER; TrJob j;
    unsigned char* wl = p.ws + WS_W + (size_t)l * WL_BYTES;
    if (r < 2 * I_IN) {
        const int which = r / I_IN; r %= I_IN; const int kb = r / 96, nb = r % 96;
        j.src = p.in[which ? 9 : 3] + (size_t)l * D * INC + (size_t)(kb * 64) * INC + nb * 64; j.ldsrc = INC;
        j.dst = (bf16*)(wl + WL_IG) + (size_t)(which * INC + nb * 64) * D + kb * 64; j.lddst = D; return j; }
    r -= 2 * I_IN;
    if (r < 2 * I_PA) {
        const int which = r / I_PA; r %= I_PA; const int kb = r / 32, nb = r % 32;
        j.src = p.in[11 + which] + (size_t)l * 1024 * D + (size_t)(kb * 64) * D + nb * 64; j.ldsrc = D;
        j.dst = (bf16*)(wl + WL_ABC) + (size_t)(nb * 64) * 3072 + which * 1024 + kb * 64; j.lddst = 3072; return j; }
    r -= 2 * I_PA;
    if (r < I_O) {
        const int kb = r / 32, nb = r % 32;
        j.src = p.in[14] + (size_t)l * D * D + (size_t)(kb * 64) * D + nb * 64; j.ldsrc = D;
        j.dst = (bf16*)(wl + WL_O) + (size_t)(nb * 64) * D + kb * 64; j.lddst = D; return j; }
    r -= I_O;
    const int kind = r / I_EX; r %= I_EX; const int e = r >> 8; r &= 255;
    if (kind < 2) {
        const int kb = r >> 3, nb = r & 7, n0 = nb * 64;
        j.src = (e < 64 ? p.in[19 + kind] + ((size_t)l * 64 + e) * D * EH : p.in[22 + kind] + (size_t)l * D * EH) + (size_t)(kb * 64) * EH + n0; j.ldsrc = EH;
        const int drow = (n0 >> 7) * 256 + kind * 128 + (n0 & 127);
        j.dst = (bf16*)(wl + WL_GU) + (size_t)e * 1024 * D + (size_t)drow * D + kb * 64; j.lddst = D;
    } else {
        const int kb = r >> 5, nb = r & 31;
        j.src = (e < 64 ? p.in[21] + ((size_t)l * 64 + e) * EH * D : p.in[24] + (size_t)l * EH * D) + (size_t)(kb * 64) * D + nb * 64; j.ldsrc = D;
        j.dst = (bf16*)(wl + WL_D) + (size_t)e * D * EH + (size_t)(nb * 64) * EH + kb * 64; j.lddst = EH;
    }
    return j;
}
constexpr int I_DENSE = 2 * I_IN + 2 * I_PA + I_O;
#ifndef NCONV
#define NCONV 46592
#endif
constexpr int I_P0 = I_DENSE + (3 * I_EX - NCONV);
template <int MODE> __device__ __forceinline__ int tr_map(int k, int l) {
    if (MODE == 0) return k;
    if (MODE == 1) { const int ll = k / I_P0, r = k % I_P0; return ll * I_LAYER + (r < I_DENSE ? r : NCONV + r); }
    return l * I_LAYER + I_DENSE + k;
}
template <int MODE> __device__ __forceinline__ void prologue_transposes(const Params& p, int l, int gw, int NGW, LAS float* scr, int lane) {
    constexpr int NIT = MODE == 0 ? NL * I_LAYER : (MODE == 1 ? NL * I_P0 : NCONV);
    int it = gw; if (it >= NIT) return;
    f32x4 va[16], vb[16];
    TrJob ja = prologue_job(p, tr_map<MODE>(it, l)); tr_load(ja, va, lane);
    for (;;) {
        const int itn = it + NGW; const bool more = itn < NIT;
        TrJob jb = ja; if (more) { jb = prologue_job(p, tr_map<MODE>(itn, l)); tr_load(jb, vb, lane); }
        tr_store(ja, va, scr, lane);
        if (!more) break;
#pragma unroll
        for (int q = 0; q < 16; ++q) va[q] = vb[q];
        ja = jb; it = itn;
    }
}
__device__ __forceinline__ void wcprime_tile(const Params& p, int tile, LAS bf16* sA, LAS bf16* sB, int tid) {
    const int l = tile >> 8, g = (tile >> 6) & 3, tm = (tile >> 5) & 1, tn = tile & 31;
    const int lane = tid & 63, wid = tid >> 6, wm = wid >> 1, wn = wid & 1, fr = lane & 15, fq = lane >> 4;
    const float* Ap = p.in[7] + ((size_t)l * 4 + g) * 256 * 256; const float* sc = p.in[8] + (size_t)l * 1024 + g * 256;
    const float* Wp = p.in[13] + (size_t)l * 1024 * D + (size_t)(g * 256) * D;
    bf16* dst = (bf16*)(p.ws + WS_W + (size_t)l * WL_BYTES + WL_ABC) + 2048;
    f32x4 acc[2][2];
#pragma unroll
    for (int a = 0; a < 2; ++a)
#pragma unroll
        for (int b = 0; b < 2; ++b) acc[a][b] = (f32x4){0.f, 0.f, 0.f, 0.f};
    const int ar = tid >> 2, akseg = (tid & 3) * 8, wk = tid >> 4, wns = (tid & 15) * 4;
    for (int k0 = 0; k0 < 256; k0 += 32) {
        const float* ap = Ap + (size_t)(tm * 128 + ar) * 256 + k0 + akseg;
        const f32x4 x0 = *(const f32x4*)ap, x1 = *(const f32x4*)(ap + 4), s0 = *(const f32x4*)(sc + k0 + akseg), s1 = *(const f32x4*)(sc + k0 + akseg + 4);
        u32x4 av; av.x = pk2(x0.x * s0.x, x0.y * s0.y); av.y = pk2(x0.z * s0.z, x0.w * s0.w); av.z = pk2(x1.x * s1.x, x1.y * s1.y); av.w = pk2(x1.z * s1.z, x1.w * s1.w);
        const f32x4 wv = *(const f32x4*)(Wp + (size_t)(k0 + wk) * D + tn * 64 + wns);
        *(LAS u32x4*)(sA + ar * 40 + akseg) = av;
        sB[(wns + 0) * 40 + wk] = (bf16)f2bf(wv.x); sB[(wns + 1) * 40 + wk] = (bf16)f2bf(wv.y); sB[(wns + 2) * 40 + wk] = (bf16)f2bf(wv.z); sB[(wns + 3) * 40 + wk] = (bf16)f2bf(wv.w);
        __syncthreads();
#pragma unroll
        for (int mi = 0; mi < 2; ++mi) {
            const bf16x8 a = *(const LAS bf16x8*)(sA + (wm * 32 + mi * 16 + fr) * 40 + fq * 8);
#pragma unroll
            for (int ni = 0; ni < 2; ++ni) {
                const bf16x8 b = *(const LAS bf16x8*)(sB + (wn * 32 + ni * 16 + fr) * 40 + fq * 8);
                acc[mi][ni] = __builtin_amdgcn_mfma_f32_16x16x32_bf16(a, b, acc[mi][ni], 0, 0, 0);
            }
        }
        __syncthreads();
    }
#pragma unroll
    for (int mi = 0; mi < 2; ++mi)
#pragma unroll
        for (int ni = 0; ni < 2; ++ni)
#pragma unroll
            for (int j = 0; j < 4; ++j) { const int c = tm * 128 + wm * 32 + mi * 16 + fq * 4 + j, n = tn * 64 + wn * 32 + ni * 16 + fr;
                dst[(size_t)n * 3072 + g * 256 + c] = (bf16)f2bf(acc[mi][ni][j]); }
}

__global__ void __launch_bounds__(512, 2) fwd(Params p) {
    extern __shared__ __attribute__((aligned(16))) unsigned char lds_raw[];
    LAS unsigned char* lds = (LAS unsigned char*)lds_raw;
    LAS MoeTab* tb = (LAS MoeTab*)(lds + LDSCTL_OFF);
    volatile LAS unsigned* MISC = (volatile LAS unsigned*)(lds + MISC_OFF);
    const int wave0 = __builtin_amdgcn_readfirstlane((int)threadIdx.x >> 6);
    const int G = gridDim.x, bx = blockIdx.x; const int vcu = (G % 8 == 0) ? (bx % 8) * (G / 8) + bx / 8 : bx;
    const bool split = (G == 256 && p.ph_hi - p.ph_lo == NPHASES);
    constexpr int GEMM_WGS = 176;
    if (threadIdx.x < 32) MISC[threadIdx.x] = 0u;
    __syncthreads();
    unsigned* ctl = (unsigned*)(p.ws + WS_CTL);
    XcdBarrier bar; bar.bar = ctl + CW_BAR; bar.x = 0; bar.st = nullptr;
    const int lo = p.ph_lo, hi = p.ph_hi;
    if (hi - lo > 1) bar = xcd_barrier_post(ctl + CW_BAR, MISC + 8);
#define IN(k) (lo <= (k) && (k) < hi)
#define SEAM(k) do { if (IN(k) && IN((k) + 1)) xcd_barrier(bar); } while (0)

    if (IN(0)) for (int rep = 0; rep < REPS(0); ++rep) {
        const int tid = ltid(wave0), lane = tid & 63, wave = __builtin_amdgcn_readfirstlane(tid >> 6);
        LAS float* scr = (LAS float*)(lds + wave * 16384);
        const int gw = vcu * 8 + wave, NGW = G * 8;
        if (split && CONVMODE == 0) prologue_transposes<1>(p, 0, gw, NGW, scr, lane); else prologue_transposes<0>(p, 0, gw, NGW, scr, lane);
        for (int t = gw; t < T; t += NGW) entry_ln_row(p, t, lane);
        __syncthreads();
        for (int tile = bx; tile < 512; tile += G) wcprime_tile(p, tile, (LAS bf16*)lds, (LAS bf16*)(lds + 16384), tid);
    }
    SEAM(0);

    for (int l = 0; l < NL; ++l) {
        const int pb = 1 + 8 * l;
        const char* wl = (const char*)(p.ws + WS_W + (size_t)l * WL_BYTES);
        if (IN(pb + 0)) for (int rep = 0; rep < REPS(1); ++rep) {
            if (!split || bx < GEMM_WGS) {
                pg8::DenseSched S; S.A = (const char*)(p.ws + WS_XB); S.B = wl + WL_IG; S.atile = (size_t)256 * D * 2; S.btile = (size_t)256 * D * 2; S.nM = 32; S.nN = 48; S.G = split ? GEMM_WGS : G; S.c = bx;
                pg8::EpiP1 E{(bf16*)(p.ws + WS_PROJ), (bf16*)(p.ws + WS_GATE), p.in[10] + (size_t)l * INC};
                pg8::gemm_phase<pg8::EpiP1, pg8::DenseSched, false>(lds, D, D, D, S, E, wave0, STAGGER(STAG1));
            } else {
                const int tid = ltid(wave0), lane = tid & 63, wave = __builtin_amdgcn_readfirstlane(tid >> 6);
                if (CONVMODE != 2) prologue_transposes<2>(p, l, (bx - GEMM_WGS) * 8 + wave, (G - GEMM_WGS) * 8, (LAS float*)(lds + wave * 16384), lane);
            }
        }
        SEAM(pb + 0);
        if (IN(pb + 1)) for (int rep = 0; rep < REPS(2); ++rep) {
            const int tid = ltid(wave0);
            for (int u = bx; u < 256; u += G) spatial_unit(p, l, u, lds, tid);
            for (int it = bx * 512 + tid; it < 131072; it += G * 512) convpool_task(p, l, it);
        }
        SEAM(pb + 1);
        if (IN(pb + 2)) for (int rep = 0; rep < REPS(3); ++rep) {
            pg8::DenseSched S; S.A = (const char*)(p.ws + WS_YABC); S.B = wl + WL_ABC; S.atile = (size_t)256 * 3072 * 2; S.btile = (size_t)256 * 3072 * 2; S.nM = 32; S.nN = 8; S.G = G; S.c = bx;
            pg8::EpiP3 E{(const bf16*)(p.ws + WS_GATE), (bf16*)(p.ws + WS_MERGED)};
            pg8::gemm_phase<pg8::EpiP3, pg8::DenseSched, false>(lds, 3072, 3072, 3072, S, E, wave0, STAGGER(STAG3));
        }
        SEAM(pb + 2);
        if (IN(pb + 3)) for (int rep = 0; rep < REPS(4); ++rep) {
            pg8::DenseSched S; S.A = (const char*)(p.ws + WS_MERGED); S.B = wl + WL_O; S.atile = (size_t)256 * D * 2; S.btile = (size_t)256 * D * 2; S.nM = 32; S.nN = 8; S.G = G; S.c = bx;
            pg8::EpiP4 E{(bf16*)(p.ws + WS_PRE)};
            pg8::gemm_phase<pg8::EpiP4, pg8::DenseSched, false>(lds, D, D, D, S, E, wave0);
        }
        SEAM(pb + 3);
        if (IN(pb + 4)) {
            const int tid = ltid(wave0);
            for (int rep = 0; rep < REPS(5); ++rep) for (int u = bx; u < T / 32; u += G) ln1_router_unit(p, l, u, lds, tid, rep + 1 < REPS(5));
        }
        SEAM(pb + 4);
        if (IN(pb + 5)) for (int rep = 0; rep < REPS(6); ++rep) {
            moe_tables(p, l, tb, ltid(wave0));
            pg8::MoeSched<4, true> S; S.tb = tb; S.A = (const char*)(p.ws + WS_XB); S.B = wl + WL_GU; S.bexp = (size_t)1024 * D * 2; S.btile = (size_t)256 * D * 2;
            S.list = (const int*)(p.ws + WS_LIST) + (size_t)l * 64 * 8192; S.G = G; S.vcu = vcu; S.rows = (const LAS int*)(lds + 131072);
            S.preload_rows((LAS int*)(lds + 131072), ltid(wave0));
            pg8::EpiP6 E{(bf16*)(p.ws + WS_H)};
            pg8::gemm_phase<pg8::EpiP6, pg8::MoeSched<4, true>, true>(lds, D, D, D, S, E, wave0, STAGGER(STAG6));
        }
        SEAM(pb + 5);
        if (IN(pb + 6)) for (int rep = 0; rep < REPS(7); ++rep) {
            if (lo == pb + 6) moe_tables(p, l, tb, ltid(wave0));
            pg8::MoeSched<8, false> S; S.tb = tb; S.A = (const char*)(p.ws + WS_H); S.B = wl + WL_D; S.bexp = (size_t)D * EH * 2; S.btile = (size_t)256 * EH * 2;
            S.list = nullptr; S.G = G; S.vcu = vcu; S.rows = nullptr;
            pg8::EpiP7 E{p.ws + WS_Y};
            pg8::gemm_phase<pg8::EpiP7, pg8::MoeSched<8, false>, false>(lds, EH, EH, EH, S, E, wave0, STAGGER(STAG7));
        }
        SEAM(pb + 6);
        if (IN(pb + 7)) {
            const int tid = ltid(wave0), lane = tid & 63, wave = __builtin_amdgcn_readfirstlane(tid >> 6);
            if (lo == pb + 7) moe_tables(p, l, tb, tid);
            const int gw = bx * 8 + wave, NGW = G * 8;
            for (int rep = 0; rep < REPS(8); ++rep)
#pragma unroll 1
            for (int t = gw; t < T; t += NGW) combine_ln2_row(p, l, t, tb, lane, l == NL - 1, rep + 1 < REPS(8));
        }
        SEAM(pb + 7);
    }
#undef IN
#undef SEAM
}

extern "C" void kernel_launch(void* const* d_in, const int* in_sizes, int n_in, void* d_out, int out_size, void* d_ws, size_t ws_size, hipStream_t stream) {
    static int grid = 0;
    if (grid == 0) {
        if (n_in != 27 || out_size != T * D || ws_size < WS_END) { fprintf(stderr, "kernel_launch: unexpected shapes (n_in %d out %d ws %zu, need %zu)\n", n_in, out_size, ws_size, (size_t)WS_END); grid = -1; return; }
        int dev = 0, cus = 0, per_cu = 0;
        if (hipGetDevice(&dev) != hipSuccess || hipDeviceGetAttribute(&cus, hipDeviceAttributeMultiprocessorCount, dev) != hipSuccess) { fprintf(stderr, "kernel_launch: device query failed\n"); grid = -1; return; }
        if (hipFuncSetAttribute((const void*)fwd, hipFuncAttributeMaxDynamicSharedMemorySize, LDS_BYTES) != hipSuccess) { fprintf(stderr, "kernel_launch: hipFuncSetAttribute failed\n"); grid = -1; return; }
        if (hipOccupancyMaxActiveBlocksPerMultiprocessor(&per_cu, (const void*)fwd, 512, LDS_BYTES) != hipSuccess || per_cu < 1) fprintf(stderr, "kernel_launch: note: occupancy query reports %d workgroups per CU\n", per_cu);
        (void)hipGetLastError();
        grid = cus;
    }
    if (grid < 0) return;
    if (hipMemsetAsync((char*)d_ws + WS_CTL, 0, 1 * MiB, stream) != hipSuccess) { fprintf(stderr, "kernel_launch: memset failed\n"); return; }
    Params p{};
    for (int i = 0; i < 27; ++i) p.in[i] = (const float*)d_in[i];
    p.out = (float*)d_out; p.ws = (unsigned char*)d_ws;
#if MK_N_LAUNCHES == 1
    p.ph_lo = 0; p.ph_hi = NPHASES;
    hipLaunchKernelGGL(fwd, dim3(grid), dim3(512), LDS_BYTES, stream, p);
#else
    for (int ph = 0; ph < NPHASES; ++ph) { p.ph_lo = ph; p.ph_hi = ph + 1; hipLaunchKernelGGL(fwd, dim3(grid), dim3(512), LDS_BYTES, stream, p); }
#endif
    const hipError_t le = hipPeekAtLastError();
    if (le != hipSuccess) fprintf(stderr, "kernel_launch: launch failed: %s\n", hipGetErrorName(le));
}
```

```cpp
#include <hip/hip_runtime.h>
#include <cstdio>
#include <cstdint>

#ifndef MK_N_LAUNCHES
#define MK_N_LAUNCHES 1
#endif

#ifndef REP_MASK
#define REP_MASK 0
#endif
#define REPS(k) (1 + ((REP_MASK >> (k)) & 1))
#define LAS __attribute__((address_space(3)))
typedef unsigned short bf16;
typedef short bf16x8 __attribute__((ext_vector_type(8)));
typedef float f32x4 __attribute__((ext_vector_type(4)));
typedef float f32x2 __attribute__((ext_vector_type(2)));
typedef unsigned u32x4 __attribute__((ext_vector_type(4)));
typedef unsigned u32x2 __attribute__((ext_vector_type(2)));
typedef int i32x4 __attribute__((ext_vector_type(4)));
typedef int i32x8 __attribute__((ext_vector_type(8)));

constexpr int T = 8192, D = 2048, NL = 2, INC = 6144, NE = 64, EH = 512;
constexpr float ALPHA = 1.41421356237309515f;
constexpr float LN_EPS = 1e-5f;
constexpr float ROUTED_SCALE = 2.5f;
constexpr int NPHASES = 1 + 8 * NL;

constexpr size_t MiB = 1ull << 20;
constexpr size_t WS_CTL = 0;
constexpr size_t WS_TOPE = 1 * MiB, WS_TOPPOS = WS_TOPE + 256 * 1024, WS_TOPW = WS_TOPPOS + 256 * 1024;
constexpr size_t WS_LIST = 2 * MiB;
constexpr size_t WS_WR = 6 * MiB;
constexpr size_t WS_X = 8 * MiB;
constexpr size_t WS_XB = 72 * MiB;
constexpr size_t WS_PROJ = 104 * MiB;
constexpr size_t WS_GATE = 200 * MiB;
constexpr size_t WS_YABC = 296 * MiB;
constexpr size_t WS_MERGED = 360 * MiB;
constexpr size_t WS_X8 = 392 * MiB;
constexpr size_t WS_X8IN = 408 * MiB;
constexpr size_t WS_XI8 = 424 * MiB;
constexpr size_t WS_SX = 440 * MiB;
constexpr size_t WS_SW = 441 * MiB;
constexpr size_t WS_PRE = 456 * MiB;
constexpr size_t WS_H = 520 * MiB;
constexpr size_t WS_Y = 608 * MiB;
constexpr size_t WS_W = 960 * MiB;
constexpr int HROWS = 90112;
constexpr size_t WL_IG = 0;
constexpr size_t WL_ABC = 48 * MiB;
constexpr size_t WL_O = 60 * MiB;
constexpr size_t WL_GU = 68 * MiB;
constexpr size_t WL_D = 328 * MiB;
constexpr size_t WL_BYTES = 458 * MiB;
constexpr size_t WS_END = WS_W + 2 * WL_BYTES;
constexpr int CW_CNT = 1024;
constexpr int CW_BAR = 4096;
constexpr int CW_WCNT = 2048;
constexpr int CW_CMAX = 16384;
constexpr int LDS_BYTES = 147456;
constexpr int LDSCTL_OFF = 143360;
constexpr int MISC_OFF = LDSCTL_OFF + 2048;

struct Params { const float* in[27]; float* out; unsigned char* ws; int ph_lo, ph_hi; };

__device__ __forceinline__ float bf2f(unsigned b) { return __uint_as_float(b << 16); }
__device__ __forceinline__ float bflo(unsigned w) { return __uint_as_float(w << 16); }
__device__ __forceinline__ float bfhi(unsigned w) { return __uint_as_float(w & 0xffff0000u); }
__device__ __forceinline__ unsigned f2bf(float f) { unsigned u = __float_as_uint(f); return (u + 0x7fffu + ((u >> 16) & 1u)) >> 16; }
__device__ __forceinline__ unsigned cvt_pk_bf16(float lo, float hi) { unsigned r; asm volatile("v_cvt_pk_bf16_f32 %0, %1, %2" : "=v"(r) : "v"(lo), "v"(hi)); return r; }
__device__ __forceinline__ unsigned pk2(float lo, float hi) { return f2bf(lo) | (f2bf(hi) << 16); }
__device__ __forceinline__ unsigned pk4_i8(float a, float b, float c, float d, float m) {
    const int q0 = (int)__builtin_rintf(a * m), q1 = (int)__builtin_rintf(b * m), q2 = (int)__builtin_rintf(c * m), q3 = (int)__builtin_rintf(d * m);
    return (unsigned)(q0 & 255) | ((unsigned)(q1 & 255) << 8) | ((unsigned)(q2 & 255) << 16) | ((unsigned)q3 << 24); }
__device__ __forceinline__ float clamp8(float v) { return __builtin_amdgcn_fmed3f(v, -448.0f, 448.0f); }
__device__ __forceinline__ unsigned pk4_fp8(float a, float b, float c, float d) { unsigned w = 0u; w = __builtin_amdgcn_cvt_pk_fp8_f32(clamp8(a), clamp8(b), w, false); w = __builtin_amdgcn_cvt_pk_fp8_f32(clamp8(c), clamp8(d), w, true); return w; }
__device__ __forceinline__ float shx(float v, int mask, int lane) { return __int_as_float(__builtin_amdgcn_ds_bpermute((lane ^ mask) << 2, __float_as_int(v))); }
__device__ __forceinline__ float shl(float v, int src) { return __int_as_float(__builtin_amdgcn_ds_bpermute(src << 2, __float_as_int(v))); }
__device__ __forceinline__ float wave_sum(float v, int lane) {
#pragma unroll
    for (int o = 1; o < 64; o <<= 1) v += shx(v, o, lane);
    return v;
}
__device__ __forceinline__ int ltid(int wave0) { int t; asm volatile("v_mbcnt_lo_u32_b32 %0, -1, 0\n\tv_mbcnt_hi_u32_b32 %0, -1, %0" : "=v"(t)); return (wave0 << 6) | t; }
__device__ __forceinline__ float sigmoidf_(float v) { return 1.0f / (1.0f + __expf(-v)); }
__device__ __forceinline__ float fast_sigmoid(float v) { return __builtin_amdgcn_rcpf(1.0f + __builtin_amdgcn_exp2f(v * -1.44269504089f)); }
__device__ __forceinline__ f32x2 gelu_pk(f32x2 v) {
    const f32x2 av = __builtin_elementwise_abs(v), d = av * 0.2316418882f + 1.0f;
    f32x2 t; t.x = __builtin_amdgcn_rcpf(d.x); t.y = __builtin_amdgcn_rcpf(d.y);
    f32x2 q = t * 0.5307027145f + (-0.7265760135f); q = q * t + 0.7107068705f; q = q * t + (-0.142248368f); q = q * t + 0.127414796f; q = q * t;
    const f32x2 s = (v * v) * (-0.72134752044f);
    f32x2 e; e.x = __builtin_amdgcn_exp2f(s.x); e.y = __builtin_amdgcn_exp2f(s.y);
    const f32x2 m = v * (q * e), r = v - m;
    f32x2 o; o.x = v.x < 0.f ? m.x : r.x; o.y = v.y < 0.f ? m.y : r.y; return o;
}

struct MoeTab { int cnt[65]; int rb[66]; int tq[66]; int pad[3]; unsigned char tile_e[384]; };
__device__ __forceinline__ void moe_tables(const Params& p, int l, LAS MoeTab* tb, int tid) {
    __syncthreads();
    if (tid < 65) tb->cnt[tid] = (tid < 64) ? (int)__hip_atomic_load((unsigned*)(p.ws + WS_CTL) + CW_CNT + 64 * l + tid, __ATOMIC_RELAXED, __HIP_MEMORY_SCOPE_AGENT) : T;
    __syncthreads();
    if (tid == 0) { int rb = 0, tq = 0;
        for (int e = 0; e < 65; ++e) { const int n = tb->cnt[e]; tb->rb[e] = rb; tb->tq[e] = tq; rb += ((n + 255) >> 8) << 8; tq += (n + 255) >> 8; }
        tb->rb[65] = rb; tb->tq[65] = tq; }
    __syncthreads();
    if (tid < 65) { const int a = tb->tq[tid], b = tb->tq[tid + 1]; for (int k = a; k < b; ++k) tb->tile_e[k] = (unsigned char)tid; }
    __syncthreads();
}

#ifndef CONVMODE
#define CONVMODE 0
#endif
#ifndef STAG1
#define STAG1 0
#define STAG3 0
#define STAG6 0
#define STAG7 0
#endif
#define STAGGER(step) ((unsigned)(((bx * 7) & 15) * (step)))
#ifndef PG8_ALIGN
#define PG8_ALIGN true
#endif
namespace pg8 {
constexpr bool ALIGN_EPI = PG8_ALIGN;
constexpr int BM = 256, BK = 64, HALF = 128, HTB = HALF * BK * 2, STAGE_BYTES = 8 * HTB, NXCD = 8, WGM = 8;
__device__ __forceinline__ int lds_byte(int r, int c) { const int st = (r >> 4) * 2 + (c >> 5), rr = r & 15, cc = c & 31, ob = rr * 64 + cc * 2; return st * 1024 + (ob ^ (((ob >> 9) & 1) << 5)); }
__device__ __forceinline__ void stage_rc(int b, int& R, int& C) { const int st = b / 1024, sb = b % 1024, swz = sb ^ (((sb >> 9) & 1) << 5); R = (st >> 1) * 16 + swz / 64; C = (st & 1) * 32 + (swz % 64) / 2; }
__device__ __forceinline__ int perm32(int rho) { const int n = rho >> 4, i = rho & 15; return 8 * (i >> 2) + 4 * n + (i & 3); }

struct Unit { const char* A; const char* B; int orow, pn, seg, e, m0; };

__device__ __forceinline__ void tile_of(int L, int nM, int nN, int& pm, int& pn) {
    const int nwg = nM * nN; int wgid = L; { const int q = nwg / NXCD, r = nwg % NXCD, xcd = wgid % NXCD, off = wgid / NXCD; wgid = (xcd < r ? xcd * (q + 1) : r * (q + 1) + (xcd - r) * q) + off; }
    const int nig = WGM * nN, gid = wgid / nig, fm = gid * WGM, gsz = (nM - fm) < WGM ? (nM - fm) : WGM;
    pm = fm + ((wgid % nig) % gsz); pn = (wgid % nig) / gsz;
}
struct DenseSched {
    const char* A; const char* B; size_t atile, btile; int nM, nN, G, c;
    __device__ __forceinline__ bool next(int i, Unit& u) const {
        const int L = i * G + c; if (L >= nM * nN) return false;
        int pm, pn; tile_of(L, nM, nN, pm, pn);
        u.A = A + (size_t)pm * atile; u.B = B + (size_t)pn * btile; u.orow = pm * BM; u.pn = pn; u.seg = 0; u.e = 0; u.m0 = 0; return true; }
    __device__ __forceinline__ int row(const Unit&, int) const { return 0; }
};
struct ProjSched {
    const char* A; const char* B; int G, c;
    __device__ __forceinline__ bool next(int i, Unit& u) const {
        const int L = (i / 3) * G + c; if (L >= 32 * 8) return false;
        int pm, pn; tile_of(L, 32, 8, pm, pn); const int seg = i % 3;
        u.A = A + ((size_t)pm * BM * 3072 + (size_t)seg * 1024) * 2; u.B = B + ((size_t)seg * 2048 * 1024 + (size_t)pn * BM * 1024) * 2; u.orow = pm * BM; u.pn = pn; u.seg = seg; u.e = 0; u.m0 = 0; return true; }
    __device__ __forceinline__ int row(const Unit&, int) const { return 0; }
};
struct GateSched {
    const char* A; const char* B; int G, c;
    __device__ __forceinline__ bool next(int i, Unit& u) const {
        const int L = (i / 3) * G + c; if (L >= 32 * 8) return false;
        int pm, pn; tile_of(L, 32, 8, pm, pn); const int gp = (i % 3) * 8 + pn;
        u.A = A + (size_t)pm * BM * D; u.B = B + (size_t)(INC + gp * BM) * 64; u.orow = pm * BM; u.pn = 24 + gp; u.seg = 0; u.e = 0; u.m0 = 0; return true; }
    __device__ __forceinline__ int row(const Unit&, int) const { return 0; }
};
template <int NT, bool GATH> struct MoeSched {
    const LAS MoeTab* tb; const char* A; const char* B; size_t bexp, btile, arow; const int* list; const LAS int* rows; int G, vcu;
    __device__ __forceinline__ bool next(int i, Unit& u) const {
        const int L = i * G + vcu; if (L >= tb->tq[65] * NT) return false;
        const int mt = L / NT, pn = L % NT; const int e = tb->tile_e[mt];
        const int m0 = (mt - tb->tq[e]) * BM;
        u.e = e; u.m0 = m0; u.orow = tb->rb[e] + m0; u.pn = pn; u.seg = i;
        u.B = B + (size_t)e * bexp + (size_t)pn * btile;
        u.A = GATH ? A : A + (size_t)u.orow * arow; return true; }
    __device__ __forceinline__ int row_global(const Unit& u, int r) const { const int idx = u.m0 + r; if (u.e == 64) return idx; return idx < tb->cnt[u.e] ? list[u.e * 8192 + idx] : 0; }
    __device__ __forceinline__ int row(const Unit& u, int r) const { return rows[u.seg * 256 + r]; }
    __device__ __forceinline__ void preload_rows(LAS int* dst, int tid) const {
        int v[8]; bool ok[8];
#pragma unroll
        for (int i = 0; i < 8; ++i) { Unit u; ok[i] = next(i, u); v[i] = (ok[i] && tid < 256) ? row_global(u, tid) : 0; }
#pragma unroll
        for (int i = 0; i < 8; ++i) if (ok[i] && tid < 256) dst[i * 256 + tid] = v[i];
        __syncthreads();
    }
};

template <class Epi, class Sched, bool GATHER, int F8 = 0>
__device__ __forceinline__ void gemm_phase(LAS unsigned char* lds, const int K, const int lda, const int ldb, const Sched& S, const Epi& E, const int wave0, const unsigned stagger_ticks = 0u, const size_t kstepB_arg = 0, const int nB64 = 0) {
    if (stagger_ticks) { const unsigned long long t0 = __builtin_amdgcn_s_memrealtime(); while (__builtin_amdgcn_s_memrealtime() - t0 < (unsigned long long)stagger_ticks) __builtin_amdgcn_s_sleep(4); }
    const int tid = ltid(wave0), wid = wave0, lane = tid & 63, wr = wid >> 2, wc = wid & 3, fr = lane & 15, fq = lane >> 4;
    const int nt = K / BK;
    unsigned voffB[2], voffA[2][2], voffN[2][2]; int Rr[2], Cc[2];
#pragma unroll
    for (int i = 0; i < 2; ++i) { int R, C; stage_rc(tid * 16 + i * 8192, R, C); const int Rb = (R & ~31) + perm32(R & 31);
        Rr[i] = R; Cc[i] = C; voffB[i] = nB64 ? (unsigned)(Rb * 64 + ((C * 2) & 63) + ((C * 2) >> 6) * nB64 * 64) : (unsigned)(Rb * ldb + C) * 2u;
        voffA[0][i] = (unsigned)(R * lda + C) * 2u; voffA[1][i] = (unsigned)((R + HALF) * lda + C) * 2u; voffN[0][i] = voffA[0][i]; voffN[1][i] = voffA[1][i]; }
    const size_t kstep = (size_t)(BK * 2);
    const size_t kstepB = kstepB_arg ? kstepB_arg : kstep;
    const size_t hstepB = nB64 ? (size_t)HALF * 64 : (size_t)HALF * ldb * 2;
    const unsigned ldsw = (unsigned)wid * 1024u;
    const int aoff = lds_byte(wr * 64 + fr, fq * 8), boff = lds_byte(wc * 32 + fr, fq * 8);
#define PG8_SA(b, h) (((b) * 2 + (h)) * HTB)
#define PG8_SB(b, h) ((4 + (b) * 2 + (h)) * HTB)
#define PG8_STAGE_B(bufoff, gbase) do { _Pragma("unroll") for (int _i = 0; _i < 2; ++_i) \
        __builtin_amdgcn_global_load_lds((const unsigned*)((const char*)(gbase) + voffB[_i]), (LAS unsigned*)(lds + (bufoff) + ldsw + _i * 8192), 16, 0, 0); } while (0)
#define PG8_STAGE_A(bufoff, gbase, VO, h) do { _Pragma("unroll") for (int _i = 0; _i < 2; ++_i) \
        __builtin_amdgcn_global_load_lds((const unsigned*)((const char*)(gbase) + (VO)[h][_i]), (LAS unsigned*)(lds + (bufoff) + ldsw + _i * 8192), 16, 0, 0); } while (0)
#define PG8_LDA(dst, b, h) do { if constexpr (F8 == 1 || F8 == 2 || F8 == 4) { _Pragma("unroll") for (int m = 0; m < 4; ++m) { const i32x4 _lo = *(const LAS i32x4*)(lds + PG8_SA(b, h) + aoff + m * 2048), _hi = *(const LAS i32x4*)(lds + PG8_SA(b, h) + aoff + m * 2048 + 1024); \
            dst##_8[m] = __builtin_shufflevector(_lo, _hi, 0, 1, 2, 3, 4, 5, 6, 7); } } \
        else { _Pragma("unroll") for (int m = 0; m < 4; ++m) _Pragma("unroll") for (int k = 0; k < 2; ++k) dst[m][k] = *(const LAS bf16x8*)(lds + PG8_SA(b, h) + aoff + m * 2048 + k * 1024); } } while (0)
#define PG8_LDB(dst, b, h) do { if constexpr (F8 == 1 || F8 == 2 || F8 == 4) { _Pragma("unroll") for (int n = 0; n < 2; ++n) { const i32x4 _lo = *(const LAS i32x4*)(lds + PG8_SB(b, h) + boff + n * 2048), _hi = *(const LAS i32x4*)(lds + PG8_SB(b, h) + boff + n * 2048 + 1024); \
            dst##_8[n] = __builtin_shufflevector(_lo, _hi, 0, 1, 2, 3, 4, 5, 6, 7); } } \
        else { _Pragma("unroll") for (int n = 0; n < 2; ++n) _Pragma("unroll") for (int k = 0; k < 2; ++k) dst[n][k] = *(const LAS bf16x8*)(lds + PG8_SB(b, h) + boff + n * 2048 + k * 1024); } } while (0)
#define PG8_MMA(ai, bj, At, Bt) do { __builtin_amdgcn_s_setprio(1); \
        if constexpr (F8 == 3) { _Pragma("unroll") for (int m = 0; m < 4; ++m) _Pragma("unroll") for (int n = 0; n < 2; ++n) _Pragma("unroll") for (int k = 0; k < 2; ++k) \
            acc[ai][bj][m][n] = __builtin_bit_cast(f32x4, __builtin_amdgcn_mfma_i32_16x16x64_i8(__builtin_bit_cast(i32x4, Bt[n][k]), __builtin_bit_cast(i32x4, At[m][k]), __builtin_bit_cast(i32x4, acc[ai][bj][m][n]), 0, 0, 0)); \
            _Pragma("unroll") for (int m = 0; m < 4; ++m) _Pragma("unroll") for (int n = 0; n < 2; ++n) asm volatile("" : "+v"(acc[ai][bj][m][n])); } \
        else if constexpr (F8 != 0) { _Pragma("unroll") for (int m = 0; m < 4; ++m) _Pragma("unroll") for (int n = 0; n < 2; ++n) \
            acc[ai][bj][m][n] = __builtin_amdgcn_mfma_scale_f32_16x16x128_f8f6f4(Bt##_8[n], At##_8[m], acc[ai][bj][m][n], 0, 0, 0, SCW, 0, SCX); \
            _Pragma("unroll") for (int m = 0; m < 4; ++m) _Pragma("unroll") for (int n = 0; n < 2; ++n) asm volatile("" : "+v"(acc[ai][bj][m][n])); } \
        else { _Pragma("unroll") for (int m = 0; m < 4; ++m) _Pragma("unroll") for (int n = 0; n < 2; ++n) _Pragma("unroll") for (int k = 0; k < 2; ++k) \
            acc[ai][bj][m][n] = __builtin_amdgcn_mfma_f32_16x16x32_bf16(Bt[n][k], At[m][k], acc[ai][bj][m][n], 0, 0, 0); } \
        __builtin_amdgcn_s_setprio(0); } while (0)
#define PG8_WAIT_V(n) asm volatile("s_waitcnt vmcnt(" #n ")" ::: "memory")
#define PG8_WAIT_L(n) asm volatile("s_waitcnt lgkmcnt(" #n ")" ::: "memory")
#define PG8_WAIT_VX(rx) do { if (rx) asm volatile("s_waitcnt vmcnt(%0)" :: "n"(8 + Epi::NVM) : "memory"); else asm volatile("s_waitcnt vmcnt(8)" ::: "memory"); } while (0)
#define PG8_BAR __builtin_amdgcn_s_barrier()
#define PG8_SCHED __builtin_amdgcn_sched_barrier(0)
    Unit cur, nxt; int ui = 0;
    if (!S.next(0, cur)) return;
    if constexpr (GATHER) {
#pragma unroll
        for (int h = 0; h < 2; ++h)
#pragma unroll
            for (int i = 0; i < 2; ++i) voffA[h][i] = (unsigned)(S.row(cur, Rr[i] + h * HALF) * lda + Cc[i]) * 2u;
    }
    f32x4 acc[2][2][4][2];
#pragma unroll
    for (int a = 0; a < 2; ++a)
#pragma unroll
        for (int b = 0; b < 2; ++b)
#pragma unroll
            for (int m = 0; m < 4; ++m)
#pragma unroll
                for (int n = 0; n < 2; ++n) acc[a][b][m][n] = (f32x4){0.f, 0.f, 0.f, 0.f};
    bf16x8 At[4][2], B0[2][2], B1[2][2]; i32x8 At_8[4], B0_8[2], B1_8[2];
    constexpr int SCW = 0x79797979, SCX = (F8 == 4) ? (int)0x80808080 : (F8 == 2) ? 0x7d7d7d7d : 0x7f7f7f7f;
    const char* cA = cur.A; const char* cB = cur.B;
    PG8_STAGE_B(PG8_SB(0, 0), cB); PG8_STAGE_B(PG8_SB(0, 1), cB + hstepB); PG8_STAGE_A(PG8_SA(0, 0), cA, voffA, 0); PG8_STAGE_A(PG8_SA(0, 1), cA, voffA, 1);
    if (wr == 1) PG8_BAR;
    PG8_WAIT_V(2); PG8_BAR;
    PG8_STAGE_B(PG8_SB(1, 0), cB + kstepB); PG8_STAGE_A(PG8_SA(1, 0), cA + kstep, voffA, 0); PG8_STAGE_B(PG8_SB(1, 1), cB + hstepB + kstepB);
    PG8_WAIT_V(6); PG8_BAR;
    bool relax = false;
    for (;;) {
        const bool has_next = S.next(ui + 1, nxt);
        if constexpr (GATHER) {
            if (has_next) {
#pragma unroll
                for (int h = 0; h < 2; ++h)
#pragma unroll
                    for (int i = 0; i < 2; ++i) voffN[h][i] = (unsigned)(S.row(nxt, Rr[i] + h * HALF) * lda + Cc[i]) * 2u;
            } else {
#pragma unroll
                for (int h = 0; h < 2; ++h)
#pragma unroll
                    for (int i = 0; i < 2; ++i) voffN[h][i] = voffA[h][i];
            }
        }
        const char* nA = has_next ? nxt.A : cA; const char* nB = has_next ? nxt.B : cB;
#pragma unroll 1
        for (int t = 0; t < nt; t += 2) {
            const bool last = (t == nt - 2); int rxi = (relax && t == 0) ? 1 : 0; asm volatile("" : "+v"(rxi)); const bool rx = __builtin_amdgcn_readfirstlane(rxi) != 0;
            if constexpr (Epi::HAS_MID) { constexpr int SEGT = (F8 != 0) ? 8 : 16; if (t == SEGT || t == 2 * SEGT) { PG8_SCHED; E.mid(acc, cur, t / SEGT, wr, wc, fr, fq); PG8_SCHED; } }
            const char* a1 = cA + (size_t)(t + 1) * kstep;
            const char* a2 = last ? nA : cA + (size_t)(t + 2) * kstep; const char* b2 = last ? nB : cB + (size_t)(t + 2) * kstepB;
            const char* a3 = a2 + kstep; const char* b3 = b2 + kstepB;
            unsigned vo2[2][2];
#pragma unroll
            for (int h = 0; h < 2; ++h)
#pragma unroll
                for (int i = 0; i < 2; ++i) vo2[h][i] = (GATHER && last) ? voffN[h][i] : voffA[h][i];
            PG8_LDB(B0, 0, 0); PG8_LDB(B1, 0, 1); PG8_SCHED; PG8_LDA(At, 0, 0); if (!rx) PG8_STAGE_A(PG8_SA(1, 1), a1, voffA, 1);
            PG8_WAIT_VX(rx); PG8_WAIT_L(0); PG8_BAR; PG8_MMA(0, 0, At, B0); PG8_MMA(0, 1, At, B1); PG8_BAR; PG8_SCHED;
            PG8_LDA(At, 0, 1); PG8_STAGE_B(PG8_SB(0, 0), b2); PG8_STAGE_B(PG8_SB(0, 1), b2 + hstepB); PG8_STAGE_A(PG8_SA(0, 0), a2, vo2, 0);
            PG8_WAIT_VX(rx); PG8_WAIT_L(0); PG8_BAR; PG8_MMA(1, 0, At, B0); PG8_MMA(1, 1, At, B1); PG8_BAR; PG8_SCHED;
            PG8_LDB(B0, 1, 0); PG8_LDB(B1, 1, 1); PG8_SCHED; PG8_LDA(At, 1, 0); PG8_STAGE_A(PG8_SA(0, 1), a2, vo2, 1);
            PG8_WAIT_VX(rx); PG8_WAIT_L(0); PG8_BAR; PG8_MMA(0, 0, At, B0); PG8_MMA(0, 1, At, B1); PG8_BAR; PG8_SCHED;
            PG8_LDA(At, 1, 1); PG8_STAGE_B(PG8_SB(1, 0), b3); PG8_STAGE_B(PG8_SB(1, 1), b3 + hstepB); PG8_STAGE_A(PG8_SA(1, 0), a3, vo2, 0);
            PG8_WAIT_V(8); PG8_WAIT_L(0); PG8_BAR; PG8_MMA(1, 0, At, B0); PG8_MMA(1, 1, At, B1); PG8_BAR; PG8_SCHED;
        }
        if (ALIGN_EPI) { if (wr == 0) PG8_BAR; }
        if (ALIGN_EPI && has_next) { if constexpr (GATHER) PG8_STAGE_A(PG8_SA(1, 1), nA + kstep, voffN, 1); else PG8_STAGE_A(PG8_SA(1, 1), nA + kstep, voffA, 1); }
        E(acc, cur, wr, wc, fr, fq);
        if (!has_next) break;
#pragma unroll
        for (int a = 0; a < 2; ++a)
#pragma unroll
            for (int b = 0; b < 2; ++b)
#pragma unroll
                for (int m = 0; m < 4; ++m)
#pragma unroll
                    for (int n = 0; n < 2; ++n) acc[a][b][m][n] = (f32x4){0.f, 0.f, 0.f, 0.f};
        cur = nxt; cA = nA; cB = nB; ++ui; relax = ALIGN_EPI;
        if constexpr (GATHER) {
#pragma unroll
            for (int h = 0; h < 2; ++h)
#pragma unroll
                for (int i = 0; i < 2; ++i) voffA[h][i] = voffN[h][i];
        }
        if (ALIGN_EPI) { if (wr == 1) PG8_BAR; }
    }
    PG8_WAIT_V(0);
    if (!ALIGN_EPI) { if (wr == 0) PG8_BAR; }
    PG8_BAR;
#undef PG8_SA
#undef PG8_SB
#undef PG8_STAGE_A
#undef PG8_STAGE_B
#undef PG8_LDA
#undef PG8_LDB
#undef PG8_MMA
#undef PG8_WAIT_V
#undef PG8_WAIT_L
#undef PG8_WAIT_VX
#undef PG8_BAR
#undef PG8_SCHED
}

#define EPI_ROWCOL const int row0 = u.orow + wr * 64 + fr, colw = wc * 32 + 8 * fq
struct EpiP1 {
    static constexpr int NVM = 16;
    static constexpr bool HAS_MID = false;
    bf16* PROJ; bf16* GATE; const float* bgate; const float* sx; const float* sw; int i8;
    __device__ __forceinline__ void operator()(const f32x4 (&acc)[2][2][4][2], const Unit& u, int wr, int wc, int fr, int fq) const {
        EPI_ROWCOL; const int pn = u.pn; const int mode = pn < 8 ? 1 : (pn < 24 ? 0 : 2);
        bf16* base = (mode == 2) ? GATE : PROJ; const int colt = ((mode == 2) ? (pn - 24) : pn) * BM + colw;
        f32x4 bv[2][2];
#pragma unroll
        for (int bj = 0; bj < 2; ++bj)
#pragma unroll
            for (int n = 0; n < 2; ++n) {
                if (i8) bv[bj][n] = *(const f32x4*)(sw + colt + bj * HALF + 4 * n);
                else { const f32x4 t = *(const f32x4*)(bgate + ((mode == 2) ? colt : colw) + bj * HALF + 4 * n); bv[bj][n] = (mode == 2) ? t : (f32x4){0.f, 0.f, 0.f, 0.f}; } }
#pragma unroll
        for (int ai = 0; ai < 2; ++ai)
#pragma unroll
            for (int m = 0; m < 4; ++m) { bf16* rowp = base + (size_t)(row0 + ai * HALF + m * 16) * INC + colt;
                float rs = 0.f; if (i8) rs = sx[row0 + ai * HALF + m * 16];
#pragma unroll
                for (int bj = 0; bj < 2; ++bj) { f32x4 v0 = acc[ai][bj][m][0], v1 = acc[ai][bj][m][1];
                    if (i8) { const i32x4 q0 = __builtin_bit_cast(i32x4, v0), q1 = __builtin_bit_cast(i32x4, v1);
                        v0 = (f32x4){(float)q0[0], (float)q0[1], (float)q0[2], (float)q0[3]} * rs * bv[bj][0]; v1 = (f32x4){(float)q1[0], (float)q1[1], (float)q1[2], (float)q1[3]} * rs * bv[bj][1]; }
                    else { v0 += bv[bj][0]; v1 += bv[bj][1]; }
                    if (mode == 1) { const f32x2 a = gelu_pk((f32x2){v0[0], v0[1]}), b = gelu_pk((f32x2){v0[2], v0[3]}), c = gelu_pk((f32x2){v1[0], v1[1]}), d = gelu_pk((f32x2){v1[2], v1[3]});
                        v0 = (f32x4){a.x, a.y, b.x, b.y}; v1 = (f32x4){c.x, c.y, d.x, d.y}; }
                    else if (mode == 2) {
#pragma unroll
                        for (int j = 0; j < 4; ++j) { v0[j] = fast_sigmoid(v0[j]); v1[j] = fast_sigmoid(v1[j]); } }
                    u32x4 w; w.x = cvt_pk_bf16(v0[0], v0[1]); w.y = cvt_pk_bf16(v0[2], v0[3]); w.z = cvt_pk_bf16(v1[0], v1[1]); w.w = cvt_pk_bf16(v1[2], v1[3]);
                    *(u32x4*)(rowp + bj * HALF) = w; } }
    }
};
struct EpiP3 {
    static constexpr int NVM = 16;
    static constexpr bool HAS_MID = true;
    const bf16* GATE; unsigned char* MG;
    __device__ __forceinline__ void mid(f32x4 (&acc)[2][2][4][2], const Unit& u, int seg, int wr, int wc, int fr, int fq) const {
        int opq = 0; asm volatile("" : "+v"(opq));
        const int row0 = u.orow + wr * 64 + fr + opq, colw = wc * 32 + 8 * fq;
#pragma unroll
        for (int ai = 0; ai < 2; ++ai)
#pragma unroll
            for (int m = 0; m < 4; ++m) { const bf16* gp = GATE + (size_t)(row0 + ai * HALF + m * 16) * INC + (size_t)(seg - 1) * D + u.pn * BM + colw;
#pragma unroll
                for (int bj = 0; bj < 2; ++bj) { const u32x4 a = *(const u32x4*)(gp + bj * HALF), b = *(const u32x4*)(gp + D + bj * HALF);
                    f32x4 r0, r1;
                    r0[0] = bflo(a.x) * __builtin_amdgcn_rcpf(fmaxf(bflo(b.x), 1e-30f)); r0[1] = bfhi(a.x) * __builtin_amdgcn_rcpf(fmaxf(bfhi(b.x), 1e-30f));
                    r0[2] = bflo(a.y) * __builtin_amdgcn_rcpf(fmaxf(bflo(b.y), 1e-30f)); r0[3] = bfhi(a.y) * __builtin_amdgcn_rcpf(fmaxf(bfhi(b.y), 1e-30f));
                    r1[0] = bflo(a.z) * __builtin_amdgcn_rcpf(fmaxf(bflo(b.z), 1e-30f)); r1[1] = bfhi(a.z) * __builtin_amdgcn_rcpf(fmaxf(bfhi(b.z), 1e-30f));
                    r1[2] = bflo(a.w) * __builtin_amdgcn_rcpf(fmaxf(bflo(b.w), 1e-30f)); r1[3] = bfhi(a.w) * __builtin_amdgcn_rcpf(fmaxf(bfhi(b.w), 1e-30f));
                    acc[ai][bj][m][0] *= r0; acc[ai][bj][m][1] *= r1; }
                asm volatile("" ::: "memory"); }
    }
    __device__ __forceinline__ void operator()(const f32x4 (&acc)[2][2][4][2], const Unit& u, int wr, int wc, int fr, int fq) const {
        EPI_ROWCOL;
#pragma unroll
        for (int ai = 0; ai < 2; ++ai)
#pragma unroll
            for (int m = 0; m < 4; ++m) { const size_t r = (size_t)(row0 + ai * HALF + m * 16);
#pragma unroll
                for (int bj = 0; bj < 2; ++bj) { const int col = u.pn * BM + bj * HALF + colw;
                    const u32x4 gw = *(const u32x4*)(GATE + r * INC + 2 * D + col);
                    f32x4 r0 = acc[ai][bj][m][0], r1 = acc[ai][bj][m][1];
                    r0[0] *= bflo(gw.x); r0[1] *= bfhi(gw.x); r0[2] *= bflo(gw.y); r0[3] *= bfhi(gw.y); r1[0] *= bflo(gw.z); r1[1] *= bfhi(gw.z); r1[2] *= bflo(gw.w); r1[3] *= bfhi(gw.w);
                    u32x2 w; w.x = pk4_fp8(4.f * r0[0], 4.f * r0[1], 4.f * r0[2], 4.f * r0[3]); w.y = pk4_fp8(4.f * r1[0], 4.f * r1[1], 4.f * r1[2], 4.f * r1[3]); *(u32x2*)(MG + r * D + col) = w; }
                asm volatile("" ::: "memory"); }
    }
};
struct EpiP4 {
    static constexpr int NVM = 16;
    static constexpr bool HAS_MID = false;
    bf16* MIX;
    __device__ __forceinline__ void operator()(const f32x4 (&acc)[2][2][4][2], const Unit& u, int wr, int wc, int fr, int fq) const {
        EPI_ROWCOL;
#pragma unroll
        for (int ai = 0; ai < 2; ++ai)
#pragma unroll
            for (int m = 0; m < 4; ++m) { bf16* rowp = MIX + (size_t)(row0 + ai * HALF + m * 16) * D + u.pn * BM + colw;
#pragma unroll
                for (int bj = 0; bj < 2; ++bj) { const f32x4 v0 = acc[ai][bj][m][0], v1 = acc[ai][bj][m][1];
                    u32x4 w; w.x = cvt_pk_bf16(v0[0], v0[1]); w.y = cvt_pk_bf16(v0[2], v0[3]); w.z = cvt_pk_bf16(v1[0], v1[1]); w.w = cvt_pk_bf16(v1[2], v1[3]);
                    *(u32x4*)(rowp + bj * HALF) = w; } }
    }
};
struct EpiP6 {
    static constexpr int NVM = 8;
    static constexpr bool HAS_MID = false;
    unsigned char* H;
    __device__ __forceinline__ void operator()(const f32x4 (&acc)[2][2][4][2], const Unit& u, int wr, int wc, int fr, int fq) const {
        EPI_ROWCOL;
#pragma unroll
        for (int ai = 0; ai < 2; ++ai)
#pragma unroll
            for (int m = 0; m < 4; ++m) { const size_t r = (size_t)(row0 + ai * HALF + m * 16);
                float h[8];
#pragma unroll
                for (int n = 0; n < 2; ++n)
#pragma unroll
                    for (int j = 0; j < 4; ++j) { const float g = acc[ai][0][m][n][j], up = acc[ai][1][m][n][j]; h[4 * n + j] = 4.0f * g * fast_sigmoid(g) * up; }
                u32x2 w; w.x = pk4_fp8(h[0], h[1], h[2], h[3]); w.y = pk4_fp8(h[4], h[5], h[6], h[7]);
                *(u32x2*)(H + r * EH + u.pn * HALF + colw) = w; }
    }
};
struct EpiP7 {
    static constexpr int NVM = 16;
    static constexpr bool HAS_MID = false;
    unsigned char* Y;
    __device__ __forceinline__ void operator()(const f32x4 (&acc)[2][2][4][2], const Unit& u, int wr, int wc, int fr, int fq) const {
        EPI_ROWCOL;
#pragma unroll
        for (int ai = 0; ai < 2; ++ai)
#pragma unroll
            for (int m = 0; m < 4; ++m) { unsigned char* rowp = Y + (size_t)(row0 + ai * HALF + m * 16) * D + u.pn * BM + colw;
#pragma unroll
                for (int bj = 0; bj < 2; ++bj) { const f32x4 v0 = acc[ai][bj][m][0], v1 = acc[ai][bj][m][1];
                    u32x2 w; w.x = 0u; w.y = 0u;
                    w.x = __builtin_amdgcn_cvt_pk_fp8_f32(v0[0], v0[1], w.x, false); w.x = __builtin_amdgcn_cvt_pk_fp8_f32(v0[2], v0[3], w.x, true);
                    w.y = __builtin_amdgcn_cvt_pk_fp8_f32(v1[0], v1[1], w.y, false); w.y = __builtin_amdgcn_cvt_pk_fp8_f32(v1[2], v1[3], w.y, true);
                    *(u32x2*)(rowp + bj * HALF) = w; }
                asm volatile("" ::: "memory"); }
    }
};
}

#define XB_TMO      128
#define XB_XCNT(j)  (256  + 64 * (j))
#define XB_XSUB(j)  (1280 + 64 * (j))
#define XB_XGEN(j)  (2304 + 64 * (j))
#define XB_TOP      3328
#define XB_TOPGEN   3392
#define XCD_BAR_WORDS 3456
#define XB_SPIN_CAP (1u << 18)
__device__ __forceinline__ unsigned xb_ld(unsigned* p)              { return __hip_atomic_load(p, __ATOMIC_RELAXED, __HIP_MEMORY_SCOPE_AGENT); }
__device__ __forceinline__ unsigned xb_add(unsigned* p, unsigned v) { return __hip_atomic_fetch_add(p, v, __ATOMIC_RELAXED, __HIP_MEMORY_SCOPE_AGENT); }
__device__ __forceinline__ unsigned xb_xcc_id() { return (unsigned)__builtin_amdgcn_s_getreg((3 << 11) | 20) & 0xFu; }
#define XB_SPIN(cond, bar) do { unsigned _sp = 0; while (cond) { __builtin_amdgcn_s_sleep(1); \
    if ((++_sp & 255u) == 0u) { if (xb_ld(&(bar)[XB_TMO])) break; if (_sp > XB_SPIN_CAP) { atomicAdd(&(bar)[XB_TMO], 1u); break; } } } } while (0)
struct XcdBarrier { unsigned* bar; unsigned x; volatile LAS unsigned* st; };
__device__ __forceinline__ XcdBarrier xcd_barrier_post(unsigned* bar, volatile LAS unsigned* st) {
    XcdBarrier b; b.bar = bar; b.x = xb_xcc_id(); b.st = st;
    if (threadIdx.x == 0) (void)xb_add(&bar[XB_XCNT(b.x)], 1u);
    return b;
}
__device__ __forceinline__ void xcd_barrier_complete(unsigned* bar, unsigned x, unsigned& nloc, unsigned& nx) {
    const unsigned G = gridDim.x * gridDim.y * gridDim.z;
    unsigned sum, cnt, mine, sp = 0u;
    for (;;) {
        sum = 0u; cnt = 0u; mine = 0u;
#pragma unroll
        for (unsigned j = 0; j < 16; ++j) { const unsigned c = xb_ld(&bar[XB_XCNT(j)]); sum += c; cnt += (c > 0u) ? 1u : 0u; mine = (j == x) ? c : mine; }
        if (sum == G) break;
        __builtin_amdgcn_s_sleep(1);
        if ((++sp & 255u) == 0u) { if (xb_ld(&bar[XB_TMO])) break; if (sp > XB_SPIN_CAP) { atomicAdd(&bar[XB_TMO], 1u); break; } }
    }
    nloc = mine > 0u ? mine : 1u; nx = cnt > 0u ? cnt : 1u;
}
__device__ __forceinline__ void xcd_barrier(const XcdBarrier& b) {
    asm volatile("s_waitcnt vmcnt(0)" ::: "memory");
    __syncthreads();
    if (threadIdx.x == 0) {
        unsigned* bar = b.bar;
        __builtin_amdgcn_s_waitcnt(0);
        unsigned nloc = b.st[0], nx = b.st[1];
        if (nloc == 0u) { xcd_barrier_complete(bar, b.x, nloc, nx); b.st[0] = nloc; b.st[1] = nx; }
        const unsigned old = xb_add(&bar[XB_XSUB(b.x)], 1u);
        const unsigned gen = old / nloc;
        if (old + 1u == (gen + 1u) * nloc) {
            __builtin_amdgcn_fence(__ATOMIC_RELEASE, "agent");
            asm volatile("s_waitcnt vmcnt(0)" ::: "memory");
            const unsigned og = xb_add(&bar[XB_TOP], 1u);
            const unsigned tg = og / nx;
            if (og + 1u == (tg + 1u) * nx) xb_add(&bar[XB_TOPGEN], 1u);
            else XB_SPIN(xb_ld(&bar[XB_TOPGEN]) == tg, bar);
            __builtin_amdgcn_fence(__ATOMIC_ACQUIRE, "agent");
            xb_add(&bar[XB_XGEN(b.x)], 1u);
            asm volatile("s_waitcnt vmcnt(0)" ::: "memory");
        } else {
            XB_SPIN(xb_ld(&bar[XB_XGEN(b.x)]) == gen, bar);
            __builtin_amdgcn_fence(__ATOMIC_ACQUIRE, "agent");
            asm volatile("s_waitcnt vmcnt(0)" ::: "memory");
        }
    }
    __syncthreads();
}

template <int MAP>
__device__ __forceinline__ void ln_finish(float (&v)[32], const float* __restrict__ g, const float* __restrict__ b, float* xout, bf16* xbout, int lane, bf16* xlout = nullptr, unsigned char* x8out = nullptr, unsigned char* xi8out = nullptr, float* sxout = nullptr) {
    float s = 0.f;
#pragma unroll
    for (int i = 0; i < 32; ++i) s += v[i];
    const float mean = wave_sum(s, lane) * (1.0f / D);
    float q = 0.f;
#pragma unroll
    for (int i = 0; i < 32; ++i) { v[i] -= mean; q += v[i] * v[i]; }
    const float rstd = 1.0f / sqrtf(wave_sum(q, lane) * (1.0f / D) + LN_EPS);
    const bool two = (xi8out != nullptr);
    float qm = 0.f;
    if (two) {
        float am = 0.f;
        if (MAP == 0) {
#pragma unroll
            for (int j = 0; j < 8; ++j) { const int c = 4 * (lane + 64 * j); const f32x4 gv = *(const f32x4*)(g + c), bv = *(const f32x4*)(b + c);
                v[4 * j] = v[4 * j] * rstd * gv.x + bv.x; v[4 * j + 1] = v[4 * j + 1] * rstd * gv.y + bv.y; v[4 * j + 2] = v[4 * j + 2] * rstd * gv.z + bv.z; v[4 * j + 3] = v[4 * j + 3] * rstd * gv.w + bv.w; }
        } else {
#pragma unroll
            for (int j = 0; j < 4; ++j) { const int c = 8 * (lane + 64 * j); const f32x4 g0 = *(const f32x4*)(g + c), g1 = *(const f32x4*)(g + c + 4), b0 = *(const f32x4*)(b + c), b1 = *(const f32x4*)(b + c + 4);
                v[8 * j] = v[8 * j] * rstd * g0.x + b0.x; v[8 * j + 1] = v[8 * j + 1] * rstd * g0.y + b0.y; v[8 * j + 2] = v[8 * j + 2] * rstd * g0.z + b0.z; v[8 * j + 3] = v[8 * j + 3] * rstd * g0.w + b0.w;
                v[8 * j + 4] = v[8 * j + 4] * rstd * g1.x + b1.x; v[8 * j + 5] = v[8 * j + 5] * rstd * g1.y + b1.y; v[8 * j + 6] = v[8 * j + 6] * rstd * g1.z + b1.z; v[8 * j + 7] = v[8 * j + 7] * rstd * g1.w + b1.w; }
        }
#pragma unroll
        for (int i = 0; i < 32; ++i) am = fmaxf(am, fabsf(v[i]));
#pragma unroll
        for (int o = 1; o < 64; o <<= 1) am = fmaxf(am, shx(am, o, lane));
        am = fmaxf(am, 1e-20f); qm = 127.0f / am;
        if (lane == 0) *sxout = am * (1.0f / 127.0f);
    }
    if (MAP == 0) {
#pragma unroll
        for (int j = 0; j < 8; ++j) {
            const int c = 4 * (lane + 64 * j);
            f32x4 o;
            if (two) { o.x = v[4 * j]; o.y = v[4 * j + 1]; o.z = v[4 * j + 2]; o.w = v[4 * j + 3]; *(unsigned*)(xi8out + c) = pk4_i8(o.x, o.y, o.z, o.w, qm); }
            else { const f32x4 gv = *(const f32x4*)(g + c), bv = *(const f32x4*)(b + c);
                o.x = v[4 * j] * rstd * gv.x + bv.x; o.y = v[4 * j + 1] * rstd * gv.y + bv.y; o.z = v[4 * j + 2] * rstd * gv.z + bv.z; o.w = v[4 * j + 3] * rstd * gv.w + bv.w; }
            if (xout) *(f32x4*)(xout + c) = o;
            if (xbout) { u32x2 w; w.x = pk2(o.x, o.y); w.y = pk2(o.z, o.w); *(u32x2*)(xbout + c) = w; }
            if (xlout) { u32x2 w; w.x = pk2(o.x - bf2f(f2bf(o.x)), o.y - bf2f(f2bf(o.y))); w.y = pk2(o.z - bf2f(f2bf(o.z)), o.w - bf2f(f2bf(o.w))); *(u32x2*)(xlout + c) = w; }
            if (x8out) *(unsigned*)(x8out + c) = pk4_fp8(o.x, o.y, o.z, o.w);
        }
    } else {
#pragma unroll
        for (int j = 0; j < 4; ++j) {
            const int c = 8 * (lane + 64 * j);
            f32x4 o0, o1;
            if (two) { o0.x = v[8 * j]; o0.y = v[8 * j + 1]; o0.z = v[8 * j + 2]; o0.w = v[8 * j + 3]; o1.x = v[8 * j + 4]; o1.y = v[8 * j + 5]; o1.z = v[8 * j + 6]; o1.w = v[8 * j + 7];
                u32x2 w; w.x = pk4_i8(o0.x, o0.y, o0.z, o0.w, qm); w.y = pk4_i8(o1.x, o1.y, o1.z, o1.w, qm); *(u32x2*)(xi8out + c) = w; }
            else { const f32x4 g0 = *(const f32x4*)(g + c), g1 = *(const f32x4*)(g + c + 4), b0 = *(const f32x4*)(b + c), b1 = *(const f32x4*)(b + c + 4);
                o0.x = v[8 * j] * rstd * g0.x + b0.x; o0.y = v[8 * j + 1] * rstd * g0.y + b0.y; o0.z = v[8 * j + 2] * rstd * g0.z + b0.z; o0.w = v[8 * j + 3] * rstd * g0.w + b0.w;
                o1.x = v[8 * j + 4] * rstd * g1.x + b1.x; o1.y = v[8 * j + 5] * rstd * g1.y + b1.y; o1.z = v[8 * j + 6] * rstd * g1.z + b1.z; o1.w = v[8 * j + 7] * rstd * g1.w + b1.w; }
            if (xout) { *(f32x4*)(xout + c) = o0; *(f32x4*)(xout + c + 4) = o1; }
            if (xbout) { u32x4 w; w.x = pk2(o0.x, o0.y); w.y = pk2(o0.z, o0.w); w.z = pk2(o1.x, o1.y); w.w = pk2(o1.z, o1.w); *(u32x4*)(xbout + c) = w; }
            if (x8out) { u32x2 w; w.x = pk4_fp8(o0.x, o0.y, o0.z, o0.w); w.y = pk4_fp8(o1.x, o1.y, o1.z, o1.w); *(u32x2*)(x8out + c) = w; }
        }
    }
}
__device__ __forceinline__ void entry_ln_row(const Params& p, int t, int lane) {
    float* X = (float*)(p.ws + WS_X); bf16* XB = (bf16*)(p.ws + WS_XB);
    float v[32]; const float* xr = p.in[0] + (size_t)t * D;
#pragma unroll
    for (int j = 0; j < 8; ++j) { const f32x4 a = __builtin_nontemporal_load((const f32x4*)(xr + 4 * (lane + 64 * j))); v[4 * j] = a.x; v[4 * j + 1] = a.y; v[4 * j + 2] = a.z; v[4 * j + 3] = a.w; }
    ln_finish<0>(v, p.in[1], p.in[2], nullptr, XB + (size_t)t * D, lane, nullptr, p.ws + WS_X8IN + (size_t)t * D, p.ws + WS_XI8 + (size_t)t * D, (float*)(p.ws + WS_SX) + t);
}

__device__ __forceinline__ void spatial_unit(const Params& p, int l, int unit, LAS unsigned char* lds, int tid) {
    const int nb = unit >> 2, g = unit & 3, lane = tid & 63, wid = __builtin_amdgcn_readfirstlane(tid >> 6), fr = lane & 15, fq = lane >> 4;
    LAS bf16* VT = (LAS bf16*)lds; LAS bf16* WM = (LAS bf16*)(lds + 69632);
    const bf16* PROJ = (const bf16*)(p.ws + WS_PROJ); unsigned char* YABC = p.ws + WS_YABC;
    const float* ws = p.in[4] + ((size_t)l * 4 + g) * 128 * 128; const float* bs = p.in[5] + ((size_t)l * 4 + g) * 128;
#pragma unroll
    for (int q = 0; q < 8; ++q) { const int pc = tid + 512 * q, i = pc >> 5, j4 = (pc & 31) * 4; const f32x4 w = *(const f32x4*)(ws + i * 128 + j4);
        u32x2 o; o.x = pk2(w.x, w.y); o.y = pk2(w.z, w.w); *(LAS u32x2*)(WM + i * 136 + j4) = o; }
    {
        const int j = wid * 16 + fr; const bf16* vp = PROJ + ((size_t)nb * 128 + j) * INC + 1024 + g * 256 + fq * 8;
        float v[64];
#pragma unroll
        for (int q = 0; q < 8; ++q) { const u32x4 w = *(const u32x4*)(vp + q * 32);
            v[8 * q] = bflo(w.x); v[8 * q + 1] = bfhi(w.x); v[8 * q + 2] = bflo(w.y); v[8 * q + 3] = bfhi(w.y); v[8 * q + 4] = bflo(w.z); v[8 * q + 5] = bfhi(w.z); v[8 * q + 6] = bflo(w.w); v[8 * q + 7] = bfhi(w.w); }
        float sm = 0.f;
#pragma unroll
        for (int i = 0; i < 64; ++i) sm += v[i];
        sm += shx(sm, 16, lane); sm += shx(sm, 32, lane);
        const float mean = sm * (1.0f / 256.0f); float sq = 0.f;
#pragma unroll
        for (int i = 0; i < 64; ++i) { v[i] -= mean; sq += v[i] * v[i]; }
        sq += shx(sq, 16, lane); sq += shx(sq, 32, lane);
        const float rstd = 1.0f / sqrtf(sq * (1.0f / 256.0f) + LN_EPS);
#pragma unroll
        for (int q = 0; q < 8; ++q)
#pragma unroll
            for (int i = 0; i < 8; ++i) VT[(q * 32 + fq * 8 + i) * 136 + j] = (bf16)f2bf(v[8 * q + i] * rstd);
    }
    __syncthreads();
    f32x4 acc[2][8];
#pragma unroll
    for (int cf = 0; cf < 2; ++cf)
#pragma unroll
        for (int f = 0; f < 8; ++f) acc[cf][f] = (f32x4){0.f, 0.f, 0.f, 0.f};
#pragma unroll
    for (int ks = 0; ks < 4; ++ks) {
        bf16x8 a[2];
#pragma unroll
        for (int cf = 0; cf < 2; ++cf) a[cf] = *(const LAS bf16x8*)(VT + (wid * 32 + cf * 16 + fr) * 136 + ks * 32 + fq * 8);
#pragma unroll
        for (int f = 0; f < 8; ++f) {
            if (ks >= 2 && f < 4) continue;
            const bf16x8 b = *(const LAS bf16x8*)(WM + (f * 16 + fr) * 136 + ks * 32 + fq * 8);
#pragma unroll
            for (int cf = 0; cf < 2; ++cf) acc[cf][f] = __builtin_amdgcn_mfma_f32_16x16x32_bf16(a[cf], b, acc[cf][f], 0, 0, 0);
        }
    }
#pragma unroll
    for (int f = 0; f < 8; ++f) {
        const int i = f * 16 + fr; const size_t t = (size_t)nb * 128 + i; const float bias = bs[i];
#pragma unroll
        for (int cf = 0; cf < 2; ++cf) { const int c = g * 256 + wid * 32 + cf * 16 + 4 * fq;
            const u32x2 uw = __builtin_nontemporal_load((const u32x2*)(PROJ + t * INC + c));
            *(unsigned*)(YABC + t * 3072 + c) = pk4_fp8(4.f * bflo(uw.x) * (acc[cf][f][0] + bias), 4.f * bfhi(uw.x) * (acc[cf][f][1] + bias), 4.f * bflo(uw.y) * (acc[cf][f][2] + bias), 4.f * bfhi(uw.y) * (acc[cf][f][3] + bias)); }
    }
    __syncthreads();
}
__device__ __forceinline__ void ld8(const bf16* ptr, float (&f)[8]) {
    const u32x4 w = __builtin_nontemporal_load((const u32x4*)ptr);
    f[0] = bflo(w.x); f[1] = bfhi(w.x); f[2] = bflo(w.y); f[3] = bfhi(w.y); f[4] = bflo(w.z); f[5] = bfhi(w.z); f[6] = bflo(w.w); f[7] = bfhi(w.w);
}
__device__ __forceinline__ void st8(bf16* ptr, const float (&f)[8]) {
    u32x4 w; w.x = pk2(f[0], f[1]); w.y = pk2(f[2], f[3]); w.z = pk2(f[4], f[5]); w.w = pk2(f[6], f[7]); *(u32x4*)ptr = w;
}
__device__ __forceinline__ void st8q(unsigned char* ptr, const float (&f)[8]) {
    u32x2 w; w.x = pk4_fp8(4.f * f[0], 4.f * f[1], 4.f * f[2], 4.f * f[3]); w.y = pk4_fp8(4.f * f[4], 4.f * f[5], 4.f * f[6], 4.f * f[7]); *(u32x2*)ptr = w;
}
__device__ __forceinline__ void conv_task(const Params& p, int l, int t0, int c) {
    const bf16* PROJ = (const bf16*)(p.ws + WS_PROJ); unsigned char* YABC = p.ws + WS_YABC;
    float w0[8], w1[8], w2[8], z2[8], z1[8];
    { const float* wc = p.in[6] + (size_t)l * 3 * 1024 + c;
      const f32x4 a0 = *(const f32x4*)wc, a1 = *(const f32x4*)(wc + 4), b0 = *(const f32x4*)(wc + 1024), b1 = *(const f32x4*)(wc + 1028), c0 = *(const f32x4*)(wc + 2048), c1 = *(const f32x4*)(wc + 2052);
      w0[0] = a0.x; w0[1] = a0.y; w0[2] = a0.z; w0[3] = a0.w; w0[4] = a1.x; w0[5] = a1.y; w0[6] = a1.z; w0[7] = a1.w;
      w1[0] = b0.x; w1[1] = b0.y; w1[2] = b0.z; w1[3] = b0.w; w1[4] = b1.x; w1[5] = b1.y; w1[6] = b1.z; w1[7] = b1.w;
      w2[0] = c0.x; w2[1] = c0.y; w2[2] = c0.z; w2[3] = c0.w; w2[4] = c1.x; w2[5] = c1.y; w2[6] = c1.z; w2[7] = c1.w; }
#pragma unroll
    for (int i = 0; i < 8; ++i) { z2[i] = 0.f; z1[i] = 0.f; }
    if (t0 >= 2) { float cg[8], hh[8]; ld8(PROJ + (size_t)(t0 - 2) * INC + 3072 + c, cg); ld8(PROJ + (size_t)(t0 - 2) * INC + 4096 + c, hh);
#pragma unroll
        for (int i = 0; i < 8; ++i) z2[i] = cg[i] * hh[i];
        ld8(PROJ + (size_t)(t0 - 1) * INC + 3072 + c, cg); ld8(PROJ + (size_t)(t0 - 1) * INC + 4096 + c, hh);
#pragma unroll
        for (int i = 0; i < 8; ++i) z1[i] = cg[i] * hh[i]; }
#pragma unroll
    for (int k = 0; k < 16; ++k) { const size_t t = (size_t)(t0 + k);
        float bgv[8], cg[8], hh[8], o[8]; ld8(PROJ + t * INC + 2048 + c, bgv); ld8(PROJ + t * INC + 3072 + c, cg); ld8(PROJ + t * INC + 4096 + c, hh);
#pragma unroll
        for (int i = 0; i < 8; ++i) { const float z0 = cg[i] * hh[i]; o[i] = bgv[i] * (w0[i] * z2[i] + w1[i] * z1[i] + w2[i] * z0); z2[i] = z1[i]; z1[i] = z0; }
        st8q(YABC + t * 3072 + 1024 + c, o); }
}
template <int WIN> __device__ __forceinline__ void pool_task(const Params& p, int t0, int c) {
    const bf16* PROJ = (const bf16*)(p.ws + WS_PROJ); unsigned char* YABC = p.ws + WS_YABC;
    float ring[WIN][8], tot[8];
#pragma unroll
    for (int i = 0; i < 8; ++i) tot[i] = 0.f;
#pragma unroll
    for (int d = 1 - WIN; d < 0; ++d) {
        if (t0 > 0) { ld8(PROJ + (size_t)(t0 + d) * INC + 5120 + c, ring[(d + WIN) % WIN]);
#pragma unroll
            for (int i = 0; i < 8; ++i) tot[i] += ring[(d + WIN) % WIN][i]; }
        else {
#pragma unroll
            for (int i = 0; i < 8; ++i) ring[(d + WIN) % WIN][i] = 0.f; }
    }
#pragma unroll
    for (int k = 0; k < 16; ++k) { const int t = t0 + k;
        float cur[8], o[8]; ld8(PROJ + (size_t)t * INC + 5120 + c, cur);
        const float inv = (k + 1 < WIN && t0 == 0) ? 1.0f / (float)(k + 1) : 1.0f / (float)WIN;
#pragma unroll
        for (int i = 0; i < 8; ++i) { tot[i] += cur[i]; o[i] = tot[i] * inv - cur[i]; ring[k % WIN][i] = cur[i]; }
        st8q(YABC + (size_t)t * 3072 + 2048 + c, o);
#pragma unroll
        for (int i = 0; i < 8; ++i) tot[i] -= ring[(k + 1) % WIN][i];
    }
}
__device__ __forceinline__ void convpool_task(const Params& p, int l, int task) {
    if (task < 65536) { conv_task(p, l, (task >> 7) * 16, (task & 127) * 8); return; }
    const int k = task - 65536, g = __builtin_amdgcn_readfirstlane((k >> 6) & 3), run = ((k >> 8) << 1) + ((k >> 5) & 1), c = (g * 32 + (k & 31)) * 8, t0 = run * 16;
    if (g == 0) pool_task<2>(p, t0, c); else if (g == 1) pool_task<4>(p, t0, c); else if (g == 2) pool_task<8>(p, t0, c); else pool_task<16>(p, t0, c);
}

typedef float f32x16 __attribute__((ext_vector_type(16)));
__device__ __forceinline__ void ln1_router_unit(const Params& p, int l, int unit, LAS unsigned char* lds, int tid, bool dry = false) {
    LAS float* part = (LAS float*)lds; LAS float* lg = (LAS float*)(lds + 65536); LAS float* sl = (LAS float*)(lds + 73728); LAS int* le = (LAS int*)(lds + 75776); LAS float* lw = (LAS float*)(lds + 76800);
    LAS int* cnt = (LAS int*)(lds + 77824); LAS int* base = cnt + 64;
    const int lane = tid & 63, wid = __builtin_amdgcn_readfirstlane(tid >> 6); const int t0 = unit * 32;
    const bf16* MIX = (const bf16*)(p.ws + WS_PRE); bf16* XL = (bf16*)(p.ws + WS_X); bf16* XB = (bf16*)(p.ws + WS_XB);
    for (int r = 0; r < 4; ++r) {
        const int t = t0 + wid * 4 + r; float v[32]; const bf16* xr = XB + (size_t)t * D; const bf16* mr = MIX + (size_t)t * D;
#pragma unroll
        for (int j = 0; j < 8; ++j) { const int c = 4 * (lane + 64 * j); const u32x2 a = __builtin_nontemporal_load((const u32x2*)(xr + c)); const u32x2 mw = __builtin_nontemporal_load((const u32x2*)(mr + c));
            v[4 * j] = ALPHA * bflo(a.x) + bflo(mw.x); v[4 * j + 1] = ALPHA * bfhi(a.x) + bfhi(mw.x); v[4 * j + 2] = ALPHA * bflo(a.y) + bflo(mw.y); v[4 * j + 3] = ALPHA * bfhi(a.y) + bfhi(mw.y); }
        ln_finish<0>(v, p.in[15] + (size_t)l * D, p.in[16] + (size_t)l * D, nullptr, XB + (size_t)t * D, lane, XL + (size_t)t * D, p.ws + WS_X8 + (size_t)t * D);
    }
    if (tid < 64) cnt[tid] = 0;
    __threadfence_block();
    __syncthreads();
    {
        const int fr = lane & 15, fq = lane >> 4;
        const bf16* wrh = (const bf16*)(p.ws + WS_WR) + (size_t)l * 2 * NE * D; const bf16* wrl = wrh + (size_t)NE * D;
        f32x4 racc[2][4];
#pragma unroll
        for (int a2 = 0; a2 < 2; ++a2)
#pragma unroll
            for (int b2 = 0; b2 < 4; ++b2) racc[a2][b2] = (f32x4){0.f, 0.f, 0.f, 0.f};
#pragma unroll 2
        for (int ks = 0; ks < 8; ++ks) {
            const int k0 = 256 * wid + 32 * ks + 8 * fq;
            bf16x8 ah[2], al[2];
#pragma unroll
            for (int mf = 0; mf < 2; ++mf) { const size_t xo = (size_t)(t0 + mf * 16 + fr) * D + k0; ah[mf] = *(const bf16x8*)(XB + xo); al[mf] = *(const bf16x8*)(XL + xo); }
#pragma unroll
            for (int nf = 0; nf < 4; ++nf) {
                const bf16x8 bh = *(const bf16x8*)(wrh + (size_t)(nf * 16 + fr) * D + k0), bl = *(const bf16x8*)(wrl + (size_t)(nf * 16 + fr) * D + k0);
#pragma unroll
                for (int mf = 0; mf < 2; ++mf) {
                    racc[mf][nf] = __builtin_amdgcn_mfma_f32_16x16x32_bf16(ah[mf], bh, racc[mf][nf], 0, 0, 0);
                    racc[mf][nf] = __builtin_amdgcn_mfma_f32_16x16x32_bf16(ah[mf], bl, racc[mf][nf], 0, 0, 0);
                    racc[mf][nf] = __builtin_amdgcn_mfma_f32_16x16x32_bf16(al[mf], bh, racc[mf][nf], 0, 0, 0); }
            }
        }
#pragma unroll
        for (int mf = 0; mf < 2; ++mf)
#pragma unroll
            for (int nf = 0; nf < 4; ++nf)
#pragma unroll
                for (int r = 0; r < 4; ++r) part[(wid * 32 + mf * 16 + 4 * fq + r) * 64 + nf * 16 + fr] = racc[mf][nf][r];
    }
    __syncthreads();
    { f32x4 sm = *(const LAS f32x4*)(part + tid * 4);
#pragma unroll
      for (int w = 1; w < 8; ++w) sm += *(const LAS f32x4*)(part + w * 2048 + tid * 4);
      *(LAS f32x4*)(lg + tid * 4) = (f32x4){sigmoidf_(sm.x), sigmoidf_(sm.y), sigmoidf_(sm.z), sigmoidf_(sm.w)}; }
    __syncthreads();
    {
        const float rbias = p.in[18][(size_t)l * NE + lane]; const int gi = lane >> 3;
        for (int tt = 0; tt < 4; ++tt) {
            const int tok = wid * 4 + tt;
            const float sc = lg[tok * 64 + lane], sel = sc + rbias;
            float m1 = sel; m1 = fmaxf(m1, shx(m1, 1, lane)); m1 = fmaxf(m1, shx(m1, 2, lane)); m1 = fmaxf(m1, shx(m1, 4, lane));
            const unsigned long long eq = __ballot(sel == m1);
            const int first = __ffs((unsigned)(eq >> (gi * 8)) & 0xffu) - 1;
            float m2 = ((lane & 7) == first) ? -INFINITY : sel; m2 = fmaxf(m2, shx(m2, 1, lane)); m2 = fmaxf(m2, shx(m2, 2, lane)); m2 = fmaxf(m2, shx(m2, 4, lane));
            const float gscore = m1 + m2;
            int grank = 0;
#pragma unroll
            for (int g2 = 0; g2 < 8; ++g2) { const float v = shl(gscore, g2 * 8); grank += ((v > gscore) || (v == gscore && g2 < gi)) ? 1 : 0; }
            const bool gsel = grank < 4;
            const unsigned long long selmask = __ballot(gsel);
            sl[wid * 64 + lane] = sel;
            asm volatile("s_waitcnt lgkmcnt(0)" ::: "memory");
            int rank = 0;
#pragma unroll
            for (int e4 = 0; e4 < 16; ++e4) { const f32x4 v = *(const LAS f32x4*)(sl + wid * 64 + e4 * 4);
#pragma unroll
                for (int j = 0; j < 4; ++j) { const int e2 = e4 * 4 + j; const bool ok = (selmask >> e2) & 1ull; rank += (ok && ((v[j] > sel) || (v[j] == sel && e2 < lane))) ? 1 : 0; } }
            asm volatile("s_waitcnt lgkmcnt(0)" ::: "memory");
            const bool chosen = gsel && rank < 8;
            const float wsum = wave_sum(chosen ? sc : 0.f, lane);
            if (chosen) { le[tok * 8 + rank] = lane; lw[tok * 8 + rank] = sc * (ROUTED_SCALE / wsum); }
        }
    }
    __syncthreads();
    if (dry) return;
    int myrank = 0, mye = 0;
    if (tid < 256) { mye = le[tid]; myrank = atomicAdd((int*)&cnt[mye], 1); }
    __syncthreads();
    if (tid < 64) { const int c = cnt[tid]; base[tid] = c ? (int)atomicAdd((unsigned*)(p.ws + WS_CTL) + CW_CNT + 64 * l + tid, (unsigned)c) : 0; }
    __syncthreads();
    if (tid < 256) {
        const int t = t0 + (tid >> 3), s = tid & 7, pos = base[mye] + myrank;
        ((int*)(p.ws + WS_TOPE))[t * 8 + s] = mye; ((int*)(p.ws + WS_TOPPOS))[t * 8 + s] = pos; ((float*)(p.ws + WS_TOPW))[t * 8 + s] = lw[tid];
        ((int*)(p.ws + WS_LIST))[((size_t)l * 64 + mye) * 8192 + pos] = t;
    }
    __syncthreads();
}

template <bool last> __device__ __forceinline__ void combine_ln2_row(const Params& p, int l, int t, const LAS MoeTab* tb, int lane, bool dry = false) {
    const unsigned char* Y = p.ws + WS_Y; bf16* XB = (bf16*)(p.ws + WS_XB);
    int row_l; float w_l;
    { const int s = lane & 15;
      if (s < 8) { const int e = ((const int*)(p.ws + WS_TOPE))[t * 8 + s]; row_l = tb->rb[e] + ((const int*)(p.ws + WS_TOPPOS))[t * 8 + s]; w_l = ((const float*)(p.ws + WS_TOPW))[t * 8 + s]; }
      else { row_l = tb->rb[64] + t; w_l = 1.0f; } }
    float v[32];
    const bf16* xr = XB + (size_t)t * D;
#pragma unroll
    for (int j = 0; j < 4; ++j) { float f[8]; ld8(xr + 8 * (lane + 64 * j), f);
#pragma unroll
        for (int i = 0; i < 8; ++i) v[8 * j + i] = ALPHA * f[i]; }
    int rows[9]; float ws[9];
#pragma unroll
    for (int s = 0; s < 9; ++s) { rows[s] = __builtin_amdgcn_readlane(row_l, s); ws[s] = 0.125f * __uint_as_float(__builtin_amdgcn_readlane(__float_as_uint(w_l), s)); }
#pragma unroll
    for (int j = 0; j < 4; ++j) {
        u32x2 q[9];
#pragma unroll
        for (int s = 0; s < 9; ++s) q[s] = __builtin_nontemporal_load((const u32x2*)(Y + (size_t)rows[s] * D + 8 * (lane + 64 * j)));
#pragma unroll
        for (int s = 0; s < 9; ++s) { const float w = ws[s];
            const f32x2 a = __builtin_amdgcn_cvt_pk_f32_fp8(q[s].x, false), b = __builtin_amdgcn_cvt_pk_f32_fp8(q[s].x, true), c = __builtin_amdgcn_cvt_pk_f32_fp8(q[s].y, false), d = __builtin_amdgcn_cvt_pk_f32_fp8(q[s].y, true);
            v[8 * j] += w * a.x; v[8 * j + 1] += w * a.y; v[8 * j + 2] += w * b.x; v[8 * j + 3] += w * b.y; v[8 * j + 4] += w * c.x; v[8 * j + 5] += w * c.y; v[8 * j + 6] += w * d.x; v[8 * j + 7] += w * d.y; }
    }
    float* xo = dry ? (float*)(p.ws + WS_PRE) + (size_t)t * D : (last ? p.out + (size_t)t * D : nullptr);
    const float* g2 = p.in[25] + (size_t)l * D; asm volatile("" : "+s"(g2));
    const float* b2 = p.in[26] + (size_t)l * D; asm volatile("" : "+s"(b2));
    ln_finish<1>(v, g2, b2, xo, (last || dry) ? nullptr : XB + (size_t)t * D, lane, nullptr, (last || dry) ? nullptr : p.ws + WS_X8IN + (size_t)t * D, (last || dry) ? nullptr : p.ws + WS_XI8 + (size_t)t * D, (float*)(p.ws + WS_SX) + t);
}

struct TrJob { const float* src; bf16* dst; int ldsrc, lddst; float qmul; int i8; };
__device__ __forceinline__ void tr_load(const TrJob& j, f32x4 (&v)[16], int lane) {
    if (j.lddst == 0) return;
    const int kr = lane >> 4, n4 = (lane & 15) * 4;
#pragma unroll
    for (int q = 0; q < 16; ++q) v[q] = __builtin_nontemporal_load((const f32x4*)(j.src + (size_t)(4 * q + kr) * j.ldsrc + n4));
}
__device__ __forceinline__ void tr_store(const TrJob& j, const f32x4 (&v)[16], LAS float* scr, int lane, const LAS float* colq = nullptr) {
    if (j.lddst == 0) return;
    const int kr = lane >> 4, n4 = (lane & 15) * 4;
#pragma unroll
    for (int q = 0; q < 16; ++q) { const int k = 4 * q + kr; *(LAS f32x4*)(scr + k * 64 + (n4 ^ (8 * (k >> 3)))) = v[q]; }
    asm volatile("s_waitcnt lgkmcnt(0)" ::: "memory");
    if (j.lddst < 0) {
        const size_t rstride = (size_t)(-j.lddst);
        const int kg2 = lane >> 4, r = lane & 15; unsigned char* d8 = (unsigned char*)j.dst;
#pragma unroll
        for (int s = 0; s < 4; ++s) {
            const int n = 16 * s + r; const LAS float* s0 = scr + (16 * kg2) * 64 + (n ^ (16 * kg2)); const LAS float* s1 = scr + (16 * kg2 + 8) * 64 + (n ^ (16 * kg2 + 8));
            u32x4 w;
            const float qm = colq ? colq[n] : j.qmul;
            if (j.i8) { w.x = pk4_i8(s0[0], s0[64], s0[128], s0[192], qm); w.y = pk4_i8(s0[256], s0[320], s0[384], s0[448], qm); w.z = pk4_i8(s1[0], s1[64], s1[128], s1[192], qm); w.w = pk4_i8(s1[256], s1[320], s1[384], s1[448], qm); }
            else { w.x = pk4_fp8(qm * s0[0], qm * s0[64], qm * s0[128], qm * s0[192]); w.y = pk4_fp8(qm * s0[256], qm * s0[320], qm * s0[384], qm * s0[448]);
                w.z = pk4_fp8(qm * s1[0], qm * s1[64], qm * s1[128], qm * s1[192]); w.w = pk4_fp8(qm * s1[256], qm * s1[320], qm * s1[384], qm * s1[448]); }
            __builtin_nontemporal_store(w, (u32x4*)(d8 + (size_t)n * rstride + 16 * kg2));
        }
        asm volatile("s_waitcnt lgkmcnt(0)" ::: "memory");
        return;
    }
    const int kg = lane >> 3, r = lane & 7;
#pragma unroll
    for (int s = 0; s < 8; ++s) {
        const int n = 8 * s + r; const LAS float* sp = scr + (8 * kg) * 64 + (n ^ (8 * kg));
        u32x4 w; w.x = cvt_pk_bf16(sp[0], sp[64]); w.y = cvt_pk_bf16(sp[128], sp[192]); w.z = cvt_pk_bf16(sp[256], sp[320]); w.w = cvt_pk_bf16(sp[384], sp[448]);
        __builtin_nontemporal_store(w, (u32x4*)(j.dst + (size_t)n * j.lddst + 8 * kg));
    }
    asm volatile("s_waitcnt lgkmcnt(0)" ::: "memory");
}
constexpr int I_IN = 32 * 96, I_PA = 16 * 32, I_O = 32 * 32, I_EX = 65 * 256, I_LAYER = 2 * I_IN + 2 * I_PA + I_O + 3 * I_EX;
__device__ __forceinline__ TrJob prologue_job(const Params& p, int it) {
    const int l = it / I_LAYER; int r = it % I_LAYER; TrJob j; j.qmul = 64.0f; j.i8 = 0;
    unsigned char* wl = p.ws + WS_W + (size_t)l * WL_BYTES;
    if (r < 2 * I_IN) {
        const int which = r / I_IN; r %= I_IN; const int kb = r / 96, nb = r % 96;
        j.src = p.in[which ? 9 : 3] + (size_t)l * D * INC + (size_t)(kb * 64) * INC + nb * 64; j.ldsrc = INC;
        j.dst = (bf16*)(wl + WL_IG + ((size_t)kb * 2 * INC + which * INC + nb * 64) * 64); j.lddst = -64;
        if (which == 0) j.lddst = 0;
        return j; }
    r -= 2 * I_IN;
    if (r < 2 * I_PA) {
        const int which = r / I_PA; r %= I_PA; const int kb = r / 32, nb = r % 32;
        j.src = p.in[11 + which] + (size_t)l * 1024 * D + (size_t)(kb * 64) * D + nb * 64; j.ldsrc = D;
        j.dst = (bf16*)(wl + WL_ABC + ((size_t)(which * 16 + kb) * 2048 + nb * 64) * 64); j.lddst = -64; return j; }
    r -= 2 * I_PA;
    if (r < I_O) {
        const int kb = r / 32, nb = r % 32;
        j.src = p.in[14] + (size_t)l * D * D + (size_t)(kb * 64) * D + nb * 64; j.ldsrc = D;
        j.dst = (bf16*)(wl + WL_O + ((size_t)kb * 2048 + nb * 64) * 64); j.lddst = -64; return j; }
    r -= I_O;
    const int kind = r / I_EX; r %= I_EX; const int e = r >> 8; r &= 255;
    if (kind < 2) {
        const int kb = r >> 3, nb = r & 7, n0 = nb * 64;
        j.src = (e < 64 ? p.in[19 + kind] + ((size_t)l * 64 + e) * D * EH : p.in[22 + kind] + (size_t)l * D * EH) + (size_t)(kb * 64) * EH + n0; j.ldsrc = EH;
        const int drow = (n0 >> 7) * 256 + kind * 128 + (n0 & 127);
        j.dst = (bf16*)(wl + WL_GU + (size_t)e * 1024 * D + ((size_t)kb * 1024 + drow) * 64); j.lddst = -64;
    } else {
        const int kb = r >> 5, nb = r & 31;
        j.src = (e < 64 ? p.in[21] + ((size_t)l * 64 + e) * EH * D : p.in[24] + (size_t)l * EH * D) + (size_t)(kb * 64) * D + nb * 64; j.ldsrc = D;
        j.dst = (bf16*)(wl + WL_D + (size_t)e * D * EH + ((size_t)kb * D + nb * 64) * 64); j.lddst = -64;
    }
    return j;
}
__device__ __forceinline__ void win_pass1(const Params& p, int l, int job, int lane) {
    const int kb = job / 96, cb = job % 96; const int kr = lane >> 4, n4 = (lane & 15) * 4;
    const float* sp = p.in[3] + (size_t)l * D * INC + (size_t)(kb * 64) * INC + cb * 64;
    f32x4 am = (f32x4){0.f, 0.f, 0.f, 0.f};
#pragma unroll
    for (int q = 0; q < 16; ++q) { const f32x4 x = *(const f32x4*)(sp + (size_t)(4 * q + kr) * INC + n4);
        am.x = fmaxf(am.x, fabsf(x.x)); am.y = fmaxf(am.y, fabsf(x.y)); am.z = fmaxf(am.z, fabsf(x.z)); am.w = fmaxf(am.w, fabsf(x.w)); }
    am.x = fmaxf(am.x, shx(am.x, 16, lane)); am.y = fmaxf(am.y, shx(am.y, 16, lane)); am.z = fmaxf(am.z, shx(am.z, 16, lane)); am.w = fmaxf(am.w, shx(am.w, 16, lane));
    am.x = fmaxf(am.x, shx(am.x, 32, lane)); am.y = fmaxf(am.y, shx(am.y, 32, lane)); am.z = fmaxf(am.z, shx(am.z, 32, lane)); am.w = fmaxf(am.w, shx(am.w, 32, lane));
    unsigned* ctl = (unsigned*)(p.ws + WS_CTL);
    unsigned dep = 0u;
    if (lane < 16) { unsigned* cm = ctl + CW_CMAX + l * INC + cb * 64 + n4;
        dep = __hip_atomic_fetch_max(cm, __float_as_uint(am.x), __ATOMIC_RELAXED, __HIP_MEMORY_SCOPE_AGENT) | __hip_atomic_fetch_max(cm + 1, __float_as_uint(am.y), __ATOMIC_RELAXED, __HIP_MEMORY_SCOPE_AGENT)
            | __hip_atomic_fetch_max(cm + 2, __float_as_uint(am.z), __ATOMIC_RELAXED, __HIP_MEMORY_SCOPE_AGENT) | __hip_atomic_fetch_max(cm + 3, __float_as_uint(am.w), __ATOMIC_RELAXED, __HIP_MEMORY_SCOPE_AGENT); }
    asm volatile("s_waitcnt vmcnt(0)" : "+v"(dep) :: "memory");
    dep = (unsigned)__builtin_amdgcn_readfirstlane((int)dep) & 0u;
    if (lane == 0) __hip_atomic_fetch_add(ctl + CW_WCNT + l * 96 + cb, 1u + dep, __ATOMIC_RELAXED, __HIP_MEMORY_SCOPE_AGENT);
}
__device__ __forceinline__ void win_pass2(const Params& p, int l, int job, LAS float* scr, LAS float* colq, int lane) {
    const int kb = job / 96, cb = job % 96; unsigned* ctl = (unsigned*)(p.ws + WS_CTL);
    { unsigned spin = 0; while (__hip_atomic_load(ctl + CW_WCNT + l * 96 + cb, __ATOMIC_RELAXED, __HIP_MEMORY_SCOPE_AGENT) < 32u && ++spin < (1u << 22)) __builtin_amdgcn_s_sleep(2); }
    { const float cs = fmaxf(__uint_as_float(__hip_atomic_load(ctl + CW_CMAX + l * INC + cb * 64 + lane, __ATOMIC_RELAXED, __HIP_MEMORY_SCOPE_AGENT)), 1e-30f);
      colq[lane] = 127.0f / cs; if (kb == 0) ((float*)(p.ws + WS_SW))[(size_t)l * INC + cb * 64 + lane] = cs * (1.0f / 127.0f); }
    unsigned char* wl = p.ws + WS_W + (size_t)l * WL_BYTES;
    TrJob j; j.src = p.in[3] + (size_t)l * D * INC + (size_t)(kb * 64) * INC + cb * 64; j.ldsrc = INC; j.dst = (bf16*)(wl + WL_IG + ((size_t)kb * 2 * INC + cb * 64) * 64); j.lddst = -64; j.qmul = 0.f; j.i8 = 1;
    f32x4 v[16]; tr_load(j, v, lane); tr_store(j, v, scr, lane, colq);
}
constexpr int I_DENSE = 2 * I_IN + 2 * I_PA + I_O;
#ifndef NCONV
#define NCONV 49920
#endif
constexpr int I_P0 = I_DENSE + (3 * I_EX - NCONV);
template <int MODE> __device__ __forceinline__ int tr_map(int k, int l) {
    if (MODE == 0) return k;
    if (MODE == 1) { const int ll = k / I_P0, r = k % I_P0; return ll * I_LAYER + (r < I_DENSE ? r : NCONV + r); }
    if (MODE == 3) return I_LAYER + k;
    if (MODE == 5) return I_IN + k;
    if (MODE == 6) return I_LAYER + I_IN + k;
    if (MODE == 7) return k;
    if (MODE == 4) return k < I_DENSE ? k : (k - I_DENSE < 3 * I_EX - NCONV ? NCONV + k : I_LAYER + I_DENSE + NCONV + (k - I_DENSE - (3 * I_EX - NCONV)));
    return l * I_LAYER + I_DENSE + k;
}
template <int MODE> __device__ __forceinline__ void prologue_transposes(const Params& p, int l, int gw, int NGW, LAS float* scr, int lane) {
    constexpr int NIT = MODE == 0 ? NL * I_LAYER : (MODE == 1 ? NL * I_P0 : (MODE == 3 ? I_DENSE : (MODE == 4 ? I_DENSE + 2 * (3 * I_EX - NCONV) : (MODE == 5 ? I_DENSE - I_IN : (MODE == 6 ? I_DENSE - I_IN : (MODE == 7 ? I_IN : NCONV))))));
    int it = gw; if (it >= NIT) return;
    f32x4 va[16], vb[16];
    TrJob ja = prologue_job(p, tr_map<MODE>(it, l)); tr_load(ja, va, lane);
    for (;;) {
        const int itn = it + NGW; const bool more = itn < NIT;
        TrJob jb = ja; if (more) { jb = prologue_job(p, tr_map<MODE>(itn, l)); tr_load(jb, vb, lane); }
        tr_store(ja, va, scr, lane);
        if (!more) break;
#pragma unroll
        for (int q = 0; q < 16; ++q) va[q] = vb[q];
        ja = jb; it = itn;
    }
}
__device__ __forceinline__ void wcprime_tile(const Params& p, int tile, LAS bf16* sA, LAS bf16* sB, int tid) {
    const int l = tile >> 8, g = (tile >> 6) & 3, tm = (tile >> 5) & 1, tn = tile & 31;
    const int lane = tid & 63, wid = tid >> 6, wm = wid >> 1, wn = wid & 1, fr = lane & 15, fq = lane >> 4;
    const float* Ap = p.in[7] + ((size_t)l * 4 + g) * 256 * 256; const float* sc = p.in[8] + (size_t)l * 1024 + g * 256;
    const float* Wp = p.in[13] + (size_t)l * 1024 * D + (size_t)(g * 256) * D;
    unsigned char* dst = p.ws + WS_W + (size_t)l * WL_BYTES + WL_ABC;
    f32x4 acc[2][2];
#pragma unroll
    for (int a = 0; a < 2; ++a)
#pragma unroll
        for (int b = 0; b < 2; ++b) acc[a][b] = (f32x4){0.f, 0.f, 0.f, 0.f};
    const int ar = tid >> 2, akseg = (tid & 3) * 8, wk = tid >> 4, wns = (tid & 15) * 4;
    for (int k0 = 0; k0 < 256; k0 += 32) {
        const float* ap = Ap + (size_t)(tm * 128 + ar) * 256 + k0 + akseg;
        const f32x4 x0 = *(const f32x4*)ap, x1 = *(const f32x4*)(ap + 4), s0 = *(const f32x4*)(sc + k0 + akseg), s1 = *(const f32x4*)(sc + k0 + akseg + 4);
        u32x4 av; av.x = pk2(x0.x * s0.x, x0.y * s0.y); av.y = pk2(x0.z * s0.z, x0.w * s0.w); av.z = pk2(x1.x * s1.x, x1.y * s1.y); av.w = pk2(x1.z * s1.z, x1.w * s1.w);
        const f32x4 wv = *(const f32x4*)(Wp + (size_t)(k0 + wk) * D + tn * 64 + wns);
        *(LAS u32x4*)(sA + ar * 40 + akseg) = av;
        sB[(wns + 0) * 40 + wk] = (bf16)f2bf(wv.x); sB[(wns + 1) * 40 + wk] = (bf16)f2bf(wv.y); sB[(wns + 2) * 40 + wk] = (bf16)f2bf(wv.z); sB[(wns + 3) * 40 + wk] = (bf16)f2bf(wv.w);
        __syncthreads();
#pragma unroll
        for (int mi = 0; mi < 2; ++mi) {
            const bf16x8 a = *(const LAS bf16x8*)(sA + (wm * 32 + mi * 16 + fr) * 40 + fq * 8);
#pragma unroll
            for (int ni = 0; ni < 2; ++ni) {
                const bf16x8 b = *(const LAS bf16x8*)(sB + (wn * 32 + ni * 16 + fr) * 40 + fq * 8);
                acc[mi][ni] = __builtin_amdgcn_mfma_f32_16x16x32_bf16(a, b, acc[mi][ni], 0, 0, 0);
            }
        }
        __syncthreads();
    }
#pragma unroll
    for (int mi = 0; mi < 2; ++mi)
#pragma unroll
        for (int ni = 0; ni < 2; ++ni)
#pragma unroll
            for (int j = 0; j < 4; ++j) { const int c = tm * 128 + wm * 32 + mi * 16 + fq * 4 + j, n = tn * 64 + wn * 32 + ni * 16 + fr;
                dst[((size_t)(32 + g * 4 + (c >> 6)) * 2048 + n) * 64 + (c & 63)] = (unsigned char)(pk4_fp8(64.f * acc[mi][ni][j], 0.f, 0.f, 0.f) & 255u); }
}

__global__ void __launch_bounds__(512, 2) fwd(Params p) {
    extern __shared__ __attribute__((aligned(16))) unsigned char lds_raw[];
    LAS unsigned char* lds = (LAS unsigned char*)lds_raw;
    LAS MoeTab* tb = (LAS MoeTab*)(lds + LDSCTL_OFF);
    volatile LAS unsigned* MISC = (volatile LAS unsigned*)(lds + MISC_OFF);
    const int wave0 = __builtin_amdgcn_readfirstlane((int)threadIdx.x >> 6);
    const int G = gridDim.x, bx = blockIdx.x; const int vcu = (G % 8 == 0) ? (bx % 8) * (G / 8) + bx / 8 : bx;
    const bool split = (G == 256 && p.ph_hi - p.ph_lo == NPHASES);
    constexpr int GEMM_WGS = 112;
    if (threadIdx.x < 32) MISC[threadIdx.x] = 0u;
    __syncthreads();
    unsigned* ctl = (unsigned*)(p.ws + WS_CTL);
    XcdBarrier bar; bar.bar = ctl + CW_BAR; bar.x = 0; bar.st = nullptr;
    const int lo = p.ph_lo, hi = p.ph_hi;
    if (hi - lo > 1) bar = xcd_barrier_post(ctl + CW_BAR, MISC + 8);
#define IN(k) (lo <= (k) && (k) < hi)
#define SEAM(k) do { if (IN(k) && IN((k) + 1)) xcd_barrier(bar); } while (0)

    if (IN(0)) for (int rep = 0; rep < REPS(0); ++rep) {
        const int tid = ltid(wave0), lane = tid & 63, wave = __builtin_amdgcn_readfirstlane(tid >> 6);
        LAS float* scr = (LAS float*)(lds + wave * 16384);
        const int gw = vcu * 8 + wave, NGW = G * 8;
        static_assert(NCONV == 3 * I_EX, "the deferred-dense schedule assumes the converters take all expert weights");
        const int NWJ = (split && CONVMODE == 0) ? 3072 : 6144;
        for (int job = gw; job < NWJ; job += NGW) win_pass1(p, job / 3072, job % 3072, lane);
        if (!(split && CONVMODE == 0)) prologue_transposes<0>(p, 0, gw, NGW, scr, lane);
        for (int t = gw; t < T; t += NGW) entry_ln_row(p, t, lane);
        for (int it = (vcu * 8 + wave) * 64 + lane; it < NL * D * NE; it += NGW * 64) {
            const int l2 = it / (D * NE), r2 = it % (D * NE), n = r2 / D, k = r2 % D; const float w = p.in[17][(size_t)l2 * D * NE + (size_t)k * NE + n];
            const unsigned hi = f2bf(w); const float rem = w - bf2f(hi);
            bf16* wr = (bf16*)(p.ws + WS_WR) + (size_t)l2 * 2 * NE * D; wr[(size_t)n * D + k] = (bf16)hi; wr[(size_t)(NE + n) * D + k] = (bf16)f2bf(rem); }
        for (int job = gw; job < NWJ; job += NGW) win_pass2(p, job / 3072, job % 3072, scr, (LAS float*)(lds + 131072 + wave * 256), lane);
        __syncthreads();
        for (int tile = bx; tile < 512; tile += G) wcprime_tile(p, tile, (LAS bf16*)lds, (LAS bf16*)(lds + 16384), tid);
    }
    SEAM(0);

    for (int l = 0; l < NL; ++l) {
        const int pb = 1 + 8 * l;
        const char* wl = (const char*)(p.ws + WS_W + (size_t)l * WL_BYTES);
        if (IN(pb + 0)) for (int rep = 0; rep < REPS(1); ++rep) {
            if (!split || bx < GEMM_WGS) {
                pg8::DenseSched S; S.A = (const char*)(p.ws + WS_XI8); S.B = wl + WL_IG; S.atile = (size_t)256 * D; S.btile = (size_t)256 * 64; S.nM = 32; S.nN = 24; S.G = split ? GEMM_WGS : G; S.c = bx;
                pg8::EpiP1 E{(bf16*)(p.ws + WS_PROJ), (bf16*)(p.ws + WS_GATE), p.in[10] + (size_t)l * INC, (const float*)(p.ws + WS_SX), (const float*)(p.ws + WS_SW) + (size_t)l * INC, 1};
                pg8::gemm_phase<pg8::EpiP1, pg8::DenseSched, false, 3>(lds, D / 2, D / 2, 64, S, E, wave0, STAGGER(STAG1), (size_t)2 * INC * 128, 2 * INC);
            } else {
                const int tid = ltid(wave0), lane = tid & 63, wave = __builtin_amdgcn_readfirstlane(tid >> 6);
                if (CONVMODE == 0 && l == 0) for (int job = (bx - GEMM_WGS) * 8 + wave; job < 3072; job += (G - GEMM_WGS) * 8) win_pass1(p, 1, job, lane);
                if (CONVMODE != 2) prologue_transposes<2>(p, l, (bx - GEMM_WGS) * 8 + wave, (G - GEMM_WGS) * 8, (LAS float*)(lds + wave * 16384), lane);
                if (CONVMODE == 0 && l == 0) prologue_transposes<5>(p, l, (bx - GEMM_WGS) * 8 + wave, (G - GEMM_WGS) * 8, (LAS float*)(lds + wave * 16384), lane);
                if (CONVMODE == 0 && l == 1) prologue_transposes<6>(p, l, (bx - GEMM_WGS) * 8 + wave, (G - GEMM_WGS) * 8, (LAS float*)(lds + wave * 16384), lane);
                if (CONVMODE == 0 && l == 0) for (int job = (bx - GEMM_WGS) * 8 + wave; job < 3072; job += (G - GEMM_WGS) * 8) win_pass2(p, 1, job, (LAS float*)(lds + wave * 16384), (LAS float*)(lds + 131072 + wave * 256), lane);
            }
        }
        SEAM(pb + 0);
        if (IN(pb + 1)) for (int rep = 0; rep < REPS(2); ++rep) {
            const int tid = ltid(wave0);
            for (int u = bx; u < 256; u += G) spatial_unit(p, l, u, lds, tid);
            for (int it = bx * 512 + tid; it < 131072; it += G * 512) convpool_task(p, l, ((it >> 9) & 1) * 65536 + (it >> 10) * 512 + (it & 511));
        }
        SEAM(pb + 1);
        if (IN(pb + 2)) for (int rep = 0; rep < REPS(3); ++rep) {
            { pg8::GateSched S; S.A = (const char*)(p.ws + WS_X8IN); S.B = wl + WL_IG; S.G = G; S.c = bx;
              pg8::EpiP1 E{(bf16*)(p.ws + WS_PROJ), (bf16*)(p.ws + WS_GATE), p.in[10] + (size_t)l * INC, nullptr, nullptr, 0};
              pg8::gemm_phase<pg8::EpiP1, pg8::GateSched, false, 1>(lds, D / 2, D / 2, 64, S, E, wave0, 0u, (size_t)2 * INC * 128, 2 * INC); }
            { pg8::DenseSched S; S.A = (const char*)(p.ws + WS_YABC); S.B = wl + WL_ABC; S.atile = (size_t)256 * 3072; S.btile = (size_t)256 * 64; S.nM = 32; S.nN = 8; S.G = G; S.c = bx;
              pg8::EpiP3 E{(const bf16*)(p.ws + WS_GATE), p.ws + WS_MERGED};
              pg8::gemm_phase<pg8::EpiP3, pg8::DenseSched, false, 2>(lds, 1536, 1536, 64, S, E, wave0, STAGGER(STAG3), (size_t)2048 * 128, 2048); }
        }
        SEAM(pb + 2);
        if (IN(pb + 3)) for (int rep = 0; rep < REPS(4); ++rep) {
            pg8::DenseSched S; S.A = (const char*)(p.ws + WS_MERGED); S.B = wl + WL_O; S.atile = (size_t)256 * D; S.btile = (size_t)256 * 64; S.nM = 32; S.nN = 8; S.G = G; S.c = bx;
            pg8::EpiP4 E{(bf16*)(p.ws + WS_PRE)};
            pg8::gemm_phase<pg8::EpiP4, pg8::DenseSched, false, 2>(lds, D / 2, D / 2, 64, S, E, wave0, 0u, (size_t)2048 * 128, 2048);
        }
        SEAM(pb + 3);
        if (IN(pb + 4)) {
            const int tid = ltid(wave0);
            for (int rep = 0; rep < REPS(5); ++rep) for (int u = bx; u < T / 32; u += G) ln1_router_unit(p, l, u, lds, tid, rep + 1 < REPS(5));
        }
        SEAM(pb + 4);
        if (IN(pb + 5)) for (int rep = 0; rep < REPS(6); ++rep) {
            moe_tables(p, l, tb, ltid(wave0));
            pg8::MoeSched<4, true> S; S.tb = tb; S.A = (const char*)(p.ws + WS_X8); S.B = wl + WL_GU; S.bexp = (size_t)1024 * D; S.btile = (size_t)256 * 64; S.arow = D;
            S.list = (const int*)(p.ws + WS_LIST) + (size_t)l * 64 * 8192; S.G = G; S.vcu = vcu; S.rows = (const LAS int*)(lds + 131072);
            S.preload_rows((LAS int*)(lds + 131072), ltid(wave0));
            pg8::EpiP6 E{p.ws + WS_H};
            pg8::gemm_phase<pg8::EpiP6, pg8::MoeSched<4, true>, true, 1>(lds, D / 2, D / 2, 64, S, E, wave0, STAGGER(STAG6), (size_t)1024 * 128, 1024);
        }
        SEAM(pb + 5);
        if (IN(pb + 6)) for (int rep = 0; rep < REPS(7); ++rep) {
            if (lo == pb + 6) moe_tables(p, l, tb, ltid(wave0));
            pg8::MoeSched<8, false> S; S.tb = tb; S.A = (const char*)(p.ws + WS_H); S.B = wl + WL_D; S.bexp = (size_t)D * EH; S.btile = (size_t)256 * 64; S.arow = EH;
            S.list = nullptr; S.G = G; S.vcu = vcu; S.rows = nullptr;
            pg8::EpiP7 E{p.ws + WS_Y};
            pg8::gemm_phase<pg8::EpiP7, pg8::MoeSched<8, false>, false, 4>(lds, EH / 2, EH / 2, 64, S, E, wave0, STAGGER(STAG7), (size_t)D * 128, D);
        }
        SEAM(pb + 6);
        if (IN(pb + 7)) {
            const int tid = ltid(wave0), lane = tid & 63, wave = __builtin_amdgcn_readfirstlane(tid >> 6);
            if (lo == pb + 7) moe_tables(p, l, tb, tid);
            const int gw = bx * 8 + wave, NGW = G * 8;
            for (int rep = 0; rep < REPS(8); ++rep)
#pragma unroll 1
            for (int t = gw; t < T; t += NGW) { if (l == NL - 1) combine_ln2_row<true>(p, l, t, tb, ltid(wave0) & 63, rep + 1 < REPS(8)); else combine_ln2_row<false>(p, l, t, tb, ltid(wave0) & 63, rep + 1 < REPS(8)); }
        }
        SEAM(pb + 7);
    }
#undef IN
#undef SEAM
}

extern "C" void kernel_launch(void* const* d_in, const int* in_sizes, int n_in, void* d_out, int out_size, void* d_ws, size_t ws_size, hipStream_t stream) {
    static int grid = 0;
    if (grid == 0) {
        if (n_in != 27 || out_size != T * D || ws_size < WS_END) { fprintf(stderr, "kernel_launch: unexpected shapes (n_in %d out %d ws %zu, need %zu)\n", n_in, out_size, ws_size, (size_t)WS_END); grid = -1; return; }
        int dev = 0, cus = 0, per_cu = 0;
        if (hipGetDevice(&dev) != hipSuccess || hipDeviceGetAttribute(&cus, hipDeviceAttributeMultiprocessorCount, dev) != hipSuccess) { fprintf(stderr, "kernel_launch: device query failed\n"); grid = -1; return; }
        if (hipFuncSetAttribute((const void*)fwd, hipFuncAttributeMaxDynamicSharedMemorySize, LDS_BYTES) != hipSuccess) { fprintf(stderr, "kernel_launch: hipFuncSetAttribute failed\n"); grid = -1; return; }
        if (hipOccupancyMaxActiveBlocksPerMultiprocessor(&per_cu, (const void*)fwd, 512, LDS_BYTES) != hipSuccess || per_cu < 1) fprintf(stderr, "kernel_launch: note: occupancy query reports %d workgroups per CU\n", per_cu);
        (void)hipGetLastError();
        grid = cus;
    }
    if (grid < 0) return;
    if (hipMemsetAsync((char*)d_ws + WS_CTL, 0, 128 * 1024, stream) != hipSuccess) { fprintf(stderr, "kernel_launch: memset failed\n"); return; }
    Params p{};
    for (int i = 0; i < 27; ++i) p.in[i] = (const float*)d_in[i];
    p.out = (float*)d_out; p.ws = (unsigned char*)d_ws;
#if MK_N_LAUNCHES == 1
    p.ph_lo = 0; p.ph_hi = NPHASES;
    hipLaunchKernelGGL(fwd, dim3(grid), dim3(512), LDS_BYTES, stream, p);
#else
    for (int ph = 0; ph < NPHASES; ++ph) { p.ph_lo = ph; p.ph_hi = ph + 1; hipLaunchKernelGGL(fwd, dim3(grid), dim3(512), LDS_BYTES, stream, p); }
#endif
    const hipError_t le = hipPeekAtLastError();
    if (le != hipSuccess) fprintf(stderr, "kernel_launch: launch failed: %s\n", hipGetErrorName(le));
}
```
